# Optimizing an MI355X kernel written in HIP

```python
import math
import jax
import jax.numpy as jnp
from jax import lax
import numpy as np

D_MODEL = 1024
BATCH = 16
SEQ = 2048
DEPTH = 2

GRID_W = 64
CTX_LEN = 256
D_MIX = D_MODEL
BRANCH = D_MIX // 4
HEAD_DIM = 64
BRANCH_HEADS = BRANCH // HEAD_DIM
SSD_HEADS = BRANCH_HEADS
SSD_GROUPS = 2
SSD_STATE = 128
SSD_BC = SSD_GROUPS * SSD_STATE
SSD_CONV = 5
SSD_CONV_CH = BRANCH + 2 * SSD_BC
SSD_CHUNK = 2 * GRID_W
GM_CHUNK = 2 * GRID_W
GM_HEADS = BRANCH_HEADS
GM_HEAD_DIM = BRANCH // GM_HEADS
SC_CONV = 3
CF_CONV = 31
D_FF = 2816
N_EXPERTS = 8
TOP_K = 2
E_FF = 3584
N_DENSE = (DEPTH + 1) // 2
N_MOE = DEPTH // 2
IN_WIDTHS = (SSD_CONV_CH, 2 * SSD_HEADS, BRANCH, 2 * BRANCH, 3 * BRANCH, 2 * BRANCH)
IN_COLS = sum(IN_WIDTHS)
IN_SPLITS = tuple(int(s) for s in np.cumsum(IN_WIDTHS)[:-1])
SSD_CTX_COLS = SSD_CONV_CH + 2 * SSD_HEADS

kernel_name = 'hybrid_ssd_gmlp_conv_moe_dit'


def rmsnorm(x, g, eps=1e-6):
    xf = x.astype(jnp.float32)
    y = xf * lax.rsqrt(jnp.mean(xf * xf, axis=-1, keepdims=True) + eps)
    return y.astype(x.dtype) * g


def layernorm(x, g, b, eps=1e-5):
    xf = x.astype(jnp.float32)
    mu = jnp.mean(xf, axis=-1, keepdims=True)
    var = jnp.mean(jnp.square(xf - mu), axis=-1, keepdims=True)
    return ((xf - mu) * lax.rsqrt(var + eps)).astype(x.dtype) * g + b


def modulate(h, shift, scale):
    return h * (1 + scale) + shift


def dwconv(x, w):
    k, ch = w.shape
    return lax.conv_general_dilated(x, w[:, None, :], (1,), [(k // 2, k // 2)],
                                    dimension_numbers=('NWC', 'WIO', 'NWC'), feature_group_count=ch)


def flip(t):
    return jnp.flip(t, axis=1)


def to_chunks(t):
    bsz, length = t.shape[:2]
    return t.reshape(bsz, length // SSD_CHUNK, SSD_CHUNK, *t.shape[2:])


def ssd_prepare(xs, dt, a):
    bsz, length, nh, hd = xs.shape
    nc = length // SSD_CHUNK
    xdt = (xs * dt[..., None]).reshape(bsz, nc, SSD_CHUNK, nh, hd)
    a_cs = jnp.cumsum((dt * a).reshape(bsz, nc, SSD_CHUNK, nh), axis=2).transpose(0, 3, 1, 2)
    return xdt, a_cs


def ssd_chunk_states(xdt, a_cs, b_c, init):
    decay_to_end = jnp.exp(a_cs[..., -1:] - a_cs)
    chunk_states = jnp.einsum('bclhn,bhcl,bclhp->bchpn', b_c, decay_to_end, xdt)
    chunk_decay = jnp.exp(a_cs[..., -1])

    def step(state, inp):
        s_c, d_c = inp
        return state * d_c[..., None, None] + s_c, state

    final, entering = lax.scan(step, init, (jnp.moveaxis(chunk_states, 1, 0), jnp.moveaxis(chunk_decay, 2, 0)))
    return jnp.moveaxis(entering, 0, 1), final


def ssd_scan(xs, dt, a, bs, cs, init):
    xdt, a_cs = ssd_prepare(xs, dt, a)
    b_c, c_c = to_chunks(bs), to_chunks(cs)
    entering, final = ssd_chunk_states(xdt, a_cs, b_c, init)
    lower = jnp.tril(jnp.ones((SSD_CHUNK, SSD_CHUNK), dtype=bool))
    lmat = jnp.exp(jnp.where(lower, a_cs[..., :, None] - a_cs[..., None, :], -jnp.inf))
    y_diag = jnp.einsum('bclhn,bcshn,bhcls,bcshp->bclhp', c_c, b_c, lmat, xdt)
    y_off = jnp.einsum('bclhn,bchpn,bhcl->bclhp', c_c, entering, jnp.exp(a_cs))
    return (y_diag + y_off).reshape(xs.shape), final


def ssd_inputs(xbc_raw, dt_raw, p):
    bsz, length, _ = xbc_raw.shape
    xbc = jax.nn.silu(dwconv(xbc_raw, p['ssd_conv_w']) + p['ssd_conv_b']).astype(jnp.float32)
    xs, bs, cs = jnp.split(xbc, (BRANCH, BRANCH + SSD_BC), axis=-1)
    rep = SSD_HEADS // SSD_GROUPS
    xs = xs.reshape(bsz, length, SSD_HEADS, HEAD_DIM)
    bs = jnp.repeat(bs.reshape(bsz, length, SSD_GROUPS, SSD_STATE), rep, axis=2)
    cs = jnp.repeat(cs.reshape(bsz, length, SSD_GROUPS, SSD_STATE), rep, axis=2)
    dt = jax.nn.softplus(dt_raw.astype(jnp.float32).reshape(bsz, length, 2, SSD_HEADS)
                         + p['ssd_dt_bias'].astype(jnp.float32))
    a = -jnp.exp(p['ssd_a_log'].astype(jnp.float32))
    return xs, bs, cs, dt, a


def ssd_bidir(xs, bs, cs, dt, a, init_f, init_b):
    y_f, fin_f = ssd_scan(xs, dt[:, :, 0], a[0], bs, cs, init_f)
    y_b, fin_b = ssd_scan(flip(xs), flip(dt[:, :, 1]), a[1], flip(bs), flip(cs), init_b)
    return y_f + flip(y_b), fin_f, fin_b


def ssd_context_states(zc, p, init):
    xbc_raw, dt_raw = jnp.split(zc, (SSD_CONV_CH,), axis=-1)
    xs, bs, _, dt, a = ssd_inputs(xbc_raw, dt_raw, p)
    xdt_f, acs_f = ssd_prepare(xs, dt[:, :, 0], a[0])
    fin_f = ssd_chunk_states(xdt_f, acs_f, to_chunks(bs), init)[1]
    xdt_b, acs_b = ssd_prepare(flip(xs), flip(dt[:, :, 1]), a[1])
    fin_b = ssd_chunk_states(xdt_b, acs_b, to_chunks(flip(bs)), init)[1]
    return fin_f, fin_b


def mixer_branches(z, p, init_f, init_b):
    xbc_raw, dt_raw, ssd_z, uv, sc, cf = jnp.split(z, IN_SPLITS, axis=-1)
    bsz, length, _ = z.shape
    xs, bs, cs, dt, a = ssd_inputs(xbc_raw, dt_raw, p)
    y, fin_f, fin_b = ssd_bidir(xs, bs, cs, dt, a, init_f, init_b)
    y = (y + p['ssd_d'].astype(jnp.float32)[:, None] * xs).reshape(bsz, length, BRANCH).astype(z.dtype)
    y_ssd = rmsnorm(y * jax.nn.silu(ssd_z), p['ssd_norm_g'])
    u, v = jnp.split(jax.nn.gelu(uv), 2, axis=-1)
    v = layernorm(v, p['gm_norm_g'], p['gm_norm_b'])
    v = v.reshape(bsz, length // GM_CHUNK, GM_CHUNK, GM_HEADS, GM_HEAD_DIM)
    s = jnp.einsum('gts,bcsgd->bctgd', p['gm_ws'], v) + p['gm_bs'].T[:, :, None]
    y_gm = u * s.reshape(bsz, length, BRANCH)
    gb, gc, xin = jnp.split(sc, 3, axis=-1)
    y_sc = gb * dwconv(gc * xin, p['sc_conv_w'])
    ca, cg = jnp.split(cf, 2, axis=-1)
    cv = dwconv(ca * jax.nn.sigmoid(cg), p['cf_conv_w']) + p['cf_conv_b']
    y_cf = jax.nn.silu(layernorm(cv, p['cf_norm_g'], p['cf_norm_b']))
    return jnp.concatenate([y_ssd, y_gm, y_sc, y_cf], axis=-1), fin_f, fin_b


def swiglu(h, w1, w3, w2):
    return (jax.nn.silu(h @ w1) * (h @ w3)) @ w2


def moe_swiglu(h, router, w1, w3, w2):
    logits = (h @ router).astype(jnp.float32)
    top_v, top_i = lax.top_k(logits, TOP_K)
    probs = jax.nn.softmax(top_v, axis=-1)
    combine = jnp.sum(jax.nn.one_hot(top_i, N_EXPERTS, dtype=jnp.float32) * probs[..., None], axis=-2).astype(h.dtype)
    out = jnp.zeros_like(h)
    for e in range(N_EXPERTS):
        out = out + combine[..., e:e + 1] * swiglu(h, w1[e], w3[e], w2[e])
    return out


def channel_mixer(t, l, ffn_w1, ffn_w3, ffn_w2, moe_router, moe_w1, moe_w3, moe_w2):
    i = l // 2
    if l % 2 == 0:
        return swiglu(t, ffn_w1[i], ffn_w3[i], ffn_w2[i])
    return moe_swiglu(t, moe_router[i], moe_w1[i], moe_w3[i], moe_w2[i])


def setup_inputs(seed: int = 0) -> dict:
    key = jax.random.key(seed)
    ks = iter(jax.random.split(key, 48))

    def nrm(shape, scale):
        return jax.random.normal(next(ks), shape, jnp.float32) * scale

    def gain(shape):
        return 1.0 + nrm(shape, 0.05)

    dt0 = jnp.exp(jax.random.uniform(next(ks), (DEPTH, 2, SSD_HEADS), jnp.float32, math.log(1e-3), math.log(1e-1)))
    a0 = jax.random.uniform(next(ks), (DEPTH, 2, SSD_HEADS), jnp.float32, 1.0, 16.0)
    return {
        'x': nrm((BATCH, SEQ, D_MODEL), 1.0),
        'c': nrm((BATCH, D_MODEL), 1.0),
        'ctx': nrm((BATCH, CTX_LEN, D_MODEL), 1.0),
        'c_ctx': nrm((D_MODEL,), 1.0),
        'mod_w': nrm((DEPTH, D_MODEL, 6 * D_MODEL), 0.5 * D_MODEL ** -0.5),
        'mod_b': nrm((DEPTH, 6 * D_MODEL), 0.02),
        'norm1_g': gain((DEPTH, D_MODEL)),
        'norm2_g': gain((DEPTH, D_MODEL)),
        'w_in': nrm((DEPTH, D_MODEL, IN_COLS), D_MODEL ** -0.5),
        'w_out': nrm((DEPTH, D_MIX, D_MODEL), D_MIX ** -0.5),
        'ssd_conv_w': nrm((DEPTH, SSD_CONV, SSD_CONV_CH), SSD_CONV ** -0.5),
        'ssd_conv_b': nrm((DEPTH, SSD_CONV_CH), 0.02),
        'ssd_dt_bias': dt0 + jnp.log(-jnp.expm1(-dt0)),
        'ssd_a_log': jnp.log(a0),
        'ssd_d': gain((DEPTH, SSD_HEADS)),
        'ssd_norm_g': gain((DEPTH, BRANCH)),
        'gm_norm_g': gain((DEPTH, BRANCH)),
        'gm_norm_b': nrm((DEPTH, BRANCH), 0.02),
        'gm_ws': nrm((DEPTH, GM_HEADS, GM_CHUNK, GM_CHUNK), GM_CHUNK ** -0.5),
        'gm_bs': gain((DEPTH, GM_HEADS, GM_CHUNK)),
        'sc_conv_w': nrm((DEPTH, SC_CONV, BRANCH), SC_CONV ** -0.5),
        'cf_conv_w': nrm((DEPTH, CF_CONV, BRANCH), CF_CONV ** -0.5),
        'cf_conv_b': nrm((DEPTH, BRANCH), 0.02),
        'cf_norm_g': gain((DEPTH, BRANCH)),
        'cf_norm_b': nrm((DEPTH, BRANCH), 0.02),
        'ffn_w1': nrm((N_DENSE, D_MODEL, D_FF), D_MODEL ** -0.5),
        'ffn_w3': nrm((N_DENSE, D_MODEL, D_FF), D_MODEL ** -0.5),
        'ffn_w2': nrm((N_DENSE, D_FF, D_MODEL), D_FF ** -0.5),
        'moe_router': nrm((N_MOE, D_MODEL, N_EXPERTS), D_MODEL ** -0.5),
        'moe_w1': nrm((N_MOE, N_EXPERTS, D_MODEL, E_FF), D_MODEL ** -0.5),
        'moe_w3': nrm((N_MOE, N_EXPERTS, D_MODEL, E_FF), D_MODEL ** -0.5),
        'moe_w2': nrm((N_MOE, N_EXPERTS, E_FF, D_MODEL), E_FF ** -0.5),
        'final_norm_g': gain((D_MODEL,)),
    }


def reference(x, c, ctx, c_ctx, mod_w, mod_b, norm1_g, norm2_g, w_in, w_out,
              ssd_conv_w, ssd_conv_b, ssd_dt_bias, ssd_a_log, ssd_d, ssd_norm_g,
              gm_norm_g, gm_norm_b, gm_ws, gm_bs, sc_conv_w, cf_conv_w, cf_conv_b, cf_norm_g, cf_norm_b,
              ffn_w1, ffn_w3, ffn_w2, moe_router, moe_w1, moe_w3, moe_w2, final_norm_g):
    bsz = x.shape[0]
    xc = ctx
    silu_c = jax.nn.silu(c)
    silu_cc = jax.nn.silu(c_ctx)
    zero_state = jnp.zeros((bsz, SSD_HEADS, HEAD_DIM, SSD_STATE), jnp.float32)
    for l in range(DEPTH):
        last = l == DEPTH - 1
        p = {'ssd_conv_w': ssd_conv_w[l], 'ssd_conv_b': ssd_conv_b[l], 'ssd_dt_bias': ssd_dt_bias[l],
             'ssd_a_log': ssd_a_log[l], 'ssd_d': ssd_d[l], 'ssd_norm_g': ssd_norm_g[l],
             'gm_norm_g': gm_norm_g[l], 'gm_norm_b': gm_norm_b[l], 'gm_ws': gm_ws[l], 'gm_bs': gm_bs[l],
             'sc_conv_w': sc_conv_w[l], 'cf_conv_w': cf_conv_w[l], 'cf_conv_b': cf_conv_b[l],
             'cf_norm_g': cf_norm_g[l], 'cf_norm_b': cf_norm_b[l]}
        sh1, sc1, g1, sh2, sc2, g2 = jnp.split((silu_c @ mod_w[l] + mod_b[l])[:, None, :], 6, axis=-1)
        csh1, csc1, cg1, csh2, csc2, cg2 = jnp.split(silu_cc @ mod_w[l] + mod_b[l], 6, axis=-1)
        h = modulate(rmsnorm(x, norm1_g[l]), sh1, sc1)
        hc = modulate(rmsnorm(xc, norm1_g[l]), csh1, csc1)
        if last:
            st_f, st_b = ssd_context_states(hc @ w_in[l][:, :SSD_CTX_COLS], p, zero_state)
        else:
            mix_c, st_f, st_b = mixer_branches(hc @ w_in[l], p, zero_state, zero_state)
            xc = xc + cg1 * (mix_c @ w_out[l])
        mix, _, _ = mixer_branches(h @ w_in[l], p, st_f, st_b)
        x = x + g1 * (mix @ w_out[l])
        h2 = modulate(rmsnorm(x, norm2_g[l]), sh2, sc2)
        x = x + g2 * channel_mixer(h2, l, ffn_w1, ffn_w3, ffn_w2, moe_router, moe_w1, moe_w3, moe_w2)
        if not last:
            hc2 = modulate(rmsnorm(xc, norm2_g[l]), csh2, csc2)
            xc = xc + cg2 * channel_mixer(hc2, l, ffn_w1, ffn_w3, ffn_w2, moe_router, moe_w1, moe_w3, moe_w2)
    return rmsnorm(x, final_norm_g)
```

```cpp
#include <hip/hip_runtime.h>
#include <cstdio>
#include <cstdint>

#ifndef PROBE_MASK
#define PROBE_MASK 0u
#endif
#define REPS(k) (((PROBE_MASK >> (k)) & 1u) ? 2 : 1)
#ifndef ONE_LAUNCH
#define ONE_LAUNCH 1
#endif
#ifndef G8_PIPE
#define G8_PIPE 1
#endif
#ifndef G8_W0_RFIRST
#define G8_W0_RFIRST 0
#endif
#ifndef G8_W1_DPOS
#define G8_W1_DPOS 1
#endif
#ifndef FFN8
#define FFN8 1
#endif

#define GAS __attribute__((address_space(1)))
#define LAS __attribute__((address_space(3)))
typedef unsigned short bf16;
typedef short bf16x8 __attribute__((ext_vector_type(8)));
typedef float f32x4 __attribute__((ext_vector_type(4)));
typedef float f32x2 __attribute__((ext_vector_type(2)));
typedef unsigned u32x4 __attribute__((ext_vector_type(4)));
typedef unsigned u32x2 __attribute__((ext_vector_type(2)));
typedef int i32x4 __attribute__((ext_vector_type(4)));
typedef int i32x8 __attribute__((ext_vector_type(8)));

constexpr int D = 1024, BATCH = 16, SEQ = 2048, CTXL = 256;
constexpr int RX = BATCH * SEQ, RC = BATCH * CTXL, RT = RX + RC;
constexpr int INC = 2824, ZC = 2816, DFF = 2816, EFF = 3584, NE = 8;
constexpr int NCHX = RX / 128, NCHC = RC / 128, NCH = NCHX + NCHC;
constexpr int MOE_ROWS = 34816;
constexpr int MOE_TILES = MOE_ROWS / 256;
constexpr int ZO_X = 0, ZO_B = 256, ZO_C = 512, ZO_Z = 768, ZO_U = 1024, ZO_V = 1280, ZO_GB = 1536, ZO_GC = 1792, ZO_XIN = 2048, ZO_CA = 2304, ZO_CG = 2560;

constexpr size_t al256(size_t x) { return (x + 255) & ~(size_t)255; }
constexpr size_t WS_CTL = 0, CTL_BYTES = 1u << 20;
constexpr size_t WS_MODV = WS_CTL + CTL_BYTES;
constexpr size_t WS_DT = WS_MODV + al256((size_t)2 * 17 * 6144 * 4);
constexpr size_t WS_ACS = WS_DT + (size_t)RT * 8 * 4;
constexpr size_t WS_TOPE = WS_ACS + (size_t)RT * 8 * 4;
constexpr size_t WS_TOPP = WS_TOPE + (size_t)RX * 2 * 4;
constexpr size_t WS_ROWTOK = WS_TOPP + (size_t)RX * 2 * 4;
constexpr size_t WS_ROWP = WS_ROWTOK + (size_t)2 * MOE_ROWS * 4;
constexpr size_t WS_SLOT = WS_ROWP + (size_t)2 * MOE_ROWS * 4;
constexpr size_t WS_WIN = WS_SLOT + (size_t)2 * RX * 4;
constexpr size_t WS_WOUT = WS_WIN + (size_t)2 * ZC * D * 2;
constexpr size_t WS_WUP = WS_WOUT + (size_t)2 * D * D * 2;
constexpr size_t WS_WDN = WS_WUP + (size_t)2 * DFF * D * 2;
constexpr size_t WS_XC = WS_WDN + (size_t)D * DFF * 2;
constexpr size_t WS_H = WS_XC + (size_t)RC * D * 4;
constexpr size_t WS_Z = WS_H + (size_t)RT * D * 2;
constexpr size_t WS_XBC = WS_Z + (size_t)RT * ZC * 2;
constexpr size_t WS_ST = WS_XBC + (size_t)RT * 768 * 2;
constexpr size_t WS_STE = WS_ST + (size_t)NCH * 2 * 4 * 8192 * 4;
constexpr size_t WS_XT = WS_STE + (size_t)NCH * 2 * 4 * 8192 * 2;
constexpr size_t WS_WSB = WS_XT + (size_t)NCH * 256 * 128 * 2;
constexpr size_t WS_END_MIX = WS_WSB + (size_t)2 * 4 * 128 * 128 * 2;
constexpr int FFN_P = 4;
constexpr size_t WS_FSLAB = WS_ST;
static_assert((size_t)16 * 4 * FFN_P * 65536 * 4 <= (size_t)NCH * 2 * 4 * 8192 * 4, "ffn slabs fit the chunk-state buffer");
constexpr size_t WS_WMUP = WS_Z;
constexpr size_t WS_WMDN = WS_WMUP + (size_t)NE * 2 * EFF * D;
constexpr size_t WS_T = WS_WMDN + (size_t)NE * D * EFF;
constexpr int MOE_P = 7, MOE_TAIL_TILES = MOE_TILES - 128;
constexpr size_t MOE_SLAB_BYTES = (size_t)MOE_TAIL_TILES * 4 * MOE_P * 65536 * 2;
constexpr size_t WS_MSLAB0 = WS_WIN;
constexpr size_t WS_MSLAB1 = WS_T + (size_t)2 * MOE_ROWS * EFF;
constexpr size_t WS_END_MOE = WS_MSLAB1 + MOE_SLAB_BYTES;
static_assert(WS_MSLAB0 + MOE_SLAB_BYTES <= WS_H, "pass-0 slabs fit below the activation buffer");
constexpr size_t WS_NEED = WS_END_MOE > WS_END_MIX ? WS_END_MOE : WS_END_MIX;
static_assert(WS_NEED < (size_t)612 * 1000 * 1000, "workspace budget");
constexpr int CW_BAR = 4096;
constexpr int CW_CNT = 8192;
constexpr int CW_RUN = 8192 + 64;
constexpr int CW_TMO = 0;

constexpr int RING_BYTES = 131072;
constexpr int LDS_BYTES = 147456;
constexpr int MISC_OFF = LDS_BYTES - 256;

#define RLX_AGENT __ATOMIC_RELAXED, __HIP_MEMORY_SCOPE_AGENT
__device__ __forceinline__ float bflo(unsigned w) { return __uint_as_float(w << 16); }
__device__ __forceinline__ float bfhi(unsigned w) { return __uint_as_float(w & 0xffff0000u); }
__device__ __forceinline__ unsigned cvt_pk_bf16(float lo, float hi) { unsigned r; asm volatile("v_cvt_pk_bf16_f32 %0, %1, %2" : "=v"(r) : "v"(lo), "v"(hi)); return r; }
__device__ __forceinline__ float fexp(float x) { return __builtin_amdgcn_exp2f(x * 1.4426950408889634f); }
__device__ __forceinline__ float silu_f(float x) { return x * __builtin_amdgcn_rcpf(1.0f + fexp(-x)); }
__device__ __forceinline__ float sigmoid_f(float x) { return __builtin_amdgcn_rcpf(1.0f + fexp(-x)); }
__device__ __forceinline__ float gelu_tanh_f(float x) { const float u = 0.7978845608028654f * (x + 0.044715f * x * x * x); return x * __builtin_amdgcn_rcpf(1.0f + fexp(-2.0f * u)); }
__device__ __forceinline__ unsigned pk4_fp8(float a, float b, float c, float d) { int w = __builtin_amdgcn_cvt_pk_fp8_f32(a, b, 0, false); w = __builtin_amdgcn_cvt_pk_fp8_f32(c, d, w, true); return (unsigned)w; }
__device__ __forceinline__ float softplus_f(float x) { return fmaxf(x, 0.0f) + log1pf(__expf(-fabsf(x))); }
__device__ __forceinline__ float wave_sum(float v) {
#pragma unroll
    for (int o = 1; o < 64; o <<= 1) v += __shfl_xor(v, o);
    return v;
}
__device__ __forceinline__ void unpack8(const u32x4 w, float (&f)[8]) { f[0] = bflo(w.x); f[1] = bfhi(w.x); f[2] = bflo(w.y); f[3] = bfhi(w.y); f[4] = bflo(w.z); f[5] = bfhi(w.z); f[6] = bflo(w.w); f[7] = bfhi(w.w); }
__device__ __forceinline__ u32x4 pack8(const float (&f)[8]) { u32x4 w; w.x = cvt_pk_bf16(f[0], f[1]); w.y = cvt_pk_bf16(f[2], f[3]); w.z = cvt_pk_bf16(f[4], f[5]); w.w = cvt_pk_bf16(f[6], f[7]); return w; }

#define XB_TMO      128
#define XB_XCNT(j)  (256  + 64 * (j))
#define XB_XSUB(j)  (1280 + 64 * (j))
#define XB_XGEN(j)  (2304 + 64 * (j))
#define XB_TOP      3328
#define XB_TOPGEN   3392
#define XCD_BAR_WORDS 3456
#define XB_SPIN_CAP (1u << 22)
__device__ __forceinline__ unsigned xb_ld(unsigned* p)              { return __hip_atomic_load(p, __ATOMIC_RELAXED, __HIP_MEMORY_SCOPE_AGENT); }
__device__ __forceinline__ unsigned xb_add(unsigned* p, unsigned v) { return __hip_atomic_fetch_add(p, v, __ATOMIC_RELAXED, __HIP_MEMORY_SCOPE_AGENT); }
__device__ __forceinline__ unsigned xb_xcc_id() { return (unsigned)__builtin_amdgcn_s_getreg((3 << 11) | 20) & 0xFu; }
#define XB_SPIN(cond, bar) do { unsigned _sp = 0; while (cond) { __builtin_amdgcn_s_sleep(1); \
    if ((++_sp & 255u) == 0u) { if (xb_ld(&(bar)[XB_TMO])) break; if (_sp > XB_SPIN_CAP) { atomicAdd(&(bar)[XB_TMO], 1u); break; } } } } while (0)
struct XcdBarrier { unsigned* bar; unsigned x; volatile LAS unsigned* st; };
__device__ __forceinline__ XcdBarrier xcd_barrier_post(unsigned* bar, volatile LAS unsigned* st, int tid) {
    XcdBarrier b; b.bar = bar; b.x = xb_xcc_id(); b.st = st;
    if (tid == 0) (void)xb_add(&bar[XB_XCNT(b.x)], 1u);
    return b;
}
__device__ __forceinline__ void xcd_barrier_complete(unsigned* bar, unsigned x, unsigned& nloc, unsigned& nx) {
    const unsigned G = gridDim.x * gridDim.y * gridDim.z;
    unsigned sum, cnt, mine, sp = 0u;
    for (;;) {
        sum = 0u; cnt = 0u; mine = 0u;
#pragma unroll
        for (unsigned j = 0; j < 16; ++j) { const unsigned c = xb_ld(&bar[XB_XCNT(j)]); sum += c; cnt += (c > 0u) ? 1u : 0u; mine = (j == x) ? c : mine; }
        if (sum == G) break;
        __builtin_amdgcn_s_sleep(1);
        if ((++sp & 255u) == 0u) { if (xb_ld(&bar[XB_TMO])) break; if (sp > XB_SPIN_CAP) { atomicAdd(&bar[XB_TMO], 1u); break; } }
    }
    nloc = mine > 0u ? mine : 1u; nx = cnt > 0u ? cnt : 1u;
}
__device__ __forceinline__ void xcd_barrier(const XcdBarrier& b, int tid) {
    asm volatile("s_waitcnt vmcnt(0)" ::: "memory");
    __syncthreads();
    if (tid == 0) {
        unsigned* bar = b.bar;
        __builtin_amdgcn_s_waitcnt(0);
        unsigned nloc = b.st[0], nx = b.st[1];
        if (nloc == 0u) { xcd_barrier_complete(bar, b.x, nloc, nx); b.st[0] = nloc; b.st[1] = nx; }
        const unsigned k = b.st[2] + 1u; b.st[2] = k;
        const unsigned old = xb_add(&bar[XB_XSUB(b.x)], 1u);
        if (old + 1u == k * nloc) {
            __builtin_amdgcn_fence(__ATOMIC_RELEASE, "agent");
            asm volatile("s_waitcnt vmcnt(0)" ::: "memory");
            xb_add(&bar[XB_TOP], 1u);
        }
        { unsigned sp = 0u; while (xb_add(&bar[XB_TOP], 0u) < k * nx) {
            __builtin_amdgcn_s_sleep(2); if ((++sp & 255u) == 0u) { if (xb_ld(&bar[XB_TMO])) break; if (sp > XB_SPIN_CAP) { atomicAdd(&bar[XB_TMO], 1u); break; } } } }
        __builtin_amdgcn_fence(__ATOMIC_ACQUIRE, "agent");
        asm volatile("s_waitcnt vmcnt(0)" ::: "memory");
    }
    __syncthreads();
}

namespace pg8 {
constexpr int BM = 256, BK = 64, HALF = 128, HTB = HALF * BK * 2, STAGE_BYTES = 8 * HTB, NXCD = 8, WGM = 8;
__host__ __device__ __forceinline__ int lds_byte(int r, int c) { const int st = (r >> 4) * 2 + (c >> 5), rr = r & 15, cc = c & 31, ob = rr * 64 + cc * 2; return st * 1024 + (ob ^ (((ob >> 9) & 1) << 5)); }
__host__ __device__ __forceinline__ void stage_rc(int b, int& R, int& C) { const int st = b / 1024, sb = b % 1024, swz = sb ^ (((sb >> 9) & 1) << 5); R = (st >> 1) * 16 + swz / 64; C = (st & 1) * 32 + (swz % 64) / 2; }
__host__ __device__ __forceinline__ int perm32(int rho) { const int n = rho >> 4, i = rho & 15; return 8 * (i >> 2) + 4 * n + (i & 3); }
__device__ __forceinline__ const char* uptr(const char* p) { const unsigned long long v = (unsigned long long)p; const unsigned lo = __builtin_amdgcn_readfirstlane((unsigned)v), hi = __builtin_amdgcn_readfirstlane((unsigned)(v >> 32)); return (const char*)(((unsigned long long)hi << 32) | lo); }
struct Unit { int pm, pn; const char* a; const char* b; int nt, split, part; };
__device__ __forceinline__ void tile_map(int L, int nM, int nN, int& pm, int& pn) {
    const int nwg = nM * nN; int wgid = L;
    { const int q = nwg / NXCD, r = nwg % NXCD, xcd = wgid % NXCD, off = wgid / NXCD; wgid = (xcd < r ? xcd * (q + 1) : r * (q + 1) + (xcd - r) * q) + off; }
    const int nig = WGM * nN, gid = wgid / nig, fm = gid * WGM, gsz = (nM - fm) < WGM ? (nM - fm) : WGM;
    pm = fm + ((wgid % nig) % gsz); pn = (wgid % nig) / gsz;
}
__device__ __forceinline__ bool tail_split(long L, int nu, int nwhole, int npairs, int P, int& tile, int& kt0, int& nt, int& split, int& part) {
    if (L < nwhole) { tile = (int)L; kt0 = 0; nt = 2 * npairs; split = 0; part = 0; return true; }
    const int Lt = (int)L - nwhole; if (Lt >= (nu - nwhole) * P) return false;
    part = Lt % P; const int base = npairs / P, rem = npairs % P, start = part * base + (part < rem ? part : rem), cnt = base + (part < rem ? 1 : 0);
    tile = nwhole + Lt / P; kt0 = 2 * start; nt = 2 * cnt; split = 1; return true;
}
struct RegSched {
    int nM0, nN0, n0, nM1, nN1, n1, pm1off, G, c, npairs, P; const char* A; const char* B; size_t tstep;
    __device__ __forceinline__ void init(const void* A_, const void* B_, int K, int nM0_, int nN0_, int nM1_, int nN1_, int pm1off_, int G_, int c_, int P_ = 1) {
        A = (const char*)A_; B = (const char*)B_; tstep = (size_t)256 * K * 2; nM0 = nM0_; nN0 = nN0_; n0 = nM0_ * nN0_; nM1 = nM1_; nN1 = nN1_; n1 = nM1_ * nN1_; pm1off = pm1off_; G = G_; c = c_; npairs = K / 128; P = P_; }
    __device__ __forceinline__ bool next(int i, Unit& u) const {
        const long L = (long)i * G + c; int tile, kt0;
        if (!tail_split(L, n0 + n1, P > 1 ? n0 : n0 + n1, npairs, P, tile, kt0, u.nt, u.split, u.part)) return false;
        int pm, pn;
        if (tile < n0) tile_map(tile, nM0, nN0, pm, pn); else { tile_map(tile - n0, nM1, nN1, pm, pn); pm += pm1off; }
        u.pm = pm; u.pn = pn; u.a = A + (size_t)pm * tstep + (size_t)kt0 * 128; u.b = B + (size_t)pn * tstep + (size_t)kt0 * 128; return true;
    }
    __device__ __forceinline__ void gather(const Unit&, int, unsigned (&)[2][2]) const {}
};
template <class Epi, class Sched, bool GATHER>
__device__ __forceinline__ void gemm_phase(LAS unsigned char* lds, const int K, const Sched& S, const Epi& E, int tid) {
    asm volatile("" : "+v"(tid));
    const int wid = __builtin_amdgcn_readfirstlane(tid >> 6), lane = tid & 63, wr = wid >> 2, wc = wid & 3, fr = lane & 15, fq = lane >> 4;
    unsigned voffA[2], voffB[2];
#pragma unroll
    for (int i = 0; i < 2; ++i) { int R, C; stage_rc(tid * 16 + i * 8192, R, C); const int Rb = Epi::PERM ? ((R & ~31) + perm32(R & 31)) : R;
        voffA[i] = (unsigned)(R * K + C) * 2u; voffB[i] = (unsigned)(Rb * K + C) * 2u; }
    const size_t kstep = (size_t)(BK * 2);
    const size_t hstep = (size_t)HALF * K * 2;
    const unsigned ldsw = (unsigned)wid * 1024u;
    const int aoff = lds_byte(wr * 64 + fr, fq * 8), boff = lds_byte(wc * 32 + fr, fq * 8);
#define PG8_SA(b, h) (((b) * 2 + (h)) * HTB)
#define PG8_SB(b, h) ((4 + (b) * 2 + (h)) * HTB)
#define PG8_STAGE(bufoff, gbase, voff) do { _Pragma("unroll") for (int _i = 0; _i < 2; ++_i) \
        __builtin_amdgcn_global_load_lds((const unsigned*)((const char*)(gbase) + (voff)[_i]), (LAS unsigned*)(lds + (bufoff) + ldsw + _i * 8192), 16, 0, 0); } while (0)
#define PG8_STAGE_A(bufoff, kptr, h, SEL) do { if constexpr (GATHER) { unsigned _vo[2]; _vo[0] = (SEL) ? nva[h][0] : cva[h][0]; _vo[1] = (SEL) ? nva[h][1] : cva[h][1]; PG8_STAGE(bufoff, kptr, _vo); } else { PG8_STAGE(bufoff, (kptr) + (h) * hstep, voffA); } } while (0)
#define PG8_LDA(dst, b, h) do { _Pragma("unroll") for (int m = 0; m < 4; ++m) _Pragma("unroll") for (int k = 0; k < 2; ++k) dst[m][k] = *(const LAS bf16x8*)(lds + PG8_SA(b, h) + aoff + m * 2048 + k * 1024); } while (0)
#define PG8_LDB(dst, b, h) do { _Pragma("unroll") for (int n = 0; n < 2; ++n) _Pragma("unroll") for (int k = 0; k < 2; ++k) dst[n][k] = *(const LAS bf16x8*)(lds + PG8_SB(b, h) + boff + n * 2048 + k * 1024); } while (0)
#define PG8_MMA(ai, bj, At, Bt) do { __builtin_amdgcn_s_setprio(1); _Pragma("unroll") for (int m = 0; m < 4; ++m) _Pragma("unroll") for (int n = 0; n < 2; ++n) _Pragma("unroll") for (int k = 0; k < 2; ++k) \
        acc[ai][bj][m][n] = __builtin_amdgcn_mfma_f32_16x16x32_bf16(Bt[n][k], At[m][k], acc[ai][bj][m][n], 0, 0, 0); __builtin_amdgcn_s_setprio(0); } while (0)
#define PG8_WAIT_V(n) asm volatile("s_waitcnt vmcnt(" #n ")" ::: "memory")
#define PG8_WAIT_L(n) asm volatile("s_waitcnt lgkmcnt(" #n ")" ::: "memory")
#define PG8_BAR __builtin_amdgcn_s_barrier()
#define PG8_SCHED __builtin_amdgcn_sched_barrier(0)
    Unit cur, nxt; int ui = 0;
    if (!S.next(0, cur)) return;
    f32x4 acc[2][2][4][2];
#pragma unroll
    for (int a = 0; a < 2; ++a)
#pragma unroll
        for (int b = 0; b < 2; ++b)
#pragma unroll
            for (int m = 0; m < 4; ++m)
#pragma unroll
                for (int n = 0; n < 2; ++n) acc[a][b][m][n] = (f32x4){0.f, 0.f, 0.f, 0.f};
    bf16x8 At[4][2], B0[2][2], B1[2][2];
    unsigned cva[2][2] = {{0u, 0u}, {0u, 0u}}, nva[2][2] = {{0u, 0u}, {0u, 0u}};
    if constexpr (GATHER) S.gather(cur, tid, cva);
    const char* cA = uptr(cur.a); const char* cB = uptr(cur.b);
    PG8_STAGE(PG8_SB(0, 0), cB, voffB); PG8_STAGE(PG8_SB(0, 1), cB + hstep, voffB); PG8_STAGE_A(PG8_SA(0, 0), cA, 0, false); PG8_STAGE_A(PG8_SA(0, 1), cA, 1, false);
    if (wr == 1) PG8_BAR;
    PG8_WAIT_V(2); PG8_BAR;
    PG8_STAGE(PG8_SB(1, 0), cB + kstep, voffB); PG8_STAGE_A(PG8_SA(1, 0), cA + kstep, 0, false); PG8_STAGE(PG8_SB(1, 1), cB + hstep + kstep, voffB);
    PG8_WAIT_V(6); PG8_BAR;
    for (;;) {
        const bool has_next = S.next(ui + 1, nxt);
        const char* nA = uptr(has_next ? nxt.a : cA); const char* nB = uptr(has_next ? nxt.b : cB);
        if constexpr (GATHER) { if (has_next) S.gather(nxt, tid, nva); else {
#pragma unroll
            for (int h = 0; h < 2; ++h)
#pragma unroll
                for (int i = 0; i < 2; ++i) nva[h][i] = cva[h][i]; } }
        const int nt = cur.nt;
        for (int t = 0; t < nt; t += 2) {
            const bool last = (t == nt - 2);
            asm volatile("" : "+v"(voffA[0]), "+v"(voffA[1]), "+v"(voffB[0]), "+v"(voffB[1]));
            const char* a1 = uptr(cA + (size_t)(t + 1) * kstep);
            const char* a2 = uptr(last ? nA : cA + (size_t)(t + 2) * kstep); const char* b2 = uptr(last ? nB : cB + (size_t)(t + 2) * kstep);
            const char* a3 = a2 + kstep; const char* b3 = b2 + kstep;
            PG8_LDB(B0, 0, 0); PG8_LDB(B1, 0, 1); PG8_SCHED; PG8_LDA(At, 0, 0); PG8_STAGE_A(PG8_SA(1, 1), a1, 1, false);
            PG8_WAIT_V(8); PG8_WAIT_L(0); PG8_BAR; PG8_MMA(0, 0, At, B0); PG8_MMA(0, 1, At, B1); PG8_BAR; PG8_SCHED;
            PG8_LDA(At, 0, 1); PG8_STAGE(PG8_SB(0, 0), b2, voffB); PG8_STAGE(PG8_SB(0, 1), b2 + hstep, voffB); PG8_STAGE_A(PG8_SA(0, 0), a2, 0, last);
            PG8_WAIT_V(8); PG8_WAIT_L(0); PG8_BAR; PG8_MMA(1, 0, At, B0); PG8_MMA(1, 1, At, B1); PG8_BAR; PG8_SCHED;
            PG8_LDB(B0, 1, 0); PG8_LDB(B1, 1, 1); PG8_SCHED; PG8_LDA(At, 1, 0); PG8_STAGE_A(PG8_SA(0, 1), a2, 1, last);
            PG8_WAIT_V(8); PG8_WAIT_L(0); PG8_BAR; PG8_MMA(0, 0, At, B0); PG8_MMA(0, 1, At, B1); PG8_BAR; PG8_SCHED;
            PG8_LDA(At, 1, 1); PG8_STAGE(PG8_SB(1, 0), b3, voffB); PG8_STAGE(PG8_SB(1, 1), b3 + hstep, voffB); PG8_STAGE_A(PG8_SA(1, 0), a3, 0, last);
            PG8_WAIT_V(8); PG8_WAIT_L(0); PG8_BAR; PG8_MMA(1, 0, At, B0); PG8_MMA(1, 1, At, B1); PG8_BAR; PG8_SCHED;
        }
        if (wr == 0) PG8_BAR;
        { Unit eu = cur; int efr = fr, efq = fq; asm volatile("" : "+s"(eu.pm), "+s"(eu.pn), "+s"(eu.split), "+s"(eu.part), "+v"(efr), "+v"(efq));
          E(acc, eu, wr, wc, efr, efq); }
        if (!has_next) break;
#pragma unroll
        for (int a = 0; a < 2; ++a)
#pragma unroll
            for (int b = 0; b < 2; ++b)
#pragma unroll
                for (int m = 0; m < 4; ++m)
#pragma unroll
                    for (int n = 0; n < 2; ++n) acc[a][b][m][n] = (f32x4){0.f, 0.f, 0.f, 0.f};
        cur = nxt; cA = nA; cB = nB; ++ui;
        if constexpr (GATHER) {
#pragma unroll
            for (int h = 0; h < 2; ++h)
#pragma unroll
                for (int i = 0; i < 2; ++i) cva[h][i] = nva[h][i]; }
        if (wr == 1) PG8_BAR;
    }
    PG8_WAIT_V(0);
    PG8_BAR;
#undef PG8_SA
#undef PG8_SB
#undef PG8_STAGE
#undef PG8_STAGE_A
#undef PG8_LDA
#undef PG8_LDB
#undef PG8_MMA
#undef PG8_WAIT_V
#undef PG8_WAIT_L
#undef PG8_BAR
#undef PG8_SCHED
}

struct EpiStoreBf16 {
    static constexpr bool PERM = true;
    bf16* O; int ldc;
    __device__ __forceinline__ void operator()(const f32x4 (&acc)[2][2][4][2], const Unit& u, int wr, int wc, int fr, int fq) const {
        const int row0 = u.pm * BM + wr * 64 + fr, col0 = u.pn * BM + wc * 32 + 8 * fq;
#pragma unroll
        for (int ai = 0; ai < 2; ++ai)
#pragma unroll
            for (int m = 0; m < 4; ++m) { bf16* rowp = O + (size_t)(row0 + ai * HALF + m * 16) * ldc + col0;
#pragma unroll
                for (int bj = 0; bj < 2; ++bj) { const f32x4 v0 = acc[ai][bj][m][0], v1 = acc[ai][bj][m][1];
                    u32x4 w; w.x = cvt_pk_bf16(v0[0], v0[1]); w.y = cvt_pk_bf16(v0[2], v0[3]); w.z = cvt_pk_bf16(v1[0], v1[1]); w.w = cvt_pk_bf16(v1[2], v1[3]);
                    *(u32x4*)(rowp + bj * HALF) = w; } }
    }
};
struct EpiSwiglu {
    static constexpr bool PERM = true;
    bf16* O; int ldc;
    __device__ __forceinline__ void operator()(const f32x4 (&acc)[2][2][4][2], const Unit& u, int wr, int wc, int fr, int fq) const {
        const int row0 = u.pm * BM + wr * 64 + fr, col0 = u.pn * HALF + wc * 32 + 8 * fq;
#pragma unroll
        for (int ai = 0; ai < 2; ++ai)
#pragma unroll
            for (int m = 0; m < 4; ++m) { bf16* rowp = O + (size_t)(row0 + ai * HALF + m * 16) * ldc + col0;
                float t[8];
#pragma unroll
                for (int n = 0; n < 2; ++n)
#pragma unroll
                    for (int j = 0; j < 4; ++j) t[4 * n + j] = silu_f(acc[ai][0][m][n][j]) * acc[ai][1][m][n][j];
                *(u32x4*)rowp = pack8(t); }
    }
};
struct EpiResid {
    static constexpr bool PERM = false;
    const float* xbase; float* xout; const float* cbase; float* cout; const float* gate; float* slab;
    __device__ __forceinline__ void operator()(const f32x4 (&acc)[2][2][4][2], const Unit& u, int wr, int wc, int fr, int fq) const {
        const float* base; float* out; const float* g;
        if (u.pm < RX / 256) { base = xbase + (size_t)u.pm * 256 * D; out = xout + (size_t)u.pm * 256 * D; g = gate + (size_t)(u.pm >> 3) * 6144; }
        else { const int pc = u.pm - RX / 256; base = cbase + (size_t)pc * 256 * D; out = cout + (size_t)pc * 256 * D; g = gate + (size_t)16 * 6144; }
        const int col0 = u.pn * BM + wc * 32 + 4 * fq;
        f32x4 gv[2][2];
#pragma unroll
        for (int bj = 0; bj < 2; ++bj)
#pragma unroll
            for (int n = 0; n < 2; ++n) gv[bj][n] = *(const f32x4*)(g + col0 + bj * HALF + n * 16);
#pragma unroll
        for (int ai = 0; ai < 2; ++ai)
#pragma unroll
            for (int m = 0; m < 4; ++m) { const size_t off = (size_t)(wr * 64 + fr + ai * HALF + m * 16) * D + col0;
#pragma unroll
                for (int bj = 0; bj < 2; ++bj)
#pragma unroll
                    for (int n = 0; n < 2; ++n) { const f32x4 v = gv[bj][n] * acc[ai][bj][m][n]; float* o = out + off + bj * HALF + n * 16;
                        if (u.split) *(f32x4*)(slab + ((size_t)(((u.pm - RX / 256) * 4 + u.pn) * FFN_P + u.part) << 16) + (size_t)(wr * 64 + fr + ai * HALF + m * 16) * 256 + wc * 32 + 4 * fq + bj * HALF + n * 16) = v;
                        else { const f32x4 bs = *(const f32x4*)(base + off + bj * HALF + n * 16); *(f32x4*)o = bs + v; } } }
    }
};
}


namespace g8 {
constexpr int TA = 32768, TB = 32768, STG = TA + TB, NSTG = 2;
struct Unit { const char* a; const char* b; int row0, k, pn, nt, split, part; };
__device__ __forceinline__ const char* uptr(const char* p) { const unsigned long long v = (unsigned long long)p; const unsigned lo = __builtin_amdgcn_readfirstlane((unsigned)v), hi = __builtin_amdgcn_readfirstlane((unsigned)(v >> 32)); return (const char*)(((unsigned long long)hi << 32) | lo); }

struct Sched {
    int pre0[9], pre1[9]; int k0, npass, nN, G, c, nt, P; const char* Abase; size_t arow;   size_t apass; const char* Wbase; size_t wstride, tstepB;
    __device__ __forceinline__ bool next(int i, Unit& u) const {
        long L = (long)i * G + c; int k = k0;
        const int nm0 = (k0 == 0 ? pre0[8] : pre1[8]);
        if (P == 1 && L >= (long)nm0 * nN) { if (npass < 2) return false; L -= (long)nm0 * nN; k = 1; if (L >= (long)pre1[8] * nN) return false; }
        const int nm = (k == 0 ? pre0[8] : pre1[8]);
        int pm, pn, kt0 = 0; u.split = 0; u.part = 0; u.nt = nt;
        if (P > 1) {
            if (L < 128 * nN) pg8::tile_map((int)L, 128, nN, pm, pn);
            else { const int Lt = (int)L - 128 * nN; if (Lt >= (nm - 128) * nN * P) return false; const int tile = Lt / P; pm = 128 + tile / nN; pn = tile % nN; u.part = Lt % P; u.split = 1; u.nt = nt / P; kt0 = u.part * (nt / P); }
        } else pg8::tile_map((int)L, nm, nN, pm, pn);
        int e = 0;
#pragma unroll
        for (int j = 1; j < 8; ++j) e += (pm >= (k == 0 ? pre0[j] : pre1[j])) ? 1 : 0;
        u.row0 = pm * 256; u.k = k; u.pn = pn;
        u.a = Abase + (size_t)k * apass + (size_t)u.row0 * arow + (size_t)kt0 * 128; u.b = Wbase + (size_t)e * wstride + (size_t)pn * tstepB + (size_t)kt0 * 128; return true;
    }
};

struct SchedD {
    int nMw, nN, nMt, G, c, nt, P; const char* A; size_t tstepA; const char* W; size_t tstepB;
    __device__ __forceinline__ bool next(int i, Unit& u) const {
        const long L = (long)i * G + c; int pm, pn, kt0 = 0; u.split = 0; u.part = 0; u.nt = nt; u.k = 0;
        if (L < (long)nMw * nN) pg8::tile_map((int)L, nMw, nN, pm, pn);
        else { const int Lt = (int)(L - (long)nMw * nN); if (Lt >= nMt * nN * P) return false; const int tile = Lt / P, part = Lt % P, base = nt / P, rem = nt % P;
            pm = nMw + tile / nN; pn = tile % nN; u.part = part; u.split = 1; u.nt = base + (part < rem ? 1 : 0); kt0 = part * base + (part < rem ? part : rem); }
        u.row0 = pm * 256; u.pn = pn; u.a = A + (size_t)pm * tstepA + (size_t)kt0 * 128; u.b = W + (size_t)pn * tstepB + (size_t)kt0 * 128; return true;
    }
};

template <class Epi, class Sched, bool GATHER>
__device__ __forceinline__ void gemm8_phase(LAS unsigned char* lds, const int rowbytes, const Sched& S, const Epi& E, const int* rowtok  , int tid) {
    asm volatile("" : "+v"(tid));
    const int wave = __builtin_amdgcn_readfirstlane(tid >> 6), lane = tid & 63, wr = wave >> 2, wc = wave & 3, i16 = lane & 15, q = lane >> 4;
    const int srow = tid >> 3, cpos = tid & 7;
    const unsigned soff = 16u * (unsigned)(cpos ^ (srow & 7));
    const unsigned voffB = (unsigned)srow * (unsigned)rowbytes + soff;
    unsigned voffA[4] = {voffB, voffB + 64u * (unsigned)rowbytes, voffB + 128u * (unsigned)rowbytes, voffB + 192u * (unsigned)rowbytes};
    const unsigned ldsw = (unsigned)wave * 1024u;
    const int swz = i16 & 7;
    const unsigned c0 = 16u * (unsigned)(q ^ swz), c1 = 16u * (unsigned)((4 + q) ^ swz);
    const unsigned ard = (unsigned)((128 * wr + i16) * 128), brd = (unsigned)(TA + (64 * wc + i16) * 128);
    Unit cu, su, nu;
    if (!S.next(0, cu)) return;
    su = cu; int si = 0, skt = 0; bool s_valid = true; bool n_valid = S.next(1, nu);
    unsigned gnext[4] = {0u, 0u, 0u, 0u};
    int issued = 0, pos = 0;
#define G8_GATHER(U, DST) do { if constexpr (GATHER) { _Pragma("unroll") for (int _j = 0; _j < 4; ++_j) { int tk = rowtok[(U).k * MOE_ROWS + (U).row0 + srow + 64 * _j]; tk = tk < 0 ? 0 : tk; DST[_j] = (unsigned)tk * (unsigned)rowbytes + soff; } } } while (0)
#define G8_STAGE() do { const int _sb = issued & 1; const char* _a = uptr(su.a + (size_t)skt * 128); const char* _b = uptr(su.b + (size_t)skt * 128); \
        _Pragma("unroll") for (int _j = 0; _j < 4; ++_j) __builtin_amdgcn_global_load_lds((const unsigned*)(_a + voffA[_j]), (LAS unsigned*)(lds + _sb * STG + _j * 8192 + ldsw), 16, 0, 0); \
        _Pragma("unroll") for (int _j = 0; _j < 4; ++_j) __builtin_amdgcn_global_load_lds((const unsigned*)(_b + voffB + (unsigned)(64 * _j) * (unsigned)rowbytes), (LAS unsigned*)(lds + _sb * STG + TA + _j * 8192 + ldsw), 16, 0, 0); \
        ++issued; if (++skt == su.nt) { skt = 0; ++si; su = nu; s_valid = n_valid; if constexpr (GATHER) { _Pragma("unroll") for (int _j = 0; _j < 4; ++_j) voffA[_j] = gnext[_j]; } \
            n_valid = s_valid && S.next(si + 1, nu); if (n_valid) G8_GATHER(nu, gnext); } } while (0)
    G8_GATHER(su, voffA);
    if (n_valid) G8_GATHER(nu, gnext);
    G8_STAGE();
    f32x4 acc[8][4];
    int ci = 0;
    for (;;) {
#pragma unroll
        for (int m = 0; m < 8; ++m)
#pragma unroll
            for (int n = 0; n < 4; ++n) acc[m][n] = (f32x4){0.f, 0.f, 0.f, 0.f};
#pragma unroll 1
        for (int kt = 0; kt < cu.nt; ++kt) {
            asm volatile("s_waitcnt vmcnt(0)" ::: "memory");
            __builtin_amdgcn_s_barrier();
            asm volatile("" ::: "memory");
#if G8_PIPE
            const LAS unsigned char* sb = lds + (pos & 1) * STG;
            i32x8 bf[4], a0[2], a1[2];
#define G8_RDA(dst, m0) do { _Pragma("unroll") for (int _m = 0; _m < 2; ++_m) { dst[_m].lo = *(const LAS i32x4*)(sb + ard + ((m0) + _m) * 2048 + c0); dst[_m].hi = *(const LAS i32x4*)(sb + ard + ((m0) + _m) * 2048 + c1); } } while (0)
#define G8_MM(src, m0) do { _Pragma("unroll") for (int _m = 0; _m < 2; ++_m) _Pragma("unroll") for (int n = 0; n < 4; ++n) \
                acc[(m0) + _m][n] = __builtin_amdgcn_mfma_scale_f32_16x16x128_f8f6f4(bf[n], src[_m], acc[(m0) + _m][n], 0, 0, 0, 0x7f7f7f7f, 0, 0x7f7f7f7f); } while (0)
#define G8_PIN(m0) do { _Pragma("unroll") for (int _m = 0; _m < 2; ++_m) _Pragma("unroll") for (int n = 0; n < 4; ++n) asm volatile("" : "+v"(acc[(m0) + _m][n])); } while (0)
#define G8_RD0() do { _Pragma("unroll") for (int n = 0; n < 4; ++n) { bf[n].lo = *(const LAS i32x4*)(sb + brd + n * 2048 + c0); bf[n].hi = *(const LAS i32x4*)(sb + brd + n * 2048 + c1); } \
                G8_RDA(a0, 0); __builtin_amdgcn_sched_barrier(0); G8_RDA(a1, 2); __builtin_amdgcn_sched_barrier(0); } while (0)
#if G8_W0_RFIRST
            G8_RD0();
            if (wr == 0 && s_valid) G8_STAGE();
            __builtin_amdgcn_sched_barrier(0);
#else
            if (wr == 0 && s_valid) G8_STAGE();
            __builtin_amdgcn_sched_barrier(0);
            G8_RD0();
#endif
            __builtin_amdgcn_s_setprio(1);
            G8_MM(a0, 0);
            __builtin_amdgcn_sched_barrier(0);
#if G8_W1_DPOS == 1
            G8_PIN(0);
            __builtin_amdgcn_s_setprio(0);
            if (wr == 1 && s_valid) G8_STAGE();
            __builtin_amdgcn_s_waitcnt(0xc07f);
            __builtin_amdgcn_sched_barrier(0);
            __builtin_amdgcn_s_setprio(1);
#endif
            G8_RDA(a0, 4);
            __builtin_amdgcn_sched_barrier(0);
            G8_MM(a1, 2);
            __builtin_amdgcn_sched_barrier(0);
            G8_PIN(2);
            G8_RDA(a1, 6);
            __builtin_amdgcn_sched_barrier(0);
#if G8_W1_DPOS == 2
            G8_PIN(0);
            __builtin_amdgcn_s_setprio(0);
            if (wr == 1 && s_valid) G8_STAGE();
            __builtin_amdgcn_sched_barrier(0);
            __builtin_amdgcn_s_setprio(1);
#endif
            G8_MM(a0, 4);
            __builtin_amdgcn_sched_barrier(0);
            G8_MM(a1, 6);
            __builtin_amdgcn_s_setprio(0);
            __builtin_amdgcn_sched_barrier(0);
#undef G8_RD0
#undef G8_PIN
#undef G8_RDA
#undef G8_MM
#else
            if (s_valid) G8_STAGE();
            const LAS unsigned char* sb = lds + (pos & 1) * STG;
            i32x8 af[4], bf[4];
#pragma unroll
            for (int n = 0; n < 4; ++n) { bf[n].lo = *(const LAS i32x4*)(sb + brd + n * 2048 + c0); bf[n].hi = *(const LAS i32x4*)(sb + brd + n * 2048 + c1); }
#pragma unroll
            for (int mh = 0; mh < 2; ++mh) {
#pragma unroll
                for (int m = 0; m < 4; ++m) { af[m].lo = *(const LAS i32x4*)(sb + ard + (4 * mh + m) * 2048 + c0); af[m].hi = *(const LAS i32x4*)(sb + ard + (4 * mh + m) * 2048 + c1); }
                asm volatile("s_waitcnt lgkmcnt(0)" ::: "memory");
                __builtin_amdgcn_s_setprio(1);
#pragma unroll
                for (int m = 0; m < 4; ++m)
#pragma unroll
                    for (int n = 0; n < 4; ++n) acc[4 * mh + m][n] = __builtin_amdgcn_mfma_scale_f32_16x16x128_f8f6f4(bf[n], af[m], acc[4 * mh + m][n], 0, 0, 0, 0x7f7f7f7f, 0, 0x7f7f7f7f);
                __builtin_amdgcn_s_setprio(0);
                __builtin_amdgcn_sched_barrier(0);
            }
#endif
            ++pos;
        }
        { Unit eu = cu; eu.row0 = __builtin_amdgcn_readfirstlane(cu.row0); eu.k = __builtin_amdgcn_readfirstlane(cu.k); eu.pn = __builtin_amdgcn_readfirstlane(cu.pn); eu.split = __builtin_amdgcn_readfirstlane(cu.split); eu.part = __builtin_amdgcn_readfirstlane(cu.part); int ej = i16, eq = q; asm volatile("" : "+v"(ej), "+v"(eq)); E(acc, eu, wr, wc, ej, eq); }
        ++ci; if (!S.next(ci, cu)) break;
    }
    asm volatile("s_waitcnt vmcnt(0)" ::: "memory");
    __builtin_amdgcn_s_barrier();
#undef G8_GATHER
#undef G8_STAGE
}

template <int LD>
struct EpiSwiglu8 {
    unsigned char* T; float s;
    __device__ __forceinline__ void operator()(const f32x4 (&acc)[8][4], const Unit& u, int wr, int wc, int j, int q) const {
        unsigned char* base = T + ((size_t)u.k * MOE_ROWS + u.row0 + 128 * wr + j) * LD + u.pn * 128 + 32 * wc + 8 * q;
#pragma unroll
        for (int m = 0; m < 8; ++m) { float t[8];
#pragma unroll
            for (int n = 0; n < 2; ++n)
#pragma unroll
                for (int r = 0; r < 4; ++r) t[4 * n + r] = silu_f(acc[m][n][r] * s) * (acc[m][n + 2][r] * s);
            u32x2 w; w.x = pk4_fp8(t[0], t[1], t[2], t[3]); w.y = pk4_fp8(t[4], t[5], t[6], t[7]); *(u32x2*)(base + (size_t)(16 * m) * LD) = w; }
    }
};
struct EpiMoeDown8 {
    const int* rowtok; const float* rowp; const float* gate; float* out; float s; bf16* slab0; bf16* slab1;
    __device__ __forceinline__ void operator()(const f32x4 (&acc)[8][4], const Unit& u, int wr, int wc, int j, int q) const {
        const int col0 = u.pn * 256 + 64 * wc + 4 * q;
        bf16* sl = (u.k == 0 ? slab0 : slab1) + ((size_t)((((u.row0 >> 8) - 128) * 4 + u.pn) * MOE_P + u.part) << 16) + 64 * wc + 4 * q;
#pragma unroll
        for (int m = 0; m < 8; ++m) { const int rit = 128 * wr + 16 * m + j, slot = u.k * MOE_ROWS + u.row0 + rit; const int tok = rowtok[slot];
            if (tok >= 0) { const float p = rowp[slot] * s; const float* g = gate + (size_t)(tok >> 11) * 6144 + col0; float* o = out + (size_t)tok * D + col0;
#pragma unroll
                for (int n = 0; n < 4; ++n) { const f32x4 gv = *(const f32x4*)(g + 16 * n); const f32x4 v = (gv * p) * acc[m][n];
                    if (u.split) { u32x2 w; w.x = cvt_pk_bf16(v[0], v[1]); w.y = cvt_pk_bf16(v[2], v[3]); *(u32x2*)(sl + (size_t)rit * 256 + 16 * n) = w; }
                    else { const f32x4 bs = *(const f32x4*)(o + 16 * n); *(f32x4*)(o + 16 * n) = bs + v; } } }
            __builtin_amdgcn_sched_barrier(0); }
    }
};
struct EpiResid8 {
    float* xio; float* cio; const float* gate; float* slab; float s;
    __device__ __forceinline__ void operator()(const f32x4 (&acc)[8][4], const Unit& u, int wr, int wc, int j, int q) const {
        const int pm = u.row0 >> 8; float* io; const float* g;
        if (pm < RX / 256) { io = xio + (size_t)u.row0 * D; g = gate + (size_t)(pm >> 3) * 6144; } else { io = cio + (size_t)(u.row0 - RX) * D; g = gate + (size_t)16 * 6144; }
        const int col0 = u.pn * 256 + 64 * wc + 4 * q;
        f32x4 gv[4];
#pragma unroll
        for (int n = 0; n < 4; ++n) gv[n] = *(const f32x4*)(g + col0 + 16 * n) * s;
        float* sl = slab + ((size_t)(((pm - RX / 256) * 4 + u.pn) * FFN_P + u.part) << 16) + 64 * wc + 4 * q;
#pragma unroll
        for (int m = 0; m < 8; ++m) { const int rit = 128 * wr + 16 * m + j; float* o = io + (size_t)rit * D + col0;
#pragma unroll
            for (int n = 0; n < 4; ++n) { const f32x4 v = gv[n] * acc[m][n];
                if (u.split) *(f32x4*)(sl + (size_t)rit * 256 + 16 * n) = v;
                else { const f32x4 bs = *(const f32x4*)(o + 16 * n); *(f32x4*)(o + 16 * n) = bs + v; } }
            __builtin_amdgcn_sched_barrier(0); }
    }
};
}

struct Args { const float* in[33]; float* out; unsigned char* ws; int ph_lo, ph_hi; };
enum { I_X = 0, I_C, I_CTX, I_CCTX, I_MODW, I_MODB, I_N1G, I_N2G, I_WIN, I_WOUT, I_SCW, I_SCB, I_DTB, I_ALOG, I_SSDD, I_SNG, I_GNG, I_GNB, I_GWS, I_GBS, I_SCCW, I_CFW, I_CFB, I_CFG, I_CFNB,
       I_F1, I_F3, I_F2, I_RT, I_M1, I_M3, I_M2, I_FNG };
typedef const __attribute__((address_space(4))) Args* ArgsP;
struct Frame { LAS unsigned char* lds; int tid, lane, wave, vcu, G; unsigned char* ws; };

__device__ __forceinline__ void conv_job(const Frame& F, const float* W, int ldw, int K, int c0, int ncols, bf16* WT, int rowbase, int blk, int blkstride) {
    LAS float* scr = (LAS float*)(F.lds + F.wave * 16384);
    const int gw = F.vcu * 8 + F.wave, NGW = F.G * 8, lane = F.lane;
    const int nblk = ncols / 32, nitems = (K / 64) * nblk;
    for (int it = gw; it < nitems; it += NGW) {
        const int kb = it / nblk, nb = it % nblk, k0 = 64 * kb, n0 = 32 * nb;
        const int drow0 = rowbase + (n0 / blk) * blkstride + (n0 % blk);
#pragma unroll 8
        for (int i = 0; i < 32; ++i) { const int kk = 2 * i + (lane >> 5); scr[kk * 33 + (lane & 31)] = W[(size_t)(k0 + kk) * ldw + c0 + n0 + (lane & 31)]; }
        asm volatile("s_waitcnt lgkmcnt(0)" ::: "memory");
        const int c = lane & 7;
#pragma unroll
        for (int j = 0; j < 4; ++j) { const int n = (lane >> 3) + 8 * j; const LAS float* s = scr + (8 * c) * 33 + n;
            u32x4 o; o.x = cvt_pk_bf16(s[0 * 33], s[1 * 33]); o.y = cvt_pk_bf16(s[2 * 33], s[3 * 33]); o.z = cvt_pk_bf16(s[4 * 33], s[5 * 33]); o.w = cvt_pk_bf16(s[6 * 33], s[7 * 33]);
            *(u32x4*)(WT + (size_t)(drow0 + n) * K + k0 + 8 * c) = o; }
        asm volatile("s_waitcnt lgkmcnt(0)" ::: "memory");
    }
}

__device__ __forceinline__ void conv_job8(const Frame& F, const float* W, int ldw, int K, int ncols, unsigned char* WT, int mode, int half, float scale) {
    LAS float* scr = (LAS float*)(F.lds + F.wave * 16384);
    const int gw = F.vcu * 8 + F.wave, NGW = F.G * 8, lane = F.lane;
    const int nblk = ncols / 32, nitems = (K / 64) * nblk;
    for (int it = gw; it < nitems; it += NGW) {
        const int kb = it / nblk, nb = it % nblk, k0 = 64 * kb, n0 = 32 * nb;
#pragma unroll 8
        for (int i = 0; i < 32; ++i) { const int kk = 2 * i + (lane >> 5); scr[kk * 33 + (lane & 31)] = W[(size_t)(k0 + kk) * ldw + n0 + (lane & 31)] * scale; }
        asm volatile("s_waitcnt lgkmcnt(0)" ::: "memory");
        const int c = lane & 3;
#pragma unroll
        for (int jj = 0; jj < 2; ++jj) { const int n = (lane >> 2) + 16 * jj; const LAS float* sp = scr + (16 * c) * 33 + n;
            const int drow = mode == 0 ? n0 + n : (n0 >> 7) * 256 + ((n0 & 127) >> 5) * 64 + half * 32 + (16 * ((n >> 2) & 1) + 4 * (n >> 3) + (n & 3));
            u32x4 o; o.x = pk4_fp8(sp[0 * 33], sp[1 * 33], sp[2 * 33], sp[3 * 33]); o.y = pk4_fp8(sp[4 * 33], sp[5 * 33], sp[6 * 33], sp[7 * 33]);
            o.z = pk4_fp8(sp[8 * 33], sp[9 * 33], sp[10 * 33], sp[11 * 33]); o.w = pk4_fp8(sp[12 * 33], sp[13 * 33], sp[14 * 33], sp[15 * 33]);
            *(u32x4*)(WT + (size_t)drow * K + k0 + 16 * c) = o; }
        asm volatile("s_waitcnt lgkmcnt(0)" ::: "memory");
    }
}

__device__ __forceinline__ void p0_prologue(const Frame& F, ArgsP a) {
    unsigned char* ws = F.ws;
    if (F.vcu < 192) {
        LAS float* sc = (LAS float*)F.lds;
        LAS float* red = sc + 17 * 1024;
        for (int i = F.tid; i < 17 * 1024; i += 512) { const int b = i >> 10, k = i & 1023; const float v = b < 16 ? a->in[I_C][b * 1024 + k] : a->in[I_CCTX][k]; sc[i] = silu_f(v); }
        __syncthreads();
        float* modv = (float*)(ws + WS_MODV);
        for (int item = F.vcu; item < 192; item += F.G) {
            const int l = item / 96, cb = item % 96, col = cb * 64 + F.lane;
            const float* W = a->in[I_MODW] + (size_t)l * 1024 * 6144 + col;
            float acc[17];
#pragma unroll
            for (int b = 0; b < 17; ++b) acc[b] = 0.f;
            for (int k = F.wave * 128; k < F.wave * 128 + 128; ++k) { const float w = W[(size_t)k * 6144];
#pragma unroll
                for (int b = 0; b < 17; ++b) acc[b] += sc[b * 1024 + k] * w; }
#pragma unroll
            for (int b = 0; b < 17; ++b) red[(F.wave * 17 + b) * 64 + F.lane] = acc[b];
            __syncthreads();
            for (int o = F.tid; o < 17 * 64; o += 512) { const int b = o >> 6, ln = o & 63; float s = a->in[I_MODB][l * 6144 + cb * 64 + ln];
#pragma unroll
                for (int w = 0; w < 8; ++w) s += red[(w * 17 + b) * 64 + ln];
                modv[(size_t)(l * 17 + b) * 6144 + cb * 64 + ln] = s; }
            __syncthreads();
        }
    }
    __syncthreads();
    for (int l = 0; l < 2; ++l) {
        const float* win = a->in[I_WIN] + (size_t)l * D * INC; bf16* wt = (bf16*)(ws + WS_WIN) + (size_t)l * ZC * D;
        conv_job(F, win, INC, D, 0, 768, wt, 0, 1 << 30, 0);
        conv_job(F, win, INC, D, 776, 2048, wt, 768, 1 << 30, 0);
        conv_job(F, a->in[I_WOUT] + (size_t)l * D * D, D, D, 0, D, (bf16*)(ws + WS_WOUT) + (size_t)l * D * D, 0, 1 << 30, 0);
    }
#if FFN8
    conv_job8(F, a->in[I_F1], DFF, D, DFF, ws + WS_WUP, 1, 0, 64.0f);
    conv_job8(F, a->in[I_F3], DFF, D, DFF, ws + WS_WUP, 1, 1, 64.0f);
    conv_job8(F, a->in[I_F2], D, DFF, D, ws + WS_WDN, 0, 0, 64.0f);
#else
    conv_job(F, a->in[I_F1], DFF, D, 0, DFF, (bf16*)(ws + WS_WUP), 0, 128, 256);
    conv_job(F, a->in[I_F3], DFF, D, 0, DFF, (bf16*)(ws + WS_WUP), 128, 128, 256);
    conv_job(F, a->in[I_F2], D, DFF, 0, D, (bf16*)(ws + WS_WDN), 0, 1 << 30, 0);
#endif
    int* rowtok = (int*)(ws + WS_ROWTOK);
    for (int i = F.vcu * 512 + F.tid; i < 2 * MOE_ROWS; i += F.G * 512) rowtok[i] = -1;
    for (int i = F.vcu * 512 + F.tid; i < 2 * 4 * 128 * 128 / 2; i += F.G * 512) { const f32x2 v = *(const f32x2*)(a->in[I_GWS] + 2 * i); ((unsigned*)(ws + WS_WSB))[i] = cvt_pk_bf16(v[0], v[1]); }
}
__device__ __forceinline__ void moe_convert(const Frame& F, ArgsP a) {
    for (int e = 0; e < NE; ++e) {
        unsigned char* up = F.ws + WS_WMUP + (size_t)e * 2 * EFF * D;
        conv_job8(F, a->in[I_M1] + (size_t)e * D * EFF, EFF, D, EFF, up, 1, 0, 64.0f);
        conv_job8(F, a->in[I_M3] + (size_t)e * D * EFF, EFF, D, EFF, up, 1, 1, 64.0f);
        conv_job8(F, a->in[I_M2] + (size_t)e * EFF * D, D, EFF, D, F.ws + WS_WMDN + (size_t)e * D * EFF, 0, 0, 64.0f);
    }
}

template <int MODE>
__device__ __forceinline__ void norm_phase(const Frame& F, ArgsP a, int l, int nrows, const float* xsrc, const float* csrc, const float* gain, int slot_shift, int slot_scale, const float* fslab = nullptr) {
    unsigned char* ws = F.ws;
    LAS float* wx = (LAS float*)F.lds;
    LAS int* hist = (LAS int*)(F.lds + 8 * 1024 * 4);
    if (MODE == 0 || MODE == 2) {
        for (int i = F.tid; i < 8192; i += 512) { const int k = i >> 3, j = i & 7; wx[j * 1024 + k] = (MODE == 0) ? a->in[I_WIN][(size_t)l * D * INC + (size_t)k * INC + 768 + j] : a->in[I_RT][k * 8 + j]; }
        if (F.tid < 16) hist[F.tid] = 0;
        __syncthreads();
    }
    const float* modv = (const float*)(ws + WS_MODV) + (size_t)l * 17 * 6144;
    bf16* H = (bf16*)(ws + WS_H);
    const int gw = F.vcu * 8 + F.wave, NGW = F.G * 8, lane = F.lane;
    f32x4 gv[4];
#pragma unroll
    for (int j = 0; j < 4; ++j) gv[j] = *(const f32x4*)(gain + 4 * lane + 256 * j);
    for (int r = gw; r < nrows; r += NGW) {
        const float* xr; int mb;
        if (r < RX) { xr = xsrc + (size_t)r * D; mb = r >> 11; } else { xr = csrc + (size_t)(r - RX) * D; mb = 16; }
        const float* mv = modv + (size_t)mb * 6144;
        f32x4 v[4]; float ss = 0.f;
#pragma unroll
        for (int j = 0; j < 4; ++j) { v[j] = *(const f32x4*)(xr + 4 * lane + 256 * j);
            if (fslab != nullptr && r >= RX) {
#pragma unroll
                for (int part = 0; part < FFN_P; ++part) v[j] += *(const f32x4*)(fslab + ((size_t)((((r - RX) >> 8) * 4 + j) * FFN_P + part) << 16) + (size_t)((r - RX) & 255) * 256 + 4 * lane); }
            ss += (v[j][0] * v[j][0] + v[j][1] * v[j][1]) + (v[j][2] * v[j][2] + v[j][3] * v[j][3]); }
        const float rstd = 1.0f / sqrtf(wave_sum(ss) * (1.0f / D) + 1e-6f);
        float e[8];
#pragma unroll
        for (int q = 0; q < 8; ++q) e[q] = 0.f;
#pragma unroll
        for (int j = 0; j < 4; ++j) {
            const f32x4 sh = *(const f32x4*)(mv + slot_shift * 1024 + 4 * lane + 256 * j), sc = *(const f32x4*)(mv + slot_scale * 1024 + 4 * lane + 256 * j);
            const f32x4 hv = (v[j] * rstd) * gv[j] * (sc + 1.0f) + sh;
            if (MODE >= 2) *(unsigned*)((unsigned char*)H + (size_t)r * D + 4 * lane + 256 * j) = pk4_fp8(hv[0], hv[1], hv[2], hv[3]);
            else { u32x2 w; w.x = cvt_pk_bf16(hv[0], hv[1]); w.y = cvt_pk_bf16(hv[2], hv[3]); *(u32x2*)(H + (size_t)r * D + 4 * lane + 256 * j) = w; }
            if (MODE == 0 || MODE == 2) {
#pragma unroll
                for (int q = 0; q < 8; ++q) { const f32x4 wv = *(const LAS f32x4*)(wx + q * 1024 + 4 * lane + 256 * j); e[q] += (hv[0] * wv[0] + hv[1] * wv[1]) + (hv[2] * wv[2] + hv[3] * wv[3]); }
            }
        }
        if (MODE == 0) {
#pragma unroll
            for (int q = 0; q < 8; ++q) e[q] = wave_sum(e[q]);
            float mine = 0.f;
#pragma unroll
            for (int q = 0; q < 8; ++q) mine = (lane == q) ? e[q] : mine;
            if (lane < 8) ((float*)(ws + WS_DT))[(size_t)r * 8 + lane] = softplus_f(mine + a->in[I_DTB][l * 8 + lane]);
        }
        if (MODE == 2) {
#pragma unroll
            for (int q = 0; q < 8; ++q) e[q] = wave_sum(e[q]);
            int i0 = 0; float v0 = e[0];
#pragma unroll
            for (int q = 1; q < 8; ++q) if (e[q] > v0) { v0 = e[q]; i0 = q; }
            int i1 = -1; float v1 = -3.0e38f;
#pragma unroll
            for (int q = 0; q < 8; ++q) if (q != i0 && e[q] > v1) { v1 = e[q]; i1 = q; }
            const float p0 = 1.0f / (1.0f + __expf(v1 - v0)), p1 = 1.0f - p0;
            if (lane == 0) { int* te = (int*)(ws + WS_TOPE) + (size_t)r * 2; te[0] = i0; te[1] = i1; float* tp = (float*)(ws + WS_TOPP) + (size_t)r * 2; tp[0] = p0; tp[1] = p1;
                __hip_atomic_fetch_add(&hist[i0], 1, __ATOMIC_RELAXED, __HIP_MEMORY_SCOPE_WORKGROUP); __hip_atomic_fetch_add(&hist[8 + i1], 1, __ATOMIC_RELAXED, __HIP_MEMORY_SCOPE_WORKGROUP); }
        }
    }
    if (MODE == 2) {
        __syncthreads();
        if (F.tid < 16 && hist[F.tid] != 0) atomicAdd((unsigned*)(ws + WS_CTL) + CW_CNT + F.tid, (unsigned)hist[F.tid]);
    }
    __syncthreads();
}

__device__ __forceinline__ void chunk_geom(int c, int& r0, int& seq_lo, int& seq_hi) {
    r0 = c * 128;
    if (c < NCHX) { seq_lo = (c >> 4) * SEQ; seq_hi = seq_lo + SEQ; } else { seq_lo = RX + ((c - NCHX) >> 1) * CTXL; seq_hi = seq_lo + CTXL; }
}

template <int PART>
__device__ __forceinline__ void a1_item(const Frame& F, ArgsP a, int l, int c) {
    unsigned char* ws = F.ws;
    const bf16* Z = (const bf16*)(ws + WS_Z); bf16* XBC = (bf16*)(ws + WS_XBC); bf16* XT = (bf16*)(ws + WS_XT);
    const float* DT = (const float*)(ws + WS_DT); float* ACS = (float*)(ws + WS_ACS); float* ST = (float*)(ws + WS_ST);
    const float* scw = a->in[I_SCW] + (size_t)l * 5 * 768; const float* scb = a->in[I_SCB] + (size_t)l * 768;
    LAS bf16* RAW = (LAS bf16*)F.lds;
    LAS bf16* BT = (LAS bf16*)(F.lds + 33792);
    LAS bf16* XF = (LAS bf16*)(F.lds + 68608);
    LAS bf16* XB = (LAS bf16*)(F.lds + 103424);
    LAS float* wts = (LAS float*)(F.lds + 138240);
    int lane = F.lane; asm volatile("" : "+v"(lane)); const int wave = F.wave, tid = wave * 64 + lane, lj = lane & 15, lq = lane >> 4;
    int r0, slo, shi; chunk_geom(c, r0, slo, shi);
    __syncthreads();
    if (PART < 2 && wave < 4) {
        const int h = 2 * PART + (wave >> 1), dir = wave & 1; const float av = -__expf(a->in[I_ALOG][l * 8 + dir * 4 + h]);
        const int la = dir == 0 ? 2 * lane : 127 - 2 * lane, lb = dir == 0 ? 2 * lane + 1 : 126 - 2 * lane;
        const float da = DT[(size_t)(r0 + la) * 8 + dir * 4 + h], db = DT[(size_t)(r0 + lb) * 8 + dir * 4 + h];
        const float s0 = av * da, s1 = s0 + av * db;
        float inc = s1;
#pragma unroll
        for (int o = 1; o < 64; o <<= 1) { const float t = __shfl_up(inc, o); if (lane >= o) inc += t; }
        const float pre = inc - s1, ca = pre + s0, cb = pre + s1, tot = __shfl(inc, 63);
        ACS[(size_t)(r0 + la) * 8 + dir * 4 + h] = ca; ACS[(size_t)(r0 + lb) * 8 + dir * 4 + h] = cb;
        wts[(h * 2 + dir) * 128 + la] = __expf(tot - ca) * da; wts[(h * 2 + dir) * 128 + lb] = __expf(tot - cb) * db;
    }
    if (PART < 2) { const int g = PART;
#pragma unroll
        for (int pass = 0; pass < 2; ++pass) {
            const int xc0 = pass == 0 ? 256 + g * 128 : g * 128;
            __syncthreads();
            { u32x4 rv[5];
#pragma unroll
                for (int i = 0; i < 5; ++i) { const int t = tid + 512 * i, row = t >> 4, seg = t & 15, rr = r0 - 2 + row; const int rc = rr < slo ? slo : (rr >= shi ? shi - 1 : rr);
                    rv[i] = *(const u32x4*)(Z + (size_t)rc * ZC + xc0 + seg * 8); }
#pragma unroll
                for (int i = 0; i < 5; ++i) { const int t = tid + 512 * i, row = t >> 4, seg = t & 15, rr = r0 - 2 + row; const bool ok = rr >= slo && rr < shi;
                    if (t < 132 * 16) *(LAS u32x4*)(RAW + row * 128 + seg * 8) = ok ? rv[i] : (u32x4){0u, 0u, 0u, 0u}; } }
            __syncthreads();
            const int ch = tid & 127;
            float w[5];
#pragma unroll
            for (int k = 0; k < 5; ++k) w[k] = scw[k * 768 + xc0 + ch];
            const float bias = scb[xc0 + ch];
#pragma unroll 2
            for (int i = 0; i < 4; ++i) { const int lb = (tid >> 7) + 4 * i;
                const LAS bf16* rp = RAW + (8 * lb) * 128 + ch;
                float in[12];
#pragma unroll
                for (int t = 0; t < 12; ++t) in[t] = __uint_as_float((unsigned)rp[t * 128] << 16);
                float o[8];
#pragma unroll
                for (int jj = 0; jj < 8; ++jj) { float sacc = bias;
#pragma unroll
                    for (int k = 0; k < 5; ++k) sacc += w[k] * in[jj + k];
                    o[jj] = silu_f(sacc); }
                if (pass == 0) {
                    *(LAS u32x4*)(BT + ch * 136 + 8 * lb) = pack8(o);
#pragma unroll
                    for (int jj = 0; jj < 8; ++jj) XBC[(size_t)(r0 + 8 * lb + jj) * 768 + xc0 + ch] = (bf16)(cvt_pk_bf16(o[jj], 0.f) & 0xffffu);
                } else {
                    *(u32x4*)(XT + ((size_t)c * 256 + xc0 + ch) * 128 + 8 * lb) = pack8(o);
                    const int h = 2 * g + (ch >> 6);
                    const f32x4 f0 = *(const LAS f32x4*)(wts + (h * 2) * 128 + 8 * lb), f1 = *(const LAS f32x4*)(wts + (h * 2) * 128 + 8 * lb + 4);
                    const f32x4 b0 = *(const LAS f32x4*)(wts + (h * 2 + 1) * 128 + 8 * lb), b1 = *(const LAS f32x4*)(wts + (h * 2 + 1) * 128 + 8 * lb + 4);
                    float of[8], ob[8];
#pragma unroll
                    for (int jj = 0; jj < 4; ++jj) { of[jj] = o[jj] * f0[jj]; of[4 + jj] = o[4 + jj] * f1[jj]; ob[jj] = o[jj] * b0[jj]; ob[4 + jj] = o[4 + jj] * b1[jj]; }
                    *(LAS u32x4*)(XF + ch * 136 + 8 * lb) = pack8(of); *(LAS u32x4*)(XB + ch * 136 + 8 * lb) = pack8(ob);
                }
            }
        }
        __syncthreads();
        {
            const int hl = wave >> 2, dir = (wave >> 1) & 1, nh = wave & 1, h = 2 * g + hl;
            const LAS bf16* Ub = BT + (64 * nh + lj) * 136 + 8 * lq;
            const LAS bf16* Vb = (dir ? XB : XF) + (64 * hl + lj) * 136 + 8 * lq;
            f32x4 acc[4][4];
#pragma unroll
            for (int nt = 0; nt < 4; ++nt)
#pragma unroll
                for (int pt = 0; pt < 4; ++pt) acc[nt][pt] = (f32x4){0.f, 0.f, 0.f, 0.f};
#pragma unroll
            for (int k = 0; k < 4; ++k) { bf16x8 uf[4], vf[4];
#pragma unroll
                for (int t = 0; t < 4; ++t) { uf[t] = *(const LAS bf16x8*)(Ub + t * 16 * 136 + 32 * k); vf[t] = *(const LAS bf16x8*)(Vb + t * 16 * 136 + 32 * k); }
#pragma unroll
                for (int nt = 0; nt < 4; ++nt)
#pragma unroll
                    for (int pt = 0; pt < 4; ++pt) acc[nt][pt] = __builtin_amdgcn_mfma_f32_16x16x32_bf16(uf[nt], vf[pt], acc[nt][pt], 0, 0, 0); }
            float* sp = ST + ((size_t)(c * 2 + dir) * 4 + h) * 8192;
#pragma unroll
            for (int nt = 0; nt < 4; ++nt)
#pragma unroll
                for (int pt = 0; pt < 4; ++pt) *(f32x4*)(sp + (16 * pt + lj) * 128 + 64 * nh + 16 * nt + 4 * lq) = acc[nt][pt];
        }
    }
    if (PART == 2) { LAS bf16* RAW2 = (LAS bf16*)(F.lds + 33792);
        { u32x4 rv[9];
#pragma unroll
            for (int i = 0; i < 9; ++i) { const int t = tid + 512 * i, row = t >> 5, seg = t & 31, rr = r0 - 2 + row; const int rc = rr < slo ? slo : (rr >= shi ? shi - 1 : rr);
                rv[i] = *(const u32x4*)(Z + (size_t)rc * ZC + ZO_C + seg * 8); }
#pragma unroll
            for (int i = 0; i < 9; ++i) { const int t = tid + 512 * i, row = t >> 5, seg = t & 31, rr = r0 - 2 + row; const bool ok = rr >= slo && rr < shi;
                if (t < 132 * 32) *(LAS u32x4*)(RAW2 + row * 256 + seg * 8) = ok ? rv[i] : (u32x4){0u, 0u, 0u, 0u}; } }
        __syncthreads();
        const int cg = tid & 31, ch = 512 + cg * 8;
        f32x4 cw0[5], cw1[5];
#pragma unroll
        for (int k = 0; k < 5; ++k) { cw0[k] = *(const f32x4*)(scw + k * 768 + ch); cw1[k] = *(const f32x4*)(scw + k * 768 + ch + 4); }
        const f32x4 cb0 = *(const f32x4*)(scb + ch), cb1 = *(const f32x4*)(scb + ch + 4);
#pragma unroll 2
        for (int i = 0; i < 8; ++i) { const int lr = (tid >> 5) + 16 * i;
            float acc[8];
            acc[0] = cb0[0]; acc[1] = cb0[1]; acc[2] = cb0[2]; acc[3] = cb0[3]; acc[4] = cb1[0]; acc[5] = cb1[1]; acc[6] = cb1[2]; acc[7] = cb1[3];
#pragma unroll
            for (int k = 0; k < 5; ++k) { float zv[8]; unpack8(*(const LAS u32x4*)(RAW2 + (lr + k) * 256 + cg * 8), zv);
                const f32x4 w0 = cw0[k], w1 = cw1[k];
                acc[0] += w0[0] * zv[0]; acc[1] += w0[1] * zv[1]; acc[2] += w0[2] * zv[2]; acc[3] += w0[3] * zv[3]; acc[4] += w1[0] * zv[4]; acc[5] += w1[1] * zv[5]; acc[6] += w1[2] * zv[6]; acc[7] += w1[3] * zv[7]; }
#pragma unroll
            for (int jj = 0; jj < 8; ++jj) acc[jj] = silu_f(acc[jj]);
            *(u32x4*)(XBC + (size_t)(r0 + lr) * 768 + ch) = pack8(acc); }
    }
}

__device__ __forceinline__ void a2_item(const Frame& F, ArgsP a, int l, int c) {
    unsigned char* ws = F.ws;
    const bf16* Z = (const bf16*)(ws + WS_Z); bf16* MIX = (bf16*)(ws + WS_H); const bf16* WSB = (const bf16*)(ws + WS_WSB);
    LAS bf16* VT = (LAS bf16*)F.lds;
    int lane = F.lane; asm volatile("" : "+v"(lane)); const int wave = F.wave, lj = lane & 15, lq = lane >> 4, r0 = c * 128;
    __syncthreads();
    {
        float gg[4], bbv[4];
#pragma unroll
        for (int e = 0; e < 4; ++e) { gg[e] = a->in[I_GNG][l * 256 + lane + 64 * e]; bbv[e] = a->in[I_GNB][l * 256 + lane + 64 * e]; }
#pragma unroll
        for (int hb = 0; hb < 2; ++hb) {
            bf16 raw[8][4];
#pragma unroll
            for (int i = 0; i < 8; ++i)
#pragma unroll
                for (int e = 0; e < 4; ++e) raw[i][e] = Z[(size_t)(r0 + 16 * wave + 8 * hb + i) * ZC + ZO_V + lane + 64 * e];
            float o[4][8];
#pragma unroll
            for (int i = 0; i < 8; ++i) { float v[4];
#pragma unroll
                for (int e = 0; e < 4; ++e) v[e] = gelu_tanh_f(__uint_as_float((unsigned)raw[i][e] << 16));
                const float mu = wave_sum((v[0] + v[1]) + (v[2] + v[3])) * (1.0f / 256.0f);
#pragma unroll
                for (int e = 0; e < 4; ++e) v[e] -= mu;
                const float rs = 1.0f / sqrtf(wave_sum((v[0] * v[0] + v[1] * v[1]) + (v[2] * v[2] + v[3] * v[3])) * (1.0f / 256.0f) + 1e-5f);
#pragma unroll
                for (int e = 0; e < 4; ++e) o[e][i] = v[e] * rs * gg[e] + bbv[e]; }
#pragma unroll
            for (int e = 0; e < 4; ++e) *(LAS u32x4*)(VT + (lane + 64 * e) * 136 + 16 * wave + 8 * hb) = pack8(o[e]);
        }
    }
    __syncthreads();
    const int g = wave >> 1, th = wave & 1;
    const LAS bf16* Ub = VT + (g * 64 + lj) * 136 + 8 * lq;
    const bf16* Vg = WSB + ((size_t)(l * 4 + g) * 128 + 64 * th + lj) * 128 + 8 * lq;
    f32x4 acc[4][4];
#pragma unroll
    for (int dt = 0; dt < 4; ++dt)
#pragma unroll
        for (int tt = 0; tt < 4; ++tt) acc[dt][tt] = (f32x4){0.f, 0.f, 0.f, 0.f};
    __builtin_amdgcn_sched_barrier(0);
    bf16x8 vfa[4][4];
#pragma unroll
    for (int k = 0; k < 4; ++k)
#pragma unroll
        for (int t = 0; t < 4; ++t) vfa[k][t] = *(const bf16x8*)(Vg + t * 16 * 128 + 32 * k);
#pragma unroll
    for (int k = 0; k < 4; ++k) { bf16x8 uf[4];
#pragma unroll
        for (int t = 0; t < 4; ++t) uf[t] = *(const LAS bf16x8*)(Ub + t * 16 * 136 + 32 * k);
#pragma unroll
        for (int dt = 0; dt < 4; ++dt)
#pragma unroll
            for (int tt = 0; tt < 4; ++tt) acc[dt][tt] = __builtin_amdgcn_mfma_f32_16x16x32_bf16(uf[dt], vfa[k][tt], acc[dt][tt], 0, 0, 0); }
    __builtin_amdgcn_sched_barrier(0);
    u32x2 uwa[4][4];
#pragma unroll
    for (int tt = 0; tt < 4; ++tt)
#pragma unroll
        for (int dt = 0; dt < 4; ++dt) uwa[tt][dt] = *(const u32x2*)(Z + (size_t)(r0 + 64 * th + 16 * tt + lj) * ZC + ZO_U + g * 64 + 16 * dt + 4 * lq);
#pragma unroll
    for (int tt = 0; tt < 4; ++tt) { const int t = 64 * th + 16 * tt + lj, r = r0 + t; const float bs = a->in[I_GBS][((size_t)l * 4 + g) * 128 + t];
#pragma unroll
        for (int dt = 0; dt < 4; ++dt) { const int ch0 = g * 64 + 16 * dt + 4 * lq; const u32x2 uw = uwa[tt][dt]; const f32x4 sv4 = acc[dt][tt];
            u32x2 ow; ow.x = cvt_pk_bf16(gelu_tanh_f(bflo(uw.x)) * (sv4[0] + bs), gelu_tanh_f(bfhi(uw.x)) * (sv4[1] + bs)); ow.y = cvt_pk_bf16(gelu_tanh_f(bflo(uw.y)) * (sv4[2] + bs), gelu_tanh_f(bfhi(uw.y)) * (sv4[3] + bs));
            *(u32x2*)(MIX + (size_t)r * D + 256 + ch0) = ow; } }
}

__device__ __forceinline__ void a3_item(const Frame& F, ArgsP a, int l, int c) {
    unsigned char* ws = F.ws;
    const bf16* Z = (const bf16*)(ws + WS_Z); bf16* MIX = (bf16*)(ws + WS_H);
    int lane = F.lane; asm volatile("" : "+v"(lane)); const int wave = F.wave, tid = wave * 64 + lane;
    int r0, slo, shi; chunk_geom(c, r0, slo, shi);
    {
        { const float* w = a->in[I_SCCW] + (size_t)l * 3 * 256; const int ch = (tid & 31) * 8;
            f32x4 sw0[3], sw1[3];
#pragma unroll
            for (int k = 0; k < 3; ++k) { sw0[k] = *(const f32x4*)(w + k * 256 + ch); sw1[k] = *(const f32x4*)(w + k * 256 + ch + 4); }
#pragma unroll 1
            for (int bt = 0; bt < 2; ++bt) {
                u32x4 gcv[4][3], xiv[4][3], gbv[4];
#pragma unroll
                for (int t4 = 0; t4 < 4; ++t4) { const int lr = (tid >> 5) + 16 * (4 * bt + t4), r = r0 + lr;
#pragma unroll
                    for (int k = 0; k < 3; ++k) { const int rr = r + k - 1; const int rc = rr < slo ? slo : (rr >= shi ? shi - 1 : rr);
                        gcv[t4][k] = *(const u32x4*)(Z + (size_t)rc * ZC + ZO_GC + ch); xiv[t4][k] = *(const u32x4*)(Z + (size_t)rc * ZC + ZO_XIN + ch); }
                    gbv[t4] = *(const u32x4*)(Z + (size_t)r * ZC + ZO_GB + ch); }
#pragma unroll
                for (int t4 = 0; t4 < 4; ++t4) { const int lr = (tid >> 5) + 16 * (4 * bt + t4), r = r0 + lr;
                    float acc[8];
#pragma unroll
                    for (int j = 0; j < 8; ++j) acc[j] = 0.f;
#pragma unroll
                    for (int k = 0; k < 3; ++k) { const int rr = r + k - 1; const float ok = (rr >= slo && rr < shi) ? 1.0f : 0.0f;
                        float gc[8], xi[8]; unpack8(gcv[t4][k], gc); unpack8(xiv[t4][k], xi);
                        const f32x4 w0 = sw0[k] * ok, w1 = sw1[k] * ok;
#pragma unroll
                        for (int j = 0; j < 4; ++j) { acc[j] += w0[j] * (gc[j] * xi[j]); acc[4 + j] += w1[j] * (gc[4 + j] * xi[4 + j]); } }
                    float gb[8]; unpack8(gbv[t4], gb);
#pragma unroll
                    for (int j = 0; j < 8; ++j) acc[j] *= gb[j];
                    *(u32x4*)(MIX + (size_t)r * D + 512 + ch) = pack8(acc); } } }
        {
            LAS bf16* glu = (LAS bf16*)F.lds;
            LAS float* cvb = (LAS float*)F.lds;
            __syncthreads();
#pragma unroll 1
            for (int bt = 0; bt < 2; ++bt) {
                u32x4 cav[5], cgv[5];
#pragma unroll
                for (int t5 = 0; t5 < 5; ++t5) { const int task = tid + 512 * (5 * bt + t5), i = task >> 5, ch = (task & 31) * 8, rr = r0 - 15 + i; const int rc = rr < slo ? slo : (rr >= shi ? shi - 1 : rr);
                    cav[t5] = *(const u32x4*)(Z + (size_t)rc * ZC + ZO_CA + ch); cgv[t5] = *(const u32x4*)(Z + (size_t)rc * ZC + ZO_CG + ch); }
#pragma unroll
                for (int t5 = 0; t5 < 5; ++t5) { const int task = tid + 512 * (5 * bt + t5), i = task >> 5, ch = (task & 31) * 8, rr = r0 - 15 + i; const float ok = (rr >= slo && rr < shi) ? 1.0f : 0.0f;
                    float ca[8], cg[8], o[8]; unpack8(cav[t5], ca); unpack8(cgv[t5], cg);
#pragma unroll
                    for (int j = 0; j < 8; ++j) o[j] = ok * ca[j] * sigmoid_f(cg[j]);
                    if (task < 158 * 32) *(LAS u32x4*)(glu + i * 256 + ch) = pack8(o); } }
            LAS float* wl = (LAS float*)(F.lds + 81920);
            { float wv[16];
#pragma unroll
                for (int i = 0; i < 16; ++i) { const int idx = tid + 512 * i; wv[i] = a->in[I_CFW][(size_t)l * 31 * 256 + (idx < 31 * 256 ? idx : 0)]; }
#pragma unroll
                for (int i = 0; i < 16; ++i) { const int idx = tid + 512 * i; if (idx < 31 * 256) wl[idx] = wv[i]; } }
            __syncthreads();
            const int ch = tid & 255, lh = tid >> 8;
            const LAS float* wp = wl + ch; const LAS bf16* gp = glu + (64 * lh) * 256 + ch; LAS float* cp = cvb + (64 * lh) * 256 + ch;
            float w[31];
#pragma unroll
            for (int k = 0; k < 31; ++k) w[k] = wp[k * 256];
            const float cfb = a->in[I_CFB][l * 256 + ch];
            float res[8][8];
#pragma unroll
            for (int jb = 0; jb < 8; ++jb) {
                bf16 gv[38];
#pragma unroll
                for (int i = 0; i < 38; ++i) gv[i] = gp[(8 * jb + i) * 256];
                __builtin_amdgcn_sched_barrier(0);
#pragma unroll
                for (int j = 0; j < 8; ++j) res[jb][j] = cfb;
#pragma unroll
                for (int i = 0; i < 38; ++i) { const float g = __uint_as_float((unsigned)gv[i] << 16);
#pragma unroll
                    for (int k = 0; k < 31; ++k) { const int lo = i - k; if (lo >= 0 && lo < 8) res[jb][lo] += w[k] * g; } }
                __builtin_amdgcn_sched_barrier(0);
            }
            __syncthreads();
#pragma unroll
            for (int jb = 0; jb < 8; ++jb)
#pragma unroll
                for (int j = 0; j < 8; ++j) cp[(8 * jb + j) * 256] = res[jb][j];
            __syncthreads();
            const f32x4 g = *(const f32x4*)(a->in[I_CFG] + l * 256 + 4 * lane), bb = *(const f32x4*)(a->in[I_CFNB] + l * 256 + 4 * lane);
            for (int lr = wave; lr < 128; lr += 8) { f32x4 v = *(const LAS f32x4*)(cvb + lr * 256 + 4 * lane);
                const float mu = wave_sum((v[0] + v[1]) + (v[2] + v[3])) * (1.0f / 256.0f); v = v - mu;
                const float var = wave_sum((v[0] * v[0] + v[1] * v[1]) + (v[2] * v[2] + v[3] * v[3])) * (1.0f / 256.0f);
                const f32x4 o = v * (1.0f / sqrtf(var + 1e-5f)) * g + bb;
                u32x2 ow; ow.x = cvt_pk_bf16(silu_f(o[0]), silu_f(o[1])); ow.y = cvt_pk_bf16(silu_f(o[2]), silu_f(o[3]));
                *(u32x2*)(MIX + (size_t)(r0 + lr) * D + 768 + 4 * lane) = ow; }
            __syncthreads();
        }
    }
}

__device__ __forceinline__ void pa_phase(const Frame& F, ArgsP a, int l, int nfull, int nall) {
    const int n2 = nfull, n3 = 2 * nfull, n4 = n3 + nall, n5 = n4 + nall, n6 = n5 + nall;
    for (int it = F.vcu; it < n6; it += F.G) {
        if (it < n2) a2_item(F, a, l, it);
        else if (it < n3) a3_item(F, a, l, it - n2);
        else if (it < n4) a1_item<0>(F, a, l, it - n3);
        else if (it < n5) a1_item<1>(F, a, l, it - n4);
        else a1_item<2>(F, a, l, it - n5);
    }
    __syncthreads();
}

__device__ __forceinline__ void m3_phase(const Frame& F) {
    unsigned char* ws = F.ws; const float* ST = (const float*)(ws + WS_ST); bf16* STE = (bf16*)(ws + WS_STE); const float* ACS = (const float*)(ws + WS_ACS);
    for (int task = F.vcu * 512 + F.tid; task < BATCH * 2 * 4 * 2048; task += F.G * 512) {
        const int q = task & 2047, h = (task >> 11) & 3, dir = (task >> 13) & 1, b = task >> 14;
        f32x4 e = {0.f, 0.f, 0.f, 0.f};
        for (int step = 0; step < 18; ++step) {
            int c;
            if (dir == 0) c = step < 2 ? NCHX + 2 * b + step : 16 * b + (step - 2);
            else c = step < 2 ? NCHX + 2 * b + (1 - step) : 16 * b + (17 - step);
            const float dec = __expf(dir == 0 ? ACS[(size_t)(c * 128 + 127) * 8 + h] : ACS[(size_t)(c * 128) * 8 + 4 + h]);
            const size_t eo = ((size_t)(c * 2 + dir) * 4 + h) * 8192 + (size_t)q * 4;
            const f32x4 s = *(const f32x4*)(ST + eo);
            u32x2 w; w.x = cvt_pk_bf16(e[0], e[1]); w.y = cvt_pk_bf16(e[2], e[3]); *(u32x2*)(STE + eo) = w;
            e = e * dec + s;
        }
    }
}

__device__ __forceinline__ void pc_phase(const Frame& F, ArgsP a, int l, int nchunks) {
    unsigned char* ws = F.ws;
    const bf16* Z = (const bf16*)(ws + WS_Z); const bf16* XBC = (const bf16*)(ws + WS_XBC); const bf16* XT = (const bf16*)(ws + WS_XT); const bf16* STE = (const bf16*)(ws + WS_STE);
    const float* DT = (const float*)(ws + WS_DT); const float* ACS = (const float*)(ws + WS_ACS); bf16* MIX = (bf16*)(ws + WS_H);
    LAS unsigned char* BL = F.lds;
    LAS unsigned char* XL = F.lds + 32768;
    LAS unsigned char* SL = F.lds + 65536;
    LAS float* sv = (LAS float*)(F.lds + 131072);
    LAS float* exch = sv + 2048;
    const int tid = F.tid, lane = F.lane, wave = F.wave, j = lane & 15, q = lane >> 4, lt = wave >> 1, hl = wave & 1;
    const int srow = tid >> 4, cpos = tid & 15;
    const unsigned ldsw = (unsigned)wave * 1024u;
    for (int item = F.vcu; item < nchunks * 2; item += F.G) {
        const int c = item >> 1, r0 = c * 128, l0 = 64 * (item & 1) + 16 * lt, lrow = l0 + j;
        __syncthreads();
        for (int i = tid; i < 1024; i += 512) { const int row = i >> 3, col = i & 7; sv[(col >> 2) * 512 + (col & 3) * 128 + row] = ACS[(size_t)(r0 + row) * 8 + col]; sv[1024 + (col >> 2) * 512 + (col & 3) * 128 + row] = DT[(size_t)(r0 + row) * 8 + col]; }
        f32x4 Yt[2][4];
#pragma unroll
        for (int g = 0; g < 2; ++g) {
            const int h = 2 * g + hl;
#pragma unroll
            for (int jj = 0; jj < 4; ++jj) { const int row = srow + 32 * jj; const int sc = 8 * (cpos ^ (row & 15));
                __builtin_amdgcn_global_load_lds((const unsigned*)(XBC + (size_t)(r0 + row) * 768 + 256 + g * 128 + sc), (LAS unsigned*)(BL + jj * 8192 + ldsw), 16, 0, 0);
                __builtin_amdgcn_global_load_lds((const unsigned*)(XT + ((size_t)c * 256 + g * 128 + row) * 128 + sc), (LAS unsigned*)(XL + jj * 8192 + ldsw), 16, 0, 0); }
#pragma unroll
            for (int b = 0; b < 4; ++b)
#pragma unroll
                for (int jj = 0; jj < 2; ++jj) { const int row = srow + 32 * jj; const int sc = 8 * (cpos ^ (row & 15));
                    __builtin_amdgcn_global_load_lds((const unsigned*)(STE + (((size_t)(c * 2 + (b & 1)) * 4 + 2 * g + (b >> 1)) * 64 + row) * 128 + sc), (LAS unsigned*)(SL + b * 16384 + jj * 8192 + ldsw), 16, 0, 0); }
            bf16x8 cf[4];
            { const bf16* Cn = XBC + (size_t)(r0 + lrow) * 768 + 512 + g * 128 + 8 * q;
#pragma unroll
                for (int k = 0; k < 4; ++k) cf[k] = *(const bf16x8*)(Cn + 32 * k); }
            asm volatile("s_waitcnt vmcnt(0)" ::: "memory");
            __syncthreads();
            f32x4 G[8];
#pragma unroll
            for (int st = 0; st < 8; ++st) { G[st] = (f32x4){0.f, 0.f, 0.f, 0.f};
#pragma unroll
                for (int k = 0; k < 4; ++k) G[st] = __builtin_amdgcn_mfma_f32_16x16x32_bf16(*(const LAS bf16x8*)(BL + (16 * st + j) * 256 + 16 * ((4 * k + q) ^ j)), cf[k], G[st], 0, 0, 0); }
            const float afl = sv[h * 128 + lrow], abl = sv[512 + h * 128 + lrow], Dh = a->in[I_SSDD][l * 4 + h];
            bf16x8 wf[4];
#pragma unroll
            for (int J = 0; J < 4; ++J) { float wv[8];
#pragma unroll
                for (int hf = 0; hf < 2; ++hf)
#pragma unroll
                    for (int r = 0; r < 4; ++r) { const int st = 2 * J + hf, sidx = 16 * st + 4 * q + r; float m = 0.f;
                        if (sidx <= lrow) m += fexp(afl - sv[h * 128 + sidx]) * sv[1024 + h * 128 + sidx];
                        if (sidx >= lrow) m += fexp(abl - sv[512 + h * 128 + sidx]) * sv[1536 + h * 128 + sidx];
                        wv[4 * hf + r] = G[st][r] * m + (sidx == lrow ? Dh : 0.f); }
                const u32x4 pk = pack8(wv); wf[J] = __builtin_bit_cast(bf16x8, pk); }
            f32x4 Y[4];
#pragma unroll
            for (int pt = 0; pt < 4; ++pt) { Y[pt] = (f32x4){0.f, 0.f, 0.f, 0.f}; const int row = hl * 64 + 16 * pt + j; const LAS unsigned char* xp = XL + row * 256 + 8 * (q & 1);
#pragma unroll
                for (int J = 0; J < 4; ++J) { const u32x2 lo = *(const LAS u32x2*)(xp + 16 * ((4 * J + (q >> 1)) ^ j)), hi = *(const LAS u32x2*)(xp + 16 * ((4 * J + 2 + (q >> 1)) ^ j)); const u32x4 xw = {lo.x, lo.y, hi.x, hi.y};
                    Y[pt] = __builtin_amdgcn_mfma_f32_16x16x32_bf16(__builtin_bit_cast(bf16x8, xw), wf[J], Y[pt], 0, 0, 0); } }
#pragma unroll
            for (int dir = 0; dir < 2; ++dir) { const float e = fexp(dir == 0 ? afl : abl); const LAS unsigned char* sp = SL + (hl * 2 + dir) * 16384;
#pragma unroll
                for (int pt = 0; pt < 4; ++pt) { f32x4 yd = {0.f, 0.f, 0.f, 0.f};
#pragma unroll
                    for (int k = 0; k < 4; ++k) yd = __builtin_amdgcn_mfma_f32_16x16x32_bf16(*(const LAS bf16x8*)(sp + (16 * pt + j) * 256 + 16 * ((4 * k + q) ^ j)), cf[k], yd, 0, 0, 0);
                    Y[pt] += yd * e; } }
#pragma unroll
            for (int pt = 0; pt < 4; ++pt) Yt[g][pt] = Y[pt];
            if (g == 0) __syncthreads();
        }
        float ssq = 0.f;
#pragma unroll
        for (int g = 0; g < 2; ++g)
#pragma unroll
            for (int pt = 0; pt < 4; ++pt) { const int ch = (2 * g + hl) * 64 + 16 * pt + 4 * q; const u32x2 zw = *(const u32x2*)(Z + (size_t)(r0 + lrow) * ZC + ZO_Z + ch);
                f32x4 v = Yt[g][pt]; v[0] *= silu_f(bflo(zw.x)); v[1] *= silu_f(bfhi(zw.x)); v[2] *= silu_f(bflo(zw.y)); v[3] *= silu_f(bfhi(zw.y)); Yt[g][pt] = v;
                ssq += (v[0] * v[0] + v[1] * v[1]) + (v[2] * v[2] + v[3] * v[3]); }
        ssq += __shfl_xor(ssq, 16); ssq += __shfl_xor(ssq, 32);
        if (q == 0) exch[(hl * 4 + lt) * 16 + j] = ssq;
        __syncthreads();
        const float rstd = 1.0f / sqrtf((exch[lt * 16 + j] + exch[(4 + lt) * 16 + j]) * (1.0f / 256.0f) + 1e-6f);
#pragma unroll
        for (int g = 0; g < 2; ++g)
#pragma unroll
            for (int pt = 0; pt < 4; ++pt) { const int ch = (2 * g + hl) * 64 + 16 * pt + 4 * q; const f32x4 ng = *(const f32x4*)(a->in[I_SNG] + l * 256 + ch); const f32x4 o = Yt[g][pt] * rstd * ng;
                u32x2 ow; ow.x = cvt_pk_bf16(o[0], o[1]); ow.y = cvt_pk_bf16(o[2], o[3]); *(u32x2*)(MIX + (size_t)(r0 + lrow) * D + ch) = ow; }
    }
    __syncthreads();
}

__device__ __forceinline__ void moe_assign(const Frame& F) {
    unsigned char* ws = F.ws; const unsigned* cnt = (const unsigned*)(ws + WS_CTL) + CW_CNT; unsigned* run = (unsigned*)(ws + WS_CTL) + CW_RUN;
    const int* tope = (const int*)(ws + WS_TOPE); const float* topp = (const float*)(ws + WS_TOPP); int* rowtok = (int*)(ws + WS_ROWTOK); float* rowp = (float*)(ws + WS_ROWP);
    int pre[2][8];
#pragma unroll
    for (int k = 0; k < 2; ++k) { int s = 0;
#pragma unroll
        for (int e = 0; e < 8; ++e) { pre[k][e] = s; s += ((int)__hip_atomic_load(cnt + k * 8 + e, RLX_AGENT) + 255) >> 8; } }
    const int gw = F.vcu * 8 + F.wave, NGW = F.G * 8, lane = F.lane;
    for (int base = gw * 64; base < RX; base += NGW * 64) {
        const int tok = base + lane;
#pragma unroll
        for (int k = 0; k < 2; ++k) { const int e = tope[(size_t)tok * 2 + k]; int slot = 0;
#pragma unroll
            for (int q = 0; q < 8; ++q) { const unsigned long long m = __ballot(e == q);
                if (m != 0ull) { unsigned b0 = 0; if (lane == 0) b0 = __hip_atomic_fetch_add(run + k * 8 + q, (unsigned)__popcll(m), RLX_AGENT); b0 = __shfl(b0, 0);
                    if (e == q) slot = 256 * pre[k][q] + (int)b0 + __popcll(m & ((1ull << lane) - 1ull)); } }
            rowtok[k * MOE_ROWS + slot] = tok; rowp[k * MOE_ROWS + slot] = topp[(size_t)tok * 2 + k]; ((int*)(ws + WS_SLOT))[k * RX + tok] = slot; }
    }
}

__device__ __forceinline__ void final_norm(const Frame& F, ArgsP a) {
    const int gw = F.vcu * 8 + F.wave, NGW = F.G * 8, lane = F.lane;
    f32x4 gv[4];
#pragma unroll
    for (int j = 0; j < 4; ++j) gv[j] = *(const f32x4*)(a->in[I_FNG] + 4 * lane + 256 * j);
    for (int r = gw; r < RX; r += NGW) { float* xr = a->out + (size_t)r * D; f32x4 v[4]; float ss = 0.f;
#pragma unroll
        for (int j = 0; j < 4; ++j) v[j] = *(const f32x4*)(xr + 4 * lane + 256 * j);
#pragma unroll
        for (int k = 0; k < 2; ++k) { const int sl = ((const int*)(F.ws + WS_SLOT))[k * RX + r];
            if (sl >= 128 * 256) {
                const bf16* sb = (const bf16*)(F.ws + (k == 0 ? WS_MSLAB0 : WS_MSLAB1)) + (size_t)(sl & 255) * 256 + 4 * lane; const int tl = (sl >> 8) - 128;
#pragma unroll
                for (int j = 0; j < 4; ++j)
#pragma unroll
                    for (int part = 0; part < MOE_P; ++part) { const u32x2 w = *(const u32x2*)(sb + ((size_t)((tl * 4 + j) * MOE_P + part) << 16)); v[j][0] += bflo(w.x); v[j][1] += bfhi(w.x); v[j][2] += bflo(w.y); v[j][3] += bfhi(w.y); } } }
#pragma unroll
        for (int j = 0; j < 4; ++j) ss += (v[j][0] * v[j][0] + v[j][1] * v[j][1]) + (v[j][2] * v[j][2] + v[j][3] * v[j][3]);
        const float rstd = 1.0f / sqrtf(wave_sum(ss) * (1.0f / D) + 1e-6f);
#pragma unroll
        for (int j = 0; j < 4; ++j) *(f32x4*)(xr + 4 * lane + 256 * j) = v[j] * rstd * gv[j]; }
}

__device__ __forceinline__ void phase_begin(Frame& F, int wave0) {
    int w = wave0; asm volatile("" : "+s"(w));
    int ln = (int)__builtin_amdgcn_mbcnt_hi(~0u, __builtin_amdgcn_mbcnt_lo(~0u, 0u)); asm volatile("" : "+v"(ln));
    F.wave = w; F.lane = ln; F.tid = w * 64 + ln; }
enum { PH_P0 = 0, PH0_N1, PH0_WIN, PH0_MA, PH0_M3, PH0_MC, PH0_WOUT, PH0_N2, PH0_UP, PH0_DN,
       PH1_N1, PH1_WIN, PH1_MA, PH1_M3, PH1_MC, PH1_WOUT, PH1_N2R, PH1_ASG, PH1_UP, PH1_DN0, PH1_DN1, PH_FIN, NPHASE };
__global__ void __launch_bounds__(512, 2) fwd_kernel(Args args_unused) {
    extern __shared__ __attribute__((aligned(16))) unsigned char lds_raw[];
    ArgsP ap = (ArgsP)__builtin_amdgcn_kernarg_segment_ptr();
    Frame F;
    F.lds = (LAS unsigned char*)lds_raw;
    const int wave0 = __builtin_amdgcn_readfirstlane((int)threadIdx.x >> 6);
    phase_begin(F, wave0);
    F.G = gridDim.x; { const int bx = blockIdx.x; F.vcu = (F.G % 8 == 0) ? (bx % 8) * (F.G / 8) + bx / 8 : bx; }
    F.ws = ap->ws;
    volatile LAS unsigned* MISC = (volatile LAS unsigned*)(F.lds + MISC_OFF);
    if (F.tid < 64) MISC[F.tid] = 0u;
    __syncthreads();
    XcdBarrier bar; bar.bar = (unsigned*)(ap->ws + WS_CTL) + CW_BAR; bar.x = 0; bar.st = nullptr;
    const int lo = ap->ph_lo, hi = ap->ph_hi;
    if (hi - lo > 1) bar = xcd_barrier_post((unsigned*)(ap->ws + WS_CTL) + CW_BAR, MISC + 8, F.tid);
#define IN(k) (phase_begin(F, wave0), ({ asm volatile("" : "+s"(ap)); }), F.ws = ap->ws, lo <= (k) && (k) < hi)
#define SEAM(k) do { if (IN(k) && IN((k) + 1)) xcd_barrier(bar, F.tid); } while (0)
    const int c = (int)blockIdx.x;
#define XC ((float*)(F.ws + WS_XC))
#define H ((bf16*)(F.ws + WS_H))
#define Zb ((bf16*)(F.ws + WS_Z))
#define modv ((const float*)(F.ws + WS_MODV))
#define ctl ((unsigned*)(F.ws + WS_CTL))

    if (IN(PH_P0)) { p0_prologue(F, ap); } SEAM(PH_P0);
    if (IN(PH0_N1)) { norm_phase<0>(F, ap, 0, RT, ap->in[I_X], ap->in[I_CTX], ap->in[I_N1G], 0, 1); } SEAM(PH0_N1);
    if (IN(PH0_WIN)) { pg8::RegSched S; S.init(H, F.ws + WS_WIN, D, RT / 256, ZC / 256, 0, 1, 0, F.G, c); pg8::EpiStoreBf16 E{Zb, ZC};
        pg8::gemm_phase<pg8::EpiStoreBf16, pg8::RegSched, false>(F.lds, D, S, E, F.tid); } SEAM(PH0_WIN);
    if (IN(PH0_MA)) { pa_phase(F, ap, 0, NCH, NCH); } SEAM(PH0_MA);
    if (IN(PH0_M3)) { m3_phase(F); } SEAM(PH0_M3);
    if (IN(PH0_MC)) { pc_phase(F, ap, 0, NCH); } SEAM(PH0_MC);
    if (IN(PH0_WOUT)) { pg8::RegSched S; S.init(H, F.ws + WS_WOUT, D, RT / 256, D / 256, 0, 1, 0, F.G, c); { pg8::EpiResid E{ap->in[I_X], ap->out, ap->in[I_CTX], XC, modv + 2 * 1024, (float*)(F.ws + WS_FSLAB)};
        pg8::gemm_phase<pg8::EpiResid, pg8::RegSched, false>(F.lds, D, S, E, F.tid); } } SEAM(PH0_WOUT);
#if FFN8
    if (IN(PH0_N2)) { norm_phase<3>(F, ap, 0, RT, ap->out, XC, ap->in[I_N2G], 3, 4); } SEAM(PH0_N2);
    if (IN(PH0_UP)) { g8::SchedD S; S.nMw = RT / 256; S.nN = 2 * DFF / 256; S.nMt = 0; S.G = F.G; S.c = c; S.nt = D / 128; S.P = 1; S.A = (const char*)H; S.tstepA = (size_t)256 * D; S.W = (const char*)(F.ws + WS_WUP); S.tstepB = (size_t)256 * D;
        g8::EpiSwiglu8<DFF> E{F.ws + WS_Z, 1.0f / 64.0f};
        g8::gemm8_phase<g8::EpiSwiglu8<DFF>, g8::SchedD, false>(F.lds, D, S, E, nullptr, F.tid); } SEAM(PH0_UP);
    if (IN(PH0_DN)) { g8::SchedD S; S.nMw = RX / 256; S.nN = D / 256; S.nMt = RC / 256; S.G = F.G; S.c = c; S.nt = DFF / 128; S.P = FFN_P; S.A = (const char*)(F.ws + WS_Z); S.tstepA = (size_t)256 * DFF; S.W = (const char*)(F.ws + WS_WDN); S.tstepB = (size_t)256 * DFF;
        g8::EpiResid8 E{ap->out, XC, modv + 5 * 1024, (float*)(F.ws + WS_FSLAB), 1.0f / 64.0f};
        g8::gemm8_phase<g8::EpiResid8, g8::SchedD, false>(F.lds, DFF, S, E, nullptr, F.tid); } SEAM(PH0_DN);
#else
    if (IN(PH0_N2)) { norm_phase<1>(F, ap, 0, RT, ap->out, XC, ap->in[I_N2G], 3, 4); } SEAM(PH0_N2);
    if (IN(PH0_UP)) { pg8::RegSched S; S.init(H, F.ws + WS_WUP, D, RT / 256, 2 * DFF / 256, 0, 1, 0, F.G, c); pg8::EpiSwiglu E{Zb, DFF};
        pg8::gemm_phase<pg8::EpiSwiglu, pg8::RegSched, false>(F.lds, D, S, E, F.tid); } SEAM(PH0_UP);
    if (IN(PH0_DN)) { pg8::RegSched S; S.init(Zb, F.ws + WS_WDN, DFF, RX / 256, D / 256, RC / 256, D / 256, RX / 256, F.G, c, FFN_P); { pg8::EpiResid E{ap->out, ap->out, XC, XC, modv + 5 * 1024, (float*)(F.ws + WS_FSLAB)};
        pg8::gemm_phase<pg8::EpiResid, pg8::RegSched, false>(F.lds, DFF, S, E, F.tid); } } SEAM(PH0_DN);
#endif
    if (IN(PH1_N1)) { norm_phase<0>(F, ap, 1, RT, ap->out, XC, ap->in[I_N1G] + D, 0, 1, (const float*)(F.ws + WS_FSLAB)); } SEAM(PH1_N1);
    if (IN(PH1_WIN)) { pg8::RegSched S; S.init(H, F.ws + WS_WIN + (size_t)ZC * D * 2, D, RX / 256, ZC / 256, RC / 256, 3, RX / 256, F.G, c); pg8::EpiStoreBf16 E{Zb, ZC};
        pg8::gemm_phase<pg8::EpiStoreBf16, pg8::RegSched, false>(F.lds, D, S, E, F.tid); } SEAM(PH1_WIN);
    if (IN(PH1_MA)) { pa_phase(F, ap, 1, NCHX, NCH); } SEAM(PH1_MA);
    if (IN(PH1_M3)) { m3_phase(F); } SEAM(PH1_M3);
    if (IN(PH1_MC)) { pc_phase(F, ap, 1, NCHX); } SEAM(PH1_MC);
    if (IN(PH1_WOUT)) { pg8::RegSched S; S.init(H, F.ws + WS_WOUT + (size_t)D * D * 2, D, RX / 256, D / 256, 0, 1, 0, F.G, c); { pg8::EpiResid E{ap->out, ap->out, XC, XC, modv + 17 * 6144 + 2 * 1024, (float*)(F.ws + WS_FSLAB)};
        pg8::gemm_phase<pg8::EpiResid, pg8::RegSched, false>(F.lds, D, S, E, F.tid); } } SEAM(PH1_WOUT);
    if (IN(PH1_N2R)) { norm_phase<2>(F, ap, 1, RX, ap->out, XC, ap->in[I_N2G] + D, 3, 4); moe_convert(F, ap); } SEAM(PH1_N2R);
    if (IN(PH1_ASG)) { moe_assign(F); } SEAM(PH1_ASG);
    if (IN(PH1_UP) || IN(PH1_DN0) || IN(PH1_DN1)) {
        g8::Sched S;
#pragma unroll
        for (int k = 0; k < 2; ++k) { int sacc = 0;
#pragma unroll
            for (int e = 0; e < 8; ++e) { if (k == 0) S.pre0[e] = sacc; else S.pre1[e] = sacc; sacc += (__builtin_amdgcn_readfirstlane((int)__hip_atomic_load(ctl + CW_CNT + k * 8 + e, RLX_AGENT)) + 255) >> 8; } if (k == 0) S.pre0[8] = sacc; else S.pre1[8] = sacc; }
        S.G = F.G; S.c = c;
        if (IN(PH1_UP)) {
            S.k0 = 0; S.npass = 2; S.P = 1; S.nN = 2 * EFF / 256; S.nt = D / 128; S.Abase = (const char*)H; S.arow = 0; S.apass = 0; S.Wbase = (const char*)(F.ws + WS_WMUP); S.wstride = (size_t)2 * EFF * D; S.tstepB = (size_t)256 * D;
            g8::EpiSwiglu8<EFF> E{F.ws + WS_T, 1.0f / 64.0f};
            g8::gemm8_phase<g8::EpiSwiglu8<EFF>, g8::Sched, true>(F.lds, D, S, E, (const int*)(F.ws + WS_ROWTOK), F.tid); }
        SEAM(PH1_UP);
#pragma unroll
        for (int k = 0; k < 2; ++k) {
            if (IN(PH1_DN0 + k)) { S.k0 = k; S.npass = 1; S.P = MOE_P; S.nN = D / 256; S.nt = EFF / 128; S.Abase = (const char*)(F.ws + WS_T); S.arow = EFF; S.apass = (size_t)MOE_ROWS * EFF; S.Wbase = (const char*)(F.ws + WS_WMDN); S.wstride = (size_t)D * EFF; S.tstepB = (size_t)256 * EFF;
                g8::EpiMoeDown8 E{(const int*)(F.ws + WS_ROWTOK), (const float*)(F.ws + WS_ROWP), modv + 17 * 6144 + 5 * 1024, ap->out, 1.0f / 64.0f, (bf16*)(F.ws + WS_MSLAB0), (bf16*)(F.ws + WS_MSLAB1)};
                g8::gemm8_phase<g8::EpiMoeDown8, g8::Sched, false>(F.lds, EFF, S, E, nullptr, F.tid); }
            SEAM(PH1_DN0 + k);
        }
    }
    if (IN(PH_FIN)) { final_norm(F, ap); }
#undef IN
#undef SEAM
#undef XC
#undef H
#undef Zb
#undef modv
#undef ctl
}

extern "C" void kernel_launch(void* const* d_in, const int* in_sizes, int n_in, void* d_out, int out_size, void* d_ws, size_t ws_size, hipStream_t stream) {
    static int grid = 0;
    if (grid == 0) {
        if (n_in != 33 || out_size != RX * D || ws_size < WS_NEED) { fprintf(stderr, "kernel_launch: unexpected problem (n_in %d, out %d, ws %zu, need %zu); nothing launched\n", n_in, out_size, ws_size, (size_t)WS_NEED); grid = -1; return; }
        int dev = 0, cus = 0, per_cu = 0;
        if (hipGetDevice(&dev) != hipSuccess || hipDeviceGetAttribute(&cus, hipDeviceAttributeMultiprocessorCount, dev) != hipSuccess) { grid = -1; return; }
        if (hipFuncSetAttribute((const void*)fwd_kernel, hipFuncAttributeMaxDynamicSharedMemorySize, LDS_BYTES) != hipSuccess) { fprintf(stderr, "kernel_launch: hipFuncSetAttribute failed\n"); grid = -1; return; }
        if (hipOccupancyMaxActiveBlocksPerMultiprocessor(&per_cu, (const void*)fwd_kernel, 512, LDS_BYTES) != hipSuccess || per_cu < 1) fprintf(stderr, "kernel_launch: occupancy query reports %d\n", per_cu);
        (void)hipGetLastError();
        grid = cus;
    }
    if (grid < 0) return;
    (void)hipMemsetAsync((char*)d_ws + WS_CTL, 0, CTL_BYTES, stream);
    Args a{};
    for (int i = 0; i < 33; ++i) a.in[i] = (const float*)d_in[i];
    a.out = (float*)d_out; a.ws = (unsigned char*)d_ws;
#if ONE_LAUNCH
    a.ph_lo = 0; a.ph_hi = NPHASE;
    hipLaunchKernelGGL(fwd_kernel, dim3(grid), dim3(512), LDS_BYTES, stream, a);
#else
    for (int p = 0; p < NPHASE; ++p) { a.ph_lo = p; a.ph_hi = p + 1; hipLaunchKernelGGL(fwd_kernel, dim3(grid), dim3(512), LDS_BYTES, stream, a); }
#endif
}
```

```cpp
#include <hip/hip_runtime.h>
#include <cstdio>
#include <cstdint>

#ifndef PROBE_MASK
#define PROBE_MASK 0u
#endif
#define REPS(k) (((PROBE_MASK >> (k)) & 1u) ? 2 : 1)
#ifndef ONE_LAUNCH
#define ONE_LAUNCH 1
#endif
#ifndef G8_PIPE
#define G8_PIPE 1
#endif
#ifndef PROBE_EPI
#define PROBE_EPI 0
#endif
#ifndef FFN8
#define FFN8 1
#endif

#define GAS __attribute__((address_space(1)))
#define LAS __attribute__((address_space(3)))
typedef unsigned short bf16;
typedef short bf16x8 __attribute__((ext_vector_type(8)));
typedef float f32x4 __attribute__((ext_vector_type(4)));
typedef float f32x2 __attribute__((ext_vector_type(2)));
typedef unsigned u32x4 __attribute__((ext_vector_type(4)));
typedef unsigned u32x2 __attribute__((ext_vector_type(2)));
typedef int i32x4 __attribute__((ext_vector_type(4)));
typedef int i32x8 __attribute__((ext_vector_type(8)));

constexpr int D = 1024, BATCH = 16, SEQ = 2048, CTXL = 256;
constexpr int RX = BATCH * SEQ, RC = BATCH * CTXL, RT = RX + RC;
constexpr int INC = 2824, ZC = 2816, DFF = 2816, EFF = 3584, NE = 8;
constexpr int NCHX = RX / 128, NCHC = RC / 128, NCH = NCHX + NCHC;
constexpr int MOE_ROWS = 34816;
constexpr int MOE_TILES = MOE_ROWS / 256;
constexpr int ZO_X = 0, ZO_B = 256, ZO_C = 512, ZO_Z = 768, ZO_U = 1024, ZO_V = 1280, ZO_GB = 1536, ZO_GC = 1792, ZO_XIN = 2048, ZO_CA = 2304, ZO_CG = 2560;

constexpr size_t al256(size_t x) { return (x + 255) & ~(size_t)255; }
constexpr size_t WS_CTL = 0, CTL_BYTES = 1u << 20;
constexpr size_t WS_MODV = WS_CTL + CTL_BYTES;
constexpr size_t WS_DT = WS_MODV + al256((size_t)2 * 17 * 6144 * 4);
constexpr size_t WS_ACS = WS_DT + (size_t)RT * 8 * 4;
constexpr size_t WS_TOPE = WS_ACS + (size_t)RT * 8 * 4;
constexpr size_t WS_TOPP = WS_TOPE + (size_t)RX * 2 * 4;
constexpr size_t WS_ROWTOK = WS_TOPP + (size_t)RX * 2 * 4;
constexpr size_t WS_ROWP = WS_ROWTOK + (size_t)2 * MOE_ROWS * 4;
constexpr size_t WS_SLOT = WS_ROWP + (size_t)2 * MOE_ROWS * 4;
constexpr size_t WS_DUMP = WS_SLOT + (size_t)2 * RX * 4;
constexpr size_t WS_WIN = WS_DUMP + 4096;
constexpr size_t WS_WOUT = WS_WIN + (size_t)2 * ZC * D * 2;
constexpr size_t WS_WUP = WS_WOUT + (size_t)2 * D * D * 2;
constexpr size_t WS_WDN = WS_WUP + (size_t)2 * DFF * D * 2;
constexpr size_t WS_XC = WS_WDN + (size_t)D * DFF * 2;
constexpr size_t WS_H = WS_XC + (size_t)RC * D * 4;
constexpr size_t WS_Z = WS_H + (size_t)RT * D * 2;
constexpr size_t WS_XBC = WS_Z + (size_t)RT * ZC * 2;
constexpr size_t WS_ST = WS_XBC + (size_t)RT * 768 * 2;
constexpr size_t WS_STE = WS_ST + (size_t)NCH * 2 * 4 * 8192 * 4;
constexpr size_t WS_XT = WS_STE + (size_t)NCH * 2 * 4 * 8192 * 2;
constexpr size_t WS_WSB = WS_XT + (size_t)NCH * 256 * 128 * 2;
constexpr size_t WS_END_MIX = WS_WSB + (size_t)2 * 4 * 128 * 128 * 2;
constexpr int FFN_P = 4;
constexpr size_t WS_FSLAB = WS_ST;
static_assert((size_t)16 * 4 * FFN_P * 65536 * 4 <= (size_t)NCH * 2 * 4 * 8192 * 4, "ffn slabs fit the chunk-state buffer");
constexpr size_t WS_WMUP = WS_Z;
constexpr size_t WS_WMDN = WS_WMUP + (size_t)NE * 2 * EFF * D;
constexpr size_t WS_T = WS_WMDN + (size_t)NE * D * EFF;
constexpr int MOE_P = 7, MOE_TAIL_TILES = MOE_TILES - 128;
constexpr size_t MOE_SLAB_BYTES = (size_t)MOE_TAIL_TILES * 4 * MOE_P * 65536 * 2;
constexpr size_t WS_MSLAB0 = WS_WIN;
constexpr size_t WS_MSLAB1 = WS_T + (size_t)2 * MOE_ROWS * EFF;
constexpr size_t WS_END_MOE = WS_MSLAB1 + MOE_SLAB_BYTES;
static_assert(WS_MSLAB0 + MOE_SLAB_BYTES <= WS_H, "pass-0 slabs fit below the activation buffer");
constexpr size_t WS_NEED = WS_END_MOE > WS_END_MIX ? WS_END_MOE : WS_END_MIX;
static_assert(WS_NEED < (size_t)612 * 1000 * 1000, "workspace budget");
constexpr int CW_BAR = 4096;
constexpr int CW_CNT = 8192;
constexpr int CW_RUN = 8192 + 64;
constexpr int CW_TMO = 0;

constexpr int RING_BYTES = 131072;
constexpr int LDS_BYTES = 147456;
constexpr int MISC_OFF = LDS_BYTES - 256;

#define RLX_AGENT __ATOMIC_RELAXED, __HIP_MEMORY_SCOPE_AGENT
__device__ __forceinline__ float bflo(unsigned w) { return __uint_as_float(w << 16); }
__device__ __forceinline__ float bfhi(unsigned w) { return __uint_as_float(w & 0xffff0000u); }
__device__ __forceinline__ unsigned cvt_pk_bf16(float lo, float hi) { unsigned r; asm volatile("v_cvt_pk_bf16_f32 %0, %1, %2" : "=v"(r) : "v"(lo), "v"(hi)); return r; }
__device__ __forceinline__ float fexp(float x) { return __builtin_amdgcn_exp2f(x * 1.4426950408889634f); }
__device__ __forceinline__ float silu_f(float x) { return x * __builtin_amdgcn_rcpf(1.0f + fexp(-x)); }
__device__ __forceinline__ float sigmoid_f(float x) { return __builtin_amdgcn_rcpf(1.0f + fexp(-x)); }
__device__ __forceinline__ float gelu_tanh_f(float x) { const float u = 0.7978845608028654f * (x + 0.044715f * x * x * x); return x * __builtin_amdgcn_rcpf(1.0f + fexp(-2.0f * u)); }
__device__ __forceinline__ unsigned pk4_fp8(float a, float b, float c, float d) { int w = __builtin_amdgcn_cvt_pk_fp8_f32(a, b, 0, false); w = __builtin_amdgcn_cvt_pk_fp8_f32(c, d, w, true); return (unsigned)w; }
__device__ __forceinline__ float softplus_f(float x) { return fmaxf(x, 0.0f) + log1pf(__expf(-fabsf(x))); }
__device__ __forceinline__ float wave_sum(float v) {
#pragma unroll
    for (int o = 1; o < 64; o <<= 1) v += __shfl_xor(v, o);
    return v;
}
__device__ __forceinline__ void unpack8(const u32x4 w, float (&f)[8]) { f[0] = bflo(w.x); f[1] = bfhi(w.x); f[2] = bflo(w.y); f[3] = bfhi(w.y); f[4] = bflo(w.z); f[5] = bfhi(w.z); f[6] = bflo(w.w); f[7] = bfhi(w.w); }
__device__ __forceinline__ u32x4 pack8(const float (&f)[8]) { u32x4 w; w.x = cvt_pk_bf16(f[0], f[1]); w.y = cvt_pk_bf16(f[2], f[3]); w.z = cvt_pk_bf16(f[4], f[5]); w.w = cvt_pk_bf16(f[6], f[7]); return w; }

#define XB_TMO      128
#define XB_XCNT(j)  (256  + 64 * (j))
#define XB_XSUB(j)  (1280 + 64 * (j))
#define XB_XGEN(j)  (2304 + 64 * (j))
#define XB_TOP      3328
#define XB_TOPGEN   3392
#define XCD_BAR_WORDS 3456
#define XB_SPIN_CAP (1u << 22)
__device__ __forceinline__ unsigned xb_ld(unsigned* p)              { return __hip_atomic_load(p, __ATOMIC_RELAXED, __HIP_MEMORY_SCOPE_AGENT); }
__device__ __forceinline__ unsigned xb_add(unsigned* p, unsigned v) { return __hip_atomic_fetch_add(p, v, __ATOMIC_RELAXED, __HIP_MEMORY_SCOPE_AGENT); }
__device__ __forceinline__ unsigned xb_xcc_id() { return (unsigned)__builtin_amdgcn_s_getreg((3 << 11) | 20) & 0xFu; }
#define XB_SPIN(cond, bar) do { unsigned _sp = 0; while (cond) { __builtin_amdgcn_s_sleep(1); \
    if ((++_sp & 255u) == 0u) { if (xb_ld(&(bar)[XB_TMO])) break; if (_sp > XB_SPIN_CAP) { atomicAdd(&(bar)[XB_TMO], 1u); break; } } } } while (0)
struct XcdBarrier { unsigned* bar; unsigned x; volatile LAS unsigned* st; };
__device__ __forceinline__ XcdBarrier xcd_barrier_post(unsigned* bar, volatile LAS unsigned* st, int tid) {
    XcdBarrier b; b.bar = bar; b.x = xb_xcc_id(); b.st = st;
    if (tid == 0) (void)xb_add(&bar[XB_XCNT(b.x)], 1u);
    return b;
}
__device__ __forceinline__ void xcd_barrier_complete(unsigned* bar, unsigned x, unsigned& nloc, unsigned& nx) {
    const unsigned G = gridDim.x * gridDim.y * gridDim.z;
    unsigned sum, cnt, mine, sp = 0u;
    for (;;) {
        sum = 0u; cnt = 0u; mine = 0u;
#pragma unroll
        for (unsigned j = 0; j < 16; ++j) { const unsigned c = xb_ld(&bar[XB_XCNT(j)]); sum += c; cnt += (c > 0u) ? 1u : 0u; mine = (j == x) ? c : mine; }
        if (sum == G) break;
        __builtin_amdgcn_s_sleep(1);
        if ((++sp & 255u) == 0u) { if (xb_ld(&bar[XB_TMO])) break; if (sp > XB_SPIN_CAP) { atomicAdd(&bar[XB_TMO], 1u); break; } }
    }
    nloc = mine > 0u ? mine : 1u; nx = cnt > 0u ? cnt : 1u;
}
__device__ __forceinline__ void xcd_barrier(const XcdBarrier& b, int tid) {
    asm volatile("s_waitcnt vmcnt(0)" ::: "memory");
    __syncthreads();
    if (tid == 0) {
        unsigned* bar = b.bar;
        __builtin_amdgcn_s_waitcnt(0);
        unsigned nloc = b.st[0], nx = b.st[1];
        if (nloc == 0u) { xcd_barrier_complete(bar, b.x, nloc, nx); b.st[0] = nloc; b.st[1] = nx; }
        const unsigned k = b.st[2] + 1u; b.st[2] = k;
        const unsigned old = xb_add(&bar[XB_XSUB(b.x)], 1u);
        if (old + 1u == k * nloc) {
            __builtin_amdgcn_fence(__ATOMIC_RELEASE, "agent");
            asm volatile("s_waitcnt vmcnt(0)" ::: "memory");
            xb_add(&bar[XB_TOP], 1u);
        }
        { unsigned sp = 0u; while (xb_add(&bar[XB_TOP], 0u) < k * nx) {
            __builtin_amdgcn_s_sleep(2); if ((++sp & 255u) == 0u) { if (xb_ld(&bar[XB_TMO])) break; if (sp > XB_SPIN_CAP) { atomicAdd(&bar[XB_TMO], 1u); break; } } } }
        __builtin_amdgcn_fence(__ATOMIC_ACQUIRE, "agent");
        asm volatile("s_waitcnt vmcnt(0)" ::: "memory");
    }
    __syncthreads();
}

namespace pg8 {
constexpr int BM = 256, BK = 64, HALF = 128, HTB = HALF * BK * 2, STAGE_BYTES = 8 * HTB, NXCD = 8, WGM = 8;
__host__ __device__ __forceinline__ int lds_byte(int r, int c) { const int st = (r >> 4) * 2 + (c >> 5), rr = r & 15, cc = c & 31, ob = rr * 64 + cc * 2; return st * 1024 + (ob ^ (((ob >> 9) & 1) << 5)); }
__host__ __device__ __forceinline__ void stage_rc(int b, int& R, int& C) { const int st = b / 1024, sb = b % 1024, swz = sb ^ (((sb >> 9) & 1) << 5); R = (st >> 1) * 16 + swz / 64; C = (st & 1) * 32 + (swz % 64) / 2; }
__host__ __device__ __forceinline__ int perm32(int rho) { const int n = rho >> 4, i = rho & 15; return 8 * (i >> 2) + 4 * n + (i & 3); }
__device__ __forceinline__ const char* uptr(const char* p) { const unsigned long long v = (unsigned long long)p; const unsigned lo = __builtin_amdgcn_readfirstlane((unsigned)v), hi = __builtin_amdgcn_readfirstlane((unsigned)(v >> 32)); return (const char*)(((unsigned long long)hi << 32) | lo); }
struct Unit { int pm, pn; const char* a; const char* b; int nt, split, part; };
__device__ __forceinline__ void tile_map(int L, int nM, int nN, int& pm, int& pn) {
    const int nwg = nM * nN; int wgid = L;
    { const int q = nwg / NXCD, r = nwg % NXCD, xcd = wgid % NXCD, off = wgid / NXCD; wgid = (xcd < r ? xcd * (q + 1) : r * (q + 1) + (xcd - r) * q) + off; }
    const int nig = WGM * nN, gid = wgid / nig, fm = gid * WGM, gsz = (nM - fm) < WGM ? (nM - fm) : WGM;
    pm = fm + ((wgid % nig) % gsz); pn = (wgid % nig) / gsz;
}
__device__ __forceinline__ bool tail_split(long L, int nu, int nwhole, int npairs, int P, int& tile, int& kt0, int& nt, int& split, int& part) {
    if (L < nwhole) { tile = (int)L; kt0 = 0; nt = 2 * npairs; split = 0; part = 0; return true; }
    const int Lt = (int)L - nwhole; if (Lt >= (nu - nwhole) * P) return false;
    part = Lt % P; const int base = npairs / P, rem = npairs % P, start = part * base + (part < rem ? part : rem), cnt = base + (part < rem ? 1 : 0);
    tile = nwhole + Lt / P; kt0 = 2 * start; nt = 2 * cnt; split = 1; return true;
}
struct RegSched {
    int nM0, nN0, n0, nM1, nN1, n1, pm1off, G, c, npairs, P; const char* A; const char* B; size_t tstep;
    __device__ __forceinline__ void init(const void* A_, const void* B_, int K, int nM0_, int nN0_, int nM1_, int nN1_, int pm1off_, int G_, int c_, int P_ = 1) {
        A = (const char*)A_; B = (const char*)B_; tstep = (size_t)256 * K * 2; nM0 = nM0_; nN0 = nN0_; n0 = nM0_ * nN0_; nM1 = nM1_; nN1 = nN1_; n1 = nM1_ * nN1_; pm1off = pm1off_; G = G_; c = c_; npairs = K / 128; P = P_; }
    __device__ __forceinline__ bool next(int i, Unit& u) const {
        const long L = (long)i * G + c; int tile, kt0;
        if (!tail_split(L, n0 + n1, P > 1 ? n0 : n0 + n1, npairs, P, tile, kt0, u.nt, u.split, u.part)) return false;
        int pm, pn;
        if (tile < n0) tile_map(tile, nM0, nN0, pm, pn); else { tile_map(tile - n0, nM1, nN1, pm, pn); pm += pm1off; }
        u.pm = pm; u.pn = pn; u.a = A + (size_t)pm * tstep + (size_t)kt0 * 128; u.b = B + (size_t)pn * tstep + (size_t)kt0 * 128; return true;
    }
    __device__ __forceinline__ void gather(const Unit&, int, unsigned (&)[2][2]) const {}
};
template <class Epi, class Sched, bool GATHER>
__device__ __forceinline__ void gemm_phase(LAS unsigned char* lds, const int K, const Sched& S, const Epi& E, int tid) {
    asm volatile("" : "+v"(tid));
    const int wid = __builtin_amdgcn_readfirstlane(tid >> 6), lane = tid & 63, wr = wid >> 2, wc = wid & 3, fr = lane & 15, fq = lane >> 4;
    unsigned voffA[2], voffB[2];
#pragma unroll
    for (int i = 0; i < 2; ++i) { int R, C; stage_rc(tid * 16 + i * 8192, R, C); const int Rb = Epi::PERM ? ((R & ~31) + perm32(R & 31)) : R;
        voffA[i] = (unsigned)(R * K + C) * 2u; voffB[i] = (unsigned)(Rb * K + C) * 2u; }
    const size_t kstep = (size_t)(BK * 2);
    const size_t hstep = (size_t)HALF * K * 2;
    const unsigned ldsw = (unsigned)wid * 1024u;
    const int aoff = lds_byte(wr * 64 + fr, fq * 8), boff = lds_byte(wc * 32 + fr, fq * 8);
#define PG8_SA(b, h) (((b) * 2 + (h)) * HTB)
#define PG8_SB(b, h) ((4 + (b) * 2 + (h)) * HTB)
#define PG8_STAGE(bufoff, gbase, voff) do { _Pragma("unroll") for (int _i = 0; _i < 2; ++_i) \
        __builtin_amdgcn_global_load_lds((const unsigned*)((const char*)(gbase) + (voff)[_i]), (LAS unsigned*)(lds + (bufoff) + ldsw + _i * 8192), 16, 0, 0); } while (0)
#define PG8_STAGE_A(bufoff, kptr, h, SEL) do { if constexpr (GATHER) { unsigned _vo[2]; _vo[0] = (SEL) ? nva[h][0] : cva[h][0]; _vo[1] = (SEL) ? nva[h][1] : cva[h][1]; PG8_STAGE(bufoff, kptr, _vo); } else { PG8_STAGE(bufoff, (kptr) + (h) * hstep, voffA); } } while (0)
#define PG8_LDA(dst, b, h) do { _Pragma("unroll") for (int m = 0; m < 4; ++m) _Pragma("unroll") for (int k = 0; k < 2; ++k) dst[m][k] = *(const LAS bf16x8*)(lds + PG8_SA(b, h) + aoff + m * 2048 + k * 1024); } while (0)
#define PG8_LDB(dst, b, h) do { _Pragma("unroll") for (int n = 0; n < 2; ++n) _Pragma("unroll") for (int k = 0; k < 2; ++k) dst[n][k] = *(const LAS bf16x8*)(lds + PG8_SB(b, h) + boff + n * 2048 + k * 1024); } while (0)
#define PG8_MMA(ai, bj, At, Bt) do { __builtin_amdgcn_s_setprio(1); _Pragma("unroll") for (int m = 0; m < 4; ++m) _Pragma("unroll") for (int n = 0; n < 2; ++n) _Pragma("unroll") for (int k = 0; k < 2; ++k) \
        acc[ai][bj][m][n] = __builtin_amdgcn_mfma_f32_16x16x32_bf16(Bt[n][k], At[m][k], acc[ai][bj][m][n], 0, 0, 0); __builtin_amdgcn_s_setprio(0); } while (0)
#define PG8_WAIT_V(n) asm volatile("s_waitcnt vmcnt(" #n ")" ::: "memory")
#define PG8_WAIT_L(n) asm volatile("s_waitcnt lgkmcnt(" #n ")" ::: "memory")
#define PG8_BAR __builtin_amdgcn_s_barrier()
#define PG8_SCHED __builtin_amdgcn_sched_barrier(0)
    Unit cur, nxt; int ui = 0;
    if (!S.next(0, cur)) return;
    f32x4 acc[2][2][4][2];
#pragma unroll
    for (int a = 0; a < 2; ++a)
#pragma unroll
        for (int b = 0; b < 2; ++b)
#pragma unroll
            for (int m = 0; m < 4; ++m)
#pragma unroll
                for (int n = 0; n < 2; ++n) acc[a][b][m][n] = (f32x4){0.f, 0.f, 0.f, 0.f};
    bf16x8 At[4][2], B0[2][2], B1[2][2];
    unsigned cva[2][2] = {{0u, 0u}, {0u, 0u}}, nva[2][2] = {{0u, 0u}, {0u, 0u}};
    if constexpr (GATHER) S.gather(cur, tid, cva);
    const char* cA = uptr(cur.a); const char* cB = uptr(cur.b);
    PG8_STAGE(PG8_SB(0, 0), cB, voffB); PG8_STAGE(PG8_SB(0, 1), cB + hstep, voffB); PG8_STAGE_A(PG8_SA(0, 0), cA, 0, false); PG8_STAGE_A(PG8_SA(0, 1), cA, 1, false);
    if (wr == 1) PG8_BAR;
    PG8_WAIT_V(2); PG8_BAR;
    PG8_STAGE(PG8_SB(1, 0), cB + kstep, voffB); PG8_STAGE_A(PG8_SA(1, 0), cA + kstep, 0, false); PG8_STAGE(PG8_SB(1, 1), cB + hstep + kstep, voffB);
    PG8_WAIT_V(6); PG8_BAR;
    for (;;) {
        const bool has_next = S.next(ui + 1, nxt);
        const char* nA = uptr(has_next ? nxt.a : cA); const char* nB = uptr(has_next ? nxt.b : cB);
        if constexpr (GATHER) { if (has_next) S.gather(nxt, tid, nva); else {
#pragma unroll
            for (int h = 0; h < 2; ++h)
#pragma unroll
                for (int i = 0; i < 2; ++i) nva[h][i] = cva[h][i]; } }
        const int nt = cur.nt;
        for (int t = 0; t < nt; t += 2) {
            const bool last = (t == nt - 2);
            asm volatile("" : "+v"(voffA[0]), "+v"(voffA[1]), "+v"(voffB[0]), "+v"(voffB[1]));
            const char* a1 = uptr(cA + (size_t)(t + 1) * kstep);
            const char* a2 = uptr(last ? nA : cA + (size_t)(t + 2) * kstep); const char* b2 = uptr(last ? nB : cB + (size_t)(t + 2) * kstep);
            const char* a3 = a2 + kstep; const char* b3 = b2 + kstep;
            PG8_LDB(B0, 0, 0); PG8_LDB(B1, 0, 1); PG8_SCHED; PG8_LDA(At, 0, 0); PG8_STAGE_A(PG8_SA(1, 1), a1, 1, false);
            PG8_WAIT_V(8); PG8_WAIT_L(0); PG8_BAR; PG8_MMA(0, 0, At, B0); PG8_MMA(0, 1, At, B1); PG8_BAR; PG8_SCHED;
            PG8_LDA(At, 0, 1); PG8_STAGE(PG8_SB(0, 0), b2, voffB); PG8_STAGE(PG8_SB(0, 1), b2 + hstep, voffB); PG8_STAGE_A(PG8_SA(0, 0), a2, 0, last);
            PG8_WAIT_V(8); PG8_WAIT_L(0); PG8_BAR; PG8_MMA(1, 0, At, B0); PG8_MMA(1, 1, At, B1); PG8_BAR; PG8_SCHED;
            PG8_LDB(B0, 1, 0); PG8_LDB(B1, 1, 1); PG8_SCHED; PG8_LDA(At, 1, 0); PG8_STAGE_A(PG8_SA(0, 1), a2, 1, last);
            PG8_WAIT_V(8); PG8_WAIT_L(0); PG8_BAR; PG8_MMA(0, 0, At, B0); PG8_MMA(0, 1, At, B1); PG8_BAR; PG8_SCHED;
            PG8_LDA(At, 1, 1); PG8_STAGE(PG8_SB(1, 0), b3, voffB); PG8_STAGE(PG8_SB(1, 1), b3 + hstep, voffB); PG8_STAGE_A(PG8_SA(1, 0), a3, 0, last);
            PG8_WAIT_V(8); PG8_WAIT_L(0); PG8_BAR; PG8_MMA(1, 0, At, B0); PG8_MMA(1, 1, At, B1); PG8_BAR; PG8_SCHED;
        }
        if (wr == 0) PG8_BAR;
        { Unit eu = cur; int efr = fr, efq = fq; asm volatile("" : "+s"(eu.pm), "+s"(eu.pn), "+s"(eu.split), "+s"(eu.part), "+v"(efr), "+v"(efq));
          E(acc, eu, wr, wc, efr, efq);
#if PROBE_EPI
          if constexpr (!Epi::RMW && ((PROBE_EPI >> Epi::PB) & 1)) { asm volatile("" ::: "memory");
#pragma unroll
            for (int a_ = 0; a_ < 2; ++a_)
#pragma unroll
              for (int b_ = 0; b_ < 2; ++b_)
#pragma unroll
                for (int m_ = 0; m_ < 4; ++m_)
#pragma unroll
                  for (int n_ = 0; n_ < 2; ++n_) asm volatile("" : "+v"(acc[a_][b_][m_][n_]));
            E(acc, eu, wr, wc, efr, efq); }
#endif
          }
        if (!has_next) break;
#pragma unroll
        for (int a = 0; a < 2; ++a)
#pragma unroll
            for (int b = 0; b < 2; ++b)
#pragma unroll
                for (int m = 0; m < 4; ++m)
#pragma unroll
                    for (int n = 0; n < 2; ++n) acc[a][b][m][n] = (f32x4){0.f, 0.f, 0.f, 0.f};
        cur = nxt; cA = nA; cB = nB; ++ui;
        if constexpr (GATHER) {
#pragma unroll
            for (int h = 0; h < 2; ++h)
#pragma unroll
                for (int i = 0; i < 2; ++i) cva[h][i] = nva[h][i]; }
        if (wr == 1) PG8_BAR;
    }
    PG8_WAIT_V(0);
    PG8_BAR;
#undef PG8_SA
#undef PG8_SB
#undef PG8_STAGE
#undef PG8_STAGE_A
#undef PG8_LDA
#undef PG8_LDB
#undef PG8_MMA
#undef PG8_WAIT_V
#undef PG8_WAIT_L
#undef PG8_BAR
#undef PG8_SCHED
}

struct EpiStoreBf16 {
    static constexpr bool PERM = true, RMW = false; static constexpr int PB = 3;
    bf16* O; int ldc;
    __device__ __forceinline__ void operator()(const f32x4 (&acc)[2][2][4][2], const Unit& u, int wr, int wc, int fr, int fq) const {
        const int row0 = u.pm * BM + wr * 64 + fr, col0 = u.pn * BM + wc * 32 + 8 * fq;
#pragma unroll
        for (int ai = 0; ai < 2; ++ai)
#pragma unroll
            for (int m = 0; m < 4; ++m) { bf16* rowp = O + (size_t)(row0 + ai * HALF + m * 16) * ldc + col0;
#pragma unroll
                for (int bj = 0; bj < 2; ++bj) { const f32x4 v0 = acc[ai][bj][m][0], v1 = acc[ai][bj][m][1];
                    u32x4 w; w.x = cvt_pk_bf16(v0[0], v0[1]); w.y = cvt_pk_bf16(v0[2], v0[3]); w.z = cvt_pk_bf16(v1[0], v1[1]); w.w = cvt_pk_bf16(v1[2], v1[3]);
                    *(u32x4*)(rowp + bj * HALF) = w; } }
    }
};
struct EpiSwiglu {
    static constexpr bool PERM = true, RMW = false; static constexpr int PB = 4;
    bf16* O; int ldc;
    __device__ __forceinline__ void operator()(const f32x4 (&acc)[2][2][4][2], const Unit& u, int wr, int wc, int fr, int fq) const {
        const int row0 = u.pm * BM + wr * 64 + fr, col0 = u.pn * HALF + wc * 32 + 8 * fq;
#pragma unroll
        for (int ai = 0; ai < 2; ++ai)
#pragma unroll
            for (int m = 0; m < 4; ++m) { bf16* rowp = O + (size_t)(row0 + ai * HALF + m * 16) * ldc + col0;
                float t[8];
#pragma unroll
                for (int n = 0; n < 2; ++n)
#pragma unroll
                    for (int j = 0; j < 4; ++j) t[4 * n + j] = silu_f(acc[ai][0][m][n][j]) * acc[ai][1][m][n][j];
                *(u32x4*)rowp = pack8(t); }
    }
};
struct EpiResid {
    static constexpr bool PERM = false, RMW = true; static constexpr int PB = 5;
    const float* xbase; float* xout; const float* cbase; float* cout; const float* gate; float* slab;
    __device__ __forceinline__ void operator()(const f32x4 (&acc)[2][2][4][2], const Unit& u, int wr, int wc, int fr, int fq) const {
        const float* base; float* out; const float* g;
        if (u.pm < RX / 256) { base = xbase + (size_t)u.pm * 256 * D; out = xout + (size_t)u.pm * 256 * D; g = gate + (size_t)(u.pm >> 3) * 6144; }
        else { const int pc = u.pm - RX / 256; base = cbase + (size_t)pc * 256 * D; out = cout + (size_t)pc * 256 * D; g = gate + (size_t)16 * 6144; }
        const int col0 = u.pn * BM + wc * 32 + 4 * fq;
        f32x4 gv[2][2];
#pragma unroll
        for (int bj = 0; bj < 2; ++bj)
#pragma unroll
            for (int n = 0; n < 2; ++n) gv[bj][n] = *(const f32x4*)(g + col0 + bj * HALF + n * 16);
#pragma unroll
        for (int ai = 0; ai < 2; ++ai) {
            f32x4 bs[4][2][2];
            if (!u.split) {
#pragma unroll
                for (int m = 0; m < 4; ++m)
#pragma unroll
                    for (int bj = 0; bj < 2; ++bj)
#pragma unroll
                        for (int n = 0; n < 2; ++n) bs[m][bj][n] = *(const f32x4*)(base + (size_t)(wr * 64 + fr + ai * HALF + m * 16) * D + col0 + bj * HALF + n * 16); }
            __builtin_amdgcn_sched_barrier(0);
#pragma unroll
            for (int m = 0; m < 4; ++m) { const size_t off = (size_t)(wr * 64 + fr + ai * HALF + m * 16) * D + col0;
#pragma unroll
                for (int bj = 0; bj < 2; ++bj)
#pragma unroll
                    for (int n = 0; n < 2; ++n) { const f32x4 v = gv[bj][n] * acc[ai][bj][m][n]; float* o = out + off + bj * HALF + n * 16;
                        if (u.split) *(f32x4*)(slab + ((size_t)(((u.pm - RX / 256) * 4 + u.pn) * FFN_P + u.part) << 16) + (size_t)(wr * 64 + fr + ai * HALF + m * 16) * 256 + wc * 32 + 4 * fq + bj * HALF + n * 16) = v;
                        else *(f32x4*)o = bs[m][bj][n] + v; } }
            __builtin_amdgcn_sched_barrier(0); }
    }
};
}


namespace g8 {
constexpr int TA = 32768, TB = 32768, STG = TA + TB, NSTG = 2;
struct Unit { const char* a; const char* b; int row0, k, pn, nt, split, part; };
__device__ __forceinline__ const char* uptr(const char* p) { const unsigned long long v = (unsigned long long)p; const unsigned lo = __builtin_amdgcn_readfirstlane((unsigned)v), hi = __builtin_amdgcn_readfirstlane((unsigned)(v >> 32)); return (const char*)(((unsigned long long)hi << 32) | lo); }

struct Sched {
    int pre0[9], pre1[9]; int k0, npass, nN, G, c, nt, P; const char* Abase; size_t arow;   size_t apass; const char* Wbase; size_t wstride, tstepB;
    __device__ __forceinline__ bool next(int i, Unit& u) const {
        long L = (long)i * G + c; int k = k0;
        const int nm0 = (k0 == 0 ? pre0[8] : pre1[8]);
        if (P == 1 && L >= (long)nm0 * nN) { if (npass < 2) return false; L -= (long)nm0 * nN; k = 1; if (L >= (long)pre1[8] * nN) return false; }
        const int nm = (k == 0 ? pre0[8] : pre1[8]);
        int pm, pn, kt0 = 0; u.split = 0; u.part = 0; u.nt = nt;
        if (P > 1) {
            if (L < 128 * nN) pg8::tile_map((int)L, 128, nN, pm, pn);
            else { const int Lt = (int)L - 128 * nN; if (Lt >= (nm - 128) * nN * P) return false; const int tile = Lt / P; pm = 128 + tile / nN; pn = tile % nN; u.part = Lt % P; u.split = 1; u.nt = nt / P; kt0 = u.part * (nt / P); }
        } else pg8::tile_map((int)L, nm, nN, pm, pn);
        int e = 0;
#pragma unroll
        for (int j = 1; j < 8; ++j) e += (pm >= (k == 0 ? pre0[j] : pre1[j])) ? 1 : 0;
        u.row0 = pm * 256; u.k = k; u.pn = pn;
        u.a = Abase + (size_t)k * apass + (size_t)u.row0 * arow + (size_t)kt0 * 128; u.b = Wbase + (size_t)e * wstride + (size_t)pn * tstepB + (size_t)kt0 * 128; return true;
    }
};

struct SchedD {
    int nMw, nN, nMt, G, c, nt, P; const char* A; size_t tstepA; const char* W; size_t tstepB;
    __device__ __forceinline__ bool next(int i, Unit& u) const {
        const long L = (long)i * G + c; int pm, pn, kt0 = 0; u.split = 0; u.part = 0; u.nt = nt; u.k = 0;
        if (L < (long)nMw * nN) pg8::tile_map((int)L, nMw, nN, pm, pn);
        else { const int Lt = (int)(L - (long)nMw * nN); if (Lt >= nMt * nN * P) return false; const int tile = Lt / P, part = Lt % P, base = nt / P, rem = nt % P;
            pm = nMw + tile / nN; pn = tile % nN; u.part = part; u.split = 1; u.nt = base + (part < rem ? 1 : 0); kt0 = part * base + (part < rem ? part : rem); }
        u.row0 = pm * 256; u.pn = pn; u.a = A + (size_t)pm * tstepA + (size_t)kt0 * 128; u.b = W + (size_t)pn * tstepB + (size_t)kt0 * 128; return true;
    }
};

template <class Epi, class Sched, bool GATHER>
__device__ __forceinline__ void gemm8_phase(LAS unsigned char* lds, const int rowbytes, const Sched& S, const Epi& E, const int* rowtok  , int tid) {
    asm volatile("" : "+v"(tid));
    const int wave = __builtin_amdgcn_readfirstlane(tid >> 6), lane = tid & 63, wr = wave >> 2, wc = wave & 3, i16 = lane & 15, q = lane >> 4;
    const int srow = tid >> 3, cpos = tid & 7;
    const unsigned soff = 16u * (unsigned)(cpos ^ (srow & 7));
    const unsigned voffB = (unsigned)srow * (unsigned)rowbytes + soff;
    unsigned voffA[4] = {voffB, voffB + 64u * (unsigned)rowbytes, voffB + 128u * (unsigned)rowbytes, voffB + 192u * (unsigned)rowbytes};
    const unsigned ldsw = (unsigned)wave * 1024u;
    const int swz = i16 & 7;
    const unsigned c0 = 16u * (unsigned)(q ^ swz), c1 = 16u * (unsigned)((4 + q) ^ swz);
    const unsigned ard = (unsigned)((128 * wr + i16) * 128), brd = (unsigned)(TA + (64 * wc + i16) * 128);
    Unit cu, su, nu;
    if (!S.next(0, cu)) return;
    su = cu; int si = 0, skt = 0; bool s_valid = true; bool n_valid = S.next(1, nu);
    unsigned gnext[4] = {0u, 0u, 0u, 0u};
    int issued = 0, pos = 0;
#define G8_GATHER(U, DST) do { if constexpr (GATHER) { _Pragma("unroll") for (int _j = 0; _j < 4; ++_j) { int tk = rowtok[(U).k * MOE_ROWS + (U).row0 + srow + 64 * _j]; tk = tk < 0 ? 0 : tk; DST[_j] = (unsigned)tk * (unsigned)rowbytes + soff; } } } while (0)
#define G8_STAGE() do { const int _sb = issued & 1; const char* _a = uptr(su.a + (size_t)skt * 128); const char* _b = uptr(su.b + (size_t)skt * 128); \
        _Pragma("unroll") for (int _j = 0; _j < 4; ++_j) __builtin_amdgcn_global_load_lds((const unsigned*)(_a + voffA[_j]), (LAS unsigned*)(lds + _sb * STG + _j * 8192 + ldsw), 16, 0, 0); \
        _Pragma("unroll") for (int _j = 0; _j < 4; ++_j) __builtin_amdgcn_global_load_lds((const unsigned*)(_b + voffB + (unsigned)(64 * _j) * (unsigned)rowbytes), (LAS unsigned*)(lds + _sb * STG + TA + _j * 8192 + ldsw), 16, 0, 0); \
        ++issued; if (++skt == su.nt) { skt = 0; ++si; su = nu; s_valid = n_valid; if constexpr (GATHER) { _Pragma("unroll") for (int _j = 0; _j < 4; ++_j) voffA[_j] = gnext[_j]; } \
            n_valid = s_valid && S.next(si + 1, nu); if (n_valid) G8_GATHER(nu, gnext); } } while (0)
    G8_GATHER(su, voffA);
    if (n_valid) G8_GATHER(nu, gnext);
    G8_STAGE();
    f32x4 acc[8][4];
    int ci = 0;
    for (;;) {
#pragma unroll
        for (int m = 0; m < 8; ++m)
#pragma unroll
            for (int n = 0; n < 4; ++n) acc[m][n] = (f32x4){0.f, 0.f, 0.f, 0.f};
#pragma unroll 1
        for (int kt = 0; kt < cu.nt; ++kt) {
            if (kt == 0 && ci > 0) asm volatile("s_waitcnt vmcnt(%0)" :: "n"(Epi::NST) : "memory");
            else asm volatile("s_waitcnt vmcnt(0)" ::: "memory");
            __builtin_amdgcn_s_barrier();
            asm volatile("" ::: "memory");
#if G8_PIPE
            if (wr == 0 && s_valid) G8_STAGE();
            __builtin_amdgcn_sched_barrier(0);
            const LAS unsigned char* sb = lds + (pos & 1) * STG;
            i32x8 bf[4], a0[2], a1[2];
#define G8_RDA(dst, m0) do { _Pragma("unroll") for (int _m = 0; _m < 2; ++_m) { dst[_m].lo = *(const LAS i32x4*)(sb + ard + ((m0) + _m) * 2048 + c0); dst[_m].hi = *(const LAS i32x4*)(sb + ard + ((m0) + _m) * 2048 + c1); } } while (0)
#define G8_MM(src, m0) do { _Pragma("unroll") for (int _m = 0; _m < 2; ++_m) _Pragma("unroll") for (int n = 0; n < 4; ++n) \
                acc[(m0) + _m][n] = __builtin_amdgcn_mfma_scale_f32_16x16x128_f8f6f4(bf[n], src[_m], acc[(m0) + _m][n], 0, 0, 0, 0x7f7f7f7f, 0, 0x7f7f7f7f); } while (0)
#pragma unroll
            for (int n = 0; n < 4; ++n) { bf[n].lo = *(const LAS i32x4*)(sb + brd + n * 2048 + c0); bf[n].hi = *(const LAS i32x4*)(sb + brd + n * 2048 + c1); }
            G8_RDA(a0, 0);
            __builtin_amdgcn_sched_barrier(0);
            G8_RDA(a1, 2);
            __builtin_amdgcn_sched_barrier(0);
            __builtin_amdgcn_s_setprio(1);
            G8_MM(a0, 0);
            __builtin_amdgcn_sched_barrier(0);
            G8_RDA(a0, 4);
            __builtin_amdgcn_sched_barrier(0);
            G8_MM(a1, 2);
            __builtin_amdgcn_sched_barrier(0);
#pragma unroll
            for (int m = 0; m < 4; ++m)
#pragma unroll
                for (int n = 0; n < 4; ++n) asm volatile("" : "+v"(acc[m][n]));
            G8_RDA(a1, 6);
            __builtin_amdgcn_sched_barrier(0);
            __builtin_amdgcn_s_setprio(0);
            if (wr == 1 && s_valid) G8_STAGE();
            __builtin_amdgcn_sched_barrier(0);
            __builtin_amdgcn_s_setprio(1);
            G8_MM(a0, 4);
            __builtin_amdgcn_sched_barrier(0);
            G8_MM(a1, 6);
            __builtin_amdgcn_s_setprio(0);
            __builtin_amdgcn_sched_barrier(0);
#undef G8_RDA
#undef G8_MM
#else
            if (s_valid) G8_STAGE();
            const LAS unsigned char* sb = lds + (pos & 1) * STG;
            i32x8 af[4], bf[4];
#pragma unroll
            for (int n = 0; n < 4; ++n) { bf[n].lo = *(const LAS i32x4*)(sb + brd + n * 2048 + c0); bf[n].hi = *(const LAS i32x4*)(sb + brd + n * 2048 + c1); }
#pragma unroll
            for (int mh = 0; mh < 2; ++mh) {
#pragma unroll
                for (int m = 0; m < 4; ++m) { af[m].lo = *(const LAS i32x4*)(sb + ard + (4 * mh + m) * 2048 + c0); af[m].hi = *(const LAS i32x4*)(sb + ard + (4 * mh + m) * 2048 + c1); }
                asm volatile("s_waitcnt lgkmcnt(0)" ::: "memory");
                __builtin_amdgcn_s_setprio(1);
#pragma unroll
                for (int m = 0; m < 4; ++m)
#pragma unroll
                    for (int n = 0; n < 4; ++n) acc[4 * mh + m][n] = __builtin_amdgcn_mfma_scale_f32_16x16x128_f8f6f4(bf[n], af[m], acc[4 * mh + m][n], 0, 0, 0, 0x7f7f7f7f, 0, 0x7f7f7f7f);
                __builtin_amdgcn_s_setprio(0);
                __builtin_amdgcn_sched_barrier(0);
            }
#endif
            ++pos;
        }
        { Unit eu = cu; eu.row0 = __builtin_amdgcn_readfirstlane(cu.row0); eu.k = __builtin_amdgcn_readfirstlane(cu.k); eu.pn = __builtin_amdgcn_readfirstlane(cu.pn); eu.split = __builtin_amdgcn_readfirstlane(cu.split); eu.part = __builtin_amdgcn_readfirstlane(cu.part); int ej = i16, eq = q; asm volatile("" : "+v"(ej), "+v"(eq)); E(acc, eu, wr, wc, ej, eq);
#if PROBE_EPI
          if (((PROBE_EPI >> Epi::PB) & 1) && !eu.split) { asm volatile("" ::: "memory");
#pragma unroll
            for (int m_ = 0; m_ < 8; ++m_)
#pragma unroll
              for (int n_ = 0; n_ < 4; ++n_) asm volatile("" : "+v"(acc[m_][n_]));
            Epi E2 = E; if constexpr (Epi::RMW) E2.s = 0.f; E2(acc, eu, wr, wc, ej, eq); }
#endif
          }
        ++ci; if (!S.next(ci, cu)) break;
    }
    asm volatile("s_waitcnt vmcnt(0)" ::: "memory");
    __builtin_amdgcn_s_barrier();
#undef G8_GATHER
#undef G8_STAGE
}

template <int LD>
struct EpiSwiglu8 {
    static constexpr bool RMW = false; static constexpr int NST = 8, PB = 0;
    unsigned char* T; float s;
    __device__ __forceinline__ void operator()(const f32x4 (&acc)[8][4], const Unit& u, int wr, int wc, int j, int q) const {
        unsigned char* base = T + ((size_t)u.k * MOE_ROWS + u.row0 + 128 * wr + j) * LD + u.pn * 128 + 32 * wc + 8 * q;
        const float kf = -s * 1.4426950408889634f, cf = 1.0f / (s * s);
        const f32x2 kk = {kf, kf}, cc = {cf, cf};
#pragma unroll
        for (int m = 0; m < 8; ++m) { f32x2 t[4];
#pragma unroll
            for (int n = 0; n < 2; ++n)
#pragma unroll
                for (int h = 0; h < 2; ++h) { const f32x2 a = {acc[m][n][2 * h], acc[m][n][2 * h + 1]}, b = {acc[m][n + 2][2 * h], acc[m][n + 2][2 * h + 1]};
                    const f32x2 ab = a * b, x = a * kk; f32x2 e; e[0] = __builtin_amdgcn_exp2f(x[0]); e[1] = __builtin_amdgcn_exp2f(x[1]);
                    const f32x2 d = e * cc + cc; f32x2 r; r[0] = __builtin_amdgcn_rcpf(d[0]); r[1] = __builtin_amdgcn_rcpf(d[1]);
                    t[2 * n + h] = ab * r; }
            u32x2 w; w.x = pk4_fp8(t[0][0], t[0][1], t[1][0], t[1][1]); w.y = pk4_fp8(t[2][0], t[2][1], t[3][0], t[3][1]); *(u32x2*)(base + (size_t)(16 * m) * LD) = w; }
    }
};
struct EpiMoeDown8 {
    static constexpr bool RMW = true; static constexpr int NST = 32, PB = 1;
    const int* rowtok; const float* rowp; const float* gate; float* out; float s; bf16* slab0; bf16* slab1; float* dump;
    __device__ __forceinline__ void operator()(const f32x4 (&acc)[8][4], const Unit& u, int wr, int wc, int j, int q) const {
        const int col0 = u.pn * 256 + 64 * wc + 4 * q, slot0 = u.k * MOE_ROWS + u.row0 + 128 * wr + j;
        bf16* sl = (u.k == 0 ? slab0 : slab1) + ((size_t)((((u.row0 >> 8) - 128) * 4 + u.pn) * MOE_P + u.part) << 16) + (size_t)(128 * wr + j) * 256 + 64 * wc + 4 * q;
        int tok[8]; float pv[8];
#pragma unroll
        for (int m = 0; m < 8; ++m) { tok[m] = rowtok[slot0 + 16 * m]; pv[m] = rowp[slot0 + 16 * m]; }
#pragma unroll
        for (int mb = 0; mb < 4; ++mb) {
            f32x4 gv[2][4], bs[2][4];
#pragma unroll
            for (int mm = 0; mm < 2; ++mm) { const int m = 2 * mb + mm, t = tok[m] < 0 ? 0 : tok[m]; const float* g = gate + (size_t)(t >> 11) * 6144 + col0; const float* o = out + (size_t)t * D + col0;
#pragma unroll
                for (int n = 0; n < 4; ++n) { gv[mm][n] = *(const f32x4*)(g + 16 * n); bs[mm][n] = *(const f32x4*)(o + 16 * n); } }
            __builtin_amdgcn_sched_barrier(0);
#pragma unroll
            for (int mm = 0; mm < 2; ++mm) { const int m = 2 * mb + mm; const float p = pv[m] * s; float* o = (tok[m] >= 0 ? out + (size_t)tok[m] * D : dump) + col0;
#pragma unroll
                for (int n = 0; n < 4; ++n) { const f32x4 v = (gv[mm][n] * p) * acc[m][n];
                    if (u.split) { u32x2 w; w.x = cvt_pk_bf16(v[0], v[1]); w.y = cvt_pk_bf16(v[2], v[3]); *(u32x2*)(sl + (size_t)(16 * m) * 256 + 16 * n) = w; }
                    else *(f32x4*)(o + 16 * n) = bs[mm][n] + v; } }
            __builtin_amdgcn_sched_barrier(0); }
    }
};
struct EpiResid8 {
    static constexpr bool RMW = true; static constexpr int NST = 32, PB = 2;
    float* xio; float* cio; const float* gate; float* slab; float s;
    __device__ __forceinline__ void operator()(const f32x4 (&acc)[8][4], const Unit& u, int wr, int wc, int j, int q) const {
        const int pm = u.row0 >> 8; float* io; const float* g;
        if (pm < RX / 256) { io = xio + (size_t)u.row0 * D; g = gate + (size_t)(pm >> 3) * 6144; } else { io = cio + (size_t)(u.row0 - RX) * D; g = gate + (size_t)16 * 6144; }
        const int col0 = u.pn * 256 + 64 * wc + 4 * q;
        f32x4 gv[4];
#pragma unroll
        for (int n = 0; n < 4; ++n) gv[n] = *(const f32x4*)(g + col0 + 16 * n) * s;
        float* sl = slab + ((size_t)(((pm - RX / 256) * 4 + u.pn) * FFN_P + u.part) << 16) + 64 * wc + 4 * q;
#pragma unroll
        for (int mb = 0; mb < 2; ++mb) {
            f32x4 bs[4][4];
            if (!u.split) {
#pragma unroll
                for (int mm = 0; mm < 4; ++mm)
#pragma unroll
                    for (int n = 0; n < 4; ++n) bs[mm][n] = *(const f32x4*)(io + (size_t)(128 * wr + 16 * (4 * mb + mm) + j) * D + col0 + 16 * n); }
            __builtin_amdgcn_sched_barrier(0);
#pragma unroll
            for (int mm = 0; mm < 4; ++mm) { const int m = 4 * mb + mm, rit = 128 * wr + 16 * m + j; float* o = io + (size_t)rit * D + col0;
#pragma unroll
                for (int n = 0; n < 4; ++n) { const f32x4 v = gv[n] * acc[m][n];
                    if (u.split) *(f32x4*)(sl + (size_t)rit * 256 + 16 * n) = v;
                    else *(f32x4*)(o + 16 * n) = bs[mm][n] + v; } }
            __builtin_amdgcn_sched_barrier(0); }
    }
};
}

struct Args { const float* in[33]; float* out; unsigned char* ws; int ph_lo, ph_hi; };
enum { I_X = 0, I_C, I_CTX, I_CCTX, I_MODW, I_MODB, I_N1G, I_N2G, I_WIN, I_WOUT, I_SCW, I_SCB, I_DTB, I_ALOG, I_SSDD, I_SNG, I_GNG, I_GNB, I_GWS, I_GBS, I_SCCW, I_CFW, I_CFB, I_CFG, I_CFNB,
       I_F1, I_F3, I_F2, I_RT, I_M1, I_M3, I_M2, I_FNG };
typedef const __attribute__((address_space(4))) Args* ArgsP;
struct Frame { LAS unsigned char* lds; int tid, lane, wave, vcu, G; unsigned char* ws; };

__device__ __forceinline__ void conv_job(const Frame& F, const float* W, int ldw, int K, int c0, int ncols, bf16* WT, int rowbase, int blk, int blkstride) {
    LAS float* scr = (LAS float*)(F.lds + F.wave * 16384);
    const int gw = F.vcu * 8 + F.wave, NGW = F.G * 8, lane = F.lane;
    const int nblk = ncols / 32, nitems = (K / 64) * nblk;
    for (int it = gw; it < nitems; it += NGW) {
        const int kb = it / nblk, nb = it % nblk, k0 = 64 * kb, n0 = 32 * nb;
        const int drow0 = rowbase + (n0 / blk) * blkstride + (n0 % blk);
#pragma unroll 8
        for (int i = 0; i < 32; ++i) { const int kk = 2 * i + (lane >> 5); scr[kk * 33 + (lane & 31)] = W[(size_t)(k0 + kk) * ldw + c0 + n0 + (lane & 31)]; }
        asm volatile("s_waitcnt lgkmcnt(0)" ::: "memory");
        const int c = lane & 7;
#pragma unroll
        for (int j = 0; j < 4; ++j) { const int n = (lane >> 3) + 8 * j; const LAS float* s = scr + (8 * c) * 33 + n;
            u32x4 o; o.x = cvt_pk_bf16(s[0 * 33], s[1 * 33]); o.y = cvt_pk_bf16(s[2 * 33], s[3 * 33]); o.z = cvt_pk_bf16(s[4 * 33], s[5 * 33]); o.w = cvt_pk_bf16(s[6 * 33], s[7 * 33]);
            *(u32x4*)(WT + (size_t)(drow0 + n) * K + k0 + 8 * c) = o; }
        asm volatile("s_waitcnt lgkmcnt(0)" ::: "memory");
    }
}

__device__ __forceinline__ void conv_job8(const Frame& F, const float* W, int ldw, int K, int ncols, unsigned char* WT, int mode, int half, float scale) {
    LAS float* scr = (LAS float*)(F.lds + F.wave * 16384);
    const int gw = F.vcu * 8 + F.wave, NGW = F.G * 8, lane = F.lane;
    const int nblk = ncols / 32, nitems = (K / 64) * nblk;
    for (int it = gw; it < nitems; it += NGW) {
        const int kb = it / nblk, nb = it % nblk, k0 = 64 * kb, n0 = 32 * nb;
#pragma unroll 8
        for (int i = 0; i < 32; ++i) { const int kk = 2 * i + (lane >> 5); scr[kk * 33 + (lane & 31)] = W[(size_t)(k0 + kk) * ldw + n0 + (lane & 31)] * scale; }
        asm volatile("s_waitcnt lgkmcnt(0)" ::: "memory");
        const int c = lane & 3;
#pragma unroll
        for (int jj = 0; jj < 2; ++jj) { const int n = (lane >> 2) + 16 * jj; const LAS float* sp = scr + (16 * c) * 33 + n;
            const int drow = mode == 0 ? n0 + n : (n0 >> 7) * 256 + ((n0 & 127) >> 5) * 64 + half * 32 + (16 * ((n >> 2) & 1) + 4 * (n >> 3) + (n & 3));
            u32x4 o; o.x = pk4_fp8(sp[0 * 33], sp[1 * 33], sp[2 * 33], sp[3 * 33]); o.y = pk4_fp8(sp[4 * 33], sp[5 * 33], sp[6 * 33], sp[7 * 33]);
            o.z = pk4_fp8(sp[8 * 33], sp[9 * 33], sp[10 * 33], sp[11 * 33]); o.w = pk4_fp8(sp[12 * 33], sp[13 * 33], sp[14 * 33], sp[15 * 33]);
            *(u32x4*)(WT + (size_t)drow * K + k0 + 16 * c) = o; }
        asm volatile("s_waitcnt lgkmcnt(0)" ::: "memory");
    }
}

__device__ __forceinline__ void p0_prologue(const Frame& F, ArgsP a) {
    unsigned char* ws = F.ws;
    if (F.vcu < 192) {
        LAS float* sc = (LAS float*)F.lds;
        LAS float* red = sc + 17 * 1024;
        for (int i = F.tid; i < 17 * 1024; i += 512) { const int b = i >> 10, k = i & 1023; const float v = b < 16 ? a->in[I_C][b * 1024 + k] : a->in[I_CCTX][k]; sc[i] = silu_f(v); }
        __syncthreads();
        float* modv = (float*)(ws + WS_MODV);
        for (int item = F.vcu; item < 192; item += F.G) {
            const int l = item / 96, cb = item % 96, col = cb * 64 + F.lane;
            const float* W = a->in[I_MODW] + (size_t)l * 1024 * 6144 + col;
            float acc[17];
#pragma unroll
            for (int b = 0; b < 17; ++b) acc[b] = 0.f;
            for (int k = F.wave * 128; k < F.wave * 128 + 128; ++k) { const float w = W[(size_t)k * 6144];
#pragma unroll
                for (int b = 0; b < 17; ++b) acc[b] += sc[b * 1024 + k] * w; }
#pragma unroll
            for (int b = 0; b < 17; ++b) red[(F.wave * 17 + b) * 64 + F.lane] = acc[b];
            __syncthreads();
            for (int o = F.tid; o < 17 * 64; o += 512) { const int b = o >> 6, ln = o & 63; float s = a->in[I_MODB][l * 6144 + cb * 64 + ln];
#pragma unroll
                for (int w = 0; w < 8; ++w) s += red[(w * 17 + b) * 64 + ln];
                modv[(size_t)(l * 17 + b) * 6144 + cb * 64 + ln] = s; }
            __syncthreads();
        }
    }
    __syncthreads();
    for (int l = 0; l < 2; ++l) {
        const float* win = a->in[I_WIN] + (size_t)l * D * INC; bf16* wt = (bf16*)(ws + WS_WIN) + (size_t)l * ZC * D;
        conv_job(F, win, INC, D, 0, 768, wt, 0, 1 << 30, 0);
        conv_job(F, win, INC, D, 776, 2048, wt, 768, 1 << 30, 0);
        conv_job(F, a->in[I_WOUT] + (size_t)l * D * D, D, D, 0, D, (bf16*)(ws + WS_WOUT) + (size_t)l * D * D, 0, 1 << 30, 0);
    }
#if FFN8
    conv_job8(F, a->in[I_F1], DFF, D, DFF, ws + WS_WUP, 1, 0, 64.0f);
    conv_job8(F, a->in[I_F3], DFF, D, DFF, ws + WS_WUP, 1, 1, 64.0f);
    conv_job8(F, a->in[I_F2], D, DFF, D, ws + WS_WDN, 0, 0, 64.0f);
#else
    conv_job(F, a->in[I_F1], DFF, D, 0, DFF, (bf16*)(ws + WS_WUP), 0, 128, 256);
    conv_job(F, a->in[I_F3], DFF, D, 0, DFF, (bf16*)(ws + WS_WUP), 128, 128, 256);
    conv_job(F, a->in[I_F2], D, DFF, 0, D, (bf16*)(ws + WS_WDN), 0, 1 << 30, 0);
#endif
    int* rowtok = (int*)(ws + WS_ROWTOK);
    for (int i = F.vcu * 512 + F.tid; i < 2 * MOE_ROWS; i += F.G * 512) rowtok[i] = -1;
    for (int i = F.vcu * 512 + F.tid; i < 2 * 4 * 128 * 128 / 2; i += F.G * 512) { const f32x2 v = *(const f32x2*)(a->in[I_GWS] + 2 * i); ((unsigned*)(ws + WS_WSB))[i] = cvt_pk_bf16(v[0], v[1]); }
}
__device__ __forceinline__ void moe_convert(const Frame& F, ArgsP a) {
    for (int e = 0; e < NE; ++e) {
        unsigned char* up = F.ws + WS_WMUP + (size_t)e * 2 * EFF * D;
        conv_job8(F, a->in[I_M1] + (size_t)e * D * EFF, EFF, D, EFF, up, 1, 0, 64.0f);
        conv_job8(F, a->in[I_M3] + (size_t)e * D * EFF, EFF, D, EFF, up, 1, 1, 64.0f);
        conv_job8(F, a->in[I_M2] + (size_t)e * EFF * D, D, EFF, D, F.ws + WS_WMDN + (size_t)e * D * EFF, 0, 0, 64.0f);
    }
}

template <int MODE>
__device__ __forceinline__ void norm_phase(const Frame& F, ArgsP a, int l, int nrows, const float* xsrc, const float* csrc, const float* gain, int slot_shift, int slot_scale, const float* fslab = nullptr) {
    unsigned char* ws = F.ws;
    LAS float* wx = (LAS float*)F.lds;
    LAS int* hist = (LAS int*)(F.lds + 8 * 1024 * 4);
    if (MODE == 0 || MODE == 2) {
        for (int i = F.tid; i < 8192; i += 512) { const int k = i >> 3, j = i & 7; wx[j * 1024 + k] = (MODE == 0) ? a->in[I_WIN][(size_t)l * D * INC + (size_t)k * INC + 768 + j] : a->in[I_RT][k * 8 + j]; }
        if (F.tid < 16) hist[F.tid] = 0;
        __syncthreads();
    }
    const float* modv = (const float*)(ws + WS_MODV) + (size_t)l * 17 * 6144;
    bf16* H = (bf16*)(ws + WS_H);
    const int gw = F.vcu * 8 + F.wave, NGW = F.G * 8, lane = F.lane;
    f32x4 gv[4];
#pragma unroll
    for (int j = 0; j < 4; ++j) gv[j] = *(const f32x4*)(gain + 4 * lane + 256 * j);
    for (int r = gw; r < nrows; r += NGW) {
        const float* xr; int mb;
        if (r < RX) { xr = xsrc + (size_t)r * D; mb = r >> 11; } else { xr = csrc + (size_t)(r - RX) * D; mb = 16; }
        const float* mv = modv + (size_t)mb * 6144;
        f32x4 v[4]; float ss = 0.f;
#pragma unroll
        for (int j = 0; j < 4; ++j) { v[j] = *(const f32x4*)(xr + 4 * lane + 256 * j);
            if (fslab != nullptr && r >= RX) {
#pragma unroll
                for (int part = 0; part < FFN_P; ++part) v[j] += *(const f32x4*)(fslab + ((size_t)((((r - RX) >> 8) * 4 + j) * FFN_P + part) << 16) + (size_t)((r - RX) & 255) * 256 + 4 * lane); }
            ss += (v[j][0] * v[j][0] + v[j][1] * v[j][1]) + (v[j][2] * v[j][2] + v[j][3] * v[j][3]); }
        const float rstd = 1.0f / sqrtf(wave_sum(ss) * (1.0f / D) + 1e-6f);
        float e[8];
#pragma unroll
        for (int q = 0; q < 8; ++q) e[q] = 0.f;
#pragma unroll
        for (int j = 0; j < 4; ++j) {
            const f32x4 sh = *(const f32x4*)(mv + slot_shift * 1024 + 4 * lane + 256 * j), sc = *(const f32x4*)(mv + slot_scale * 1024 + 4 * lane + 256 * j);
            const f32x4 hv = (v[j] * rstd) * gv[j] * (sc + 1.0f) + sh;
            if (MODE >= 2) *(unsigned*)((unsigned char*)H + (size_t)r * D + 4 * lane + 256 * j) = pk4_fp8(hv[0], hv[1], hv[2], hv[3]);
            else { u32x2 w; w.x = cvt_pk_bf16(hv[0], hv[1]); w.y = cvt_pk_bf16(hv[2], hv[3]); *(u32x2*)(H + (size_t)r * D + 4 * lane + 256 * j) = w; }
            if (MODE == 0 || MODE == 2) {
#pragma unroll
                for (int q = 0; q < 8; ++q) { const f32x4 wv = *(const LAS f32x4*)(wx + q * 1024 + 4 * lane + 256 * j); e[q] += (hv[0] * wv[0] + hv[1] * wv[1]) + (hv[2] * wv[2] + hv[3] * wv[3]); }
            }
        }
        if (MODE == 0) {
#pragma unroll
            for (int q = 0; q < 8; ++q) e[q] = wave_sum(e[q]);
            float mine = 0.f;
#pragma unroll
            for (int q = 0; q < 8; ++q) mine = (lane == q) ? e[q] : mine;
            if (lane < 8) ((float*)(ws + WS_DT))[(size_t)r * 8 + lane] = softplus_f(mine + a->in[I_DTB][l * 8 + lane]);
        }
        if (MODE == 2) {
#pragma unroll
            for (int q = 0; q < 8; ++q) e[q] = wave_sum(e[q]);
            int i0 = 0; float v0 = e[0];
#pragma unroll
            for (int q = 1; q < 8; ++q) if (e[q] > v0) { v0 = e[q]; i0 = q; }
            int i1 = -1; float v1 = -3.0e38f;
#pragma unroll
            for (int q = 0; q < 8; ++q) if (q != i0 && e[q] > v1) { v1 = e[q]; i1 = q; }
            const float p0 = 1.0f / (1.0f + __expf(v1 - v0)), p1 = 1.0f - p0;
            if (lane == 0) { int* te = (int*)(ws + WS_TOPE) + (size_t)r * 2; te[0] = i0; te[1] = i1; float* tp = (float*)(ws + WS_TOPP) + (size_t)r * 2; tp[0] = p0; tp[1] = p1;
                __hip_atomic_fetch_add(&hist[i0], 1, __ATOMIC_RELAXED, __HIP_MEMORY_SCOPE_WORKGROUP); __hip_atomic_fetch_add(&hist[8 + i1], 1, __ATOMIC_RELAXED, __HIP_MEMORY_SCOPE_WORKGROUP); }
        }
    }
    if (MODE == 2) {
        __syncthreads();
        if (F.tid < 16 && hist[F.tid] != 0) atomicAdd((unsigned*)(ws + WS_CTL) + CW_CNT + F.tid, (unsigned)hist[F.tid]);
    }
    __syncthreads();
}

__device__ __forceinline__ void chunk_geom(int c, int& r0, int& seq_lo, int& seq_hi) {
    r0 = c * 128;
    if (c < NCHX) { seq_lo = (c >> 4) * SEQ; seq_hi = seq_lo + SEQ; } else { seq_lo = RX + ((c - NCHX) >> 1) * CTXL; seq_hi = seq_lo + CTXL; }
}

template <int PART>
__device__ __forceinline__ void a1_item(const Frame& F, ArgsP a, int l, int c) {
    unsigned char* ws = F.ws;
    const bf16* Z = (const bf16*)(ws + WS_Z); bf16* XBC = (bf16*)(ws + WS_XBC); bf16* XT = (bf16*)(ws + WS_XT);
    const float* DT = (const float*)(ws + WS_DT); float* ACS = (float*)(ws + WS_ACS); float* ST = (float*)(ws + WS_ST);
    const float* scw = a->in[I_SCW] + (size_t)l * 5 * 768; const float* scb = a->in[I_SCB] + (size_t)l * 768;
    LAS bf16* RAW = (LAS bf16*)F.lds;
    LAS bf16* BT = (LAS bf16*)(F.lds + 33792);
    LAS bf16* XF = (LAS bf16*)(F.lds + 68608);
    LAS bf16* XB = (LAS bf16*)(F.lds + 103424);
    LAS float* wts = (LAS float*)(F.lds + 138240);
    int lane = F.lane; asm volatile("" : "+v"(lane)); const int wave = F.wave, tid = wave * 64 + lane, lj = lane & 15, lq = lane >> 4;
    int r0, slo, shi; chunk_geom(c, r0, slo, shi);
    __syncthreads();
    if (PART < 2 && wave < 4) {
        const int h = 2 * PART + (wave >> 1), dir = wave & 1; const float av = -__expf(a->in[I_ALOG][l * 8 + dir * 4 + h]);
        const int la = dir == 0 ? 2 * lane : 127 - 2 * lane, lb = dir == 0 ? 2 * lane + 1 : 126 - 2 * lane;
        const float da = DT[(size_t)(r0 + la) * 8 + dir * 4 + h], db = DT[(size_t)(r0 + lb) * 8 + dir * 4 + h];
        const float s0 = av * da, s1 = s0 + av * db;
        float inc = s1;
#pragma unroll
        for (int o = 1; o < 64; o <<= 1) { const float t = __shfl_up(inc, o); if (lane >= o) inc += t; }
        const float pre = inc - s1, ca = pre + s0, cb = pre + s1, tot = __shfl(inc, 63);
        ACS[(size_t)(r0 + la) * 8 + dir * 4 + h] = ca; ACS[(size_t)(r0 + lb) * 8 + dir * 4 + h] = cb;
        wts[(h * 2 + dir) * 128 + la] = __expf(tot - ca) * da; wts[(h * 2 + dir) * 128 + lb] = __expf(tot - cb) * db;
    }
    if (PART < 2) { const int g = PART;
#pragma unroll
        for (int pass = 0; pass < 2; ++pass) {
            const int xc0 = pass == 0 ? 256 + g * 128 : g * 128;
            __syncthreads();
            { u32x4 rv[5];
#pragma unroll
                for (int i = 0; i < 5; ++i) { const int t = tid + 512 * i, row = t >> 4, seg = t & 15, rr = r0 - 2 + row; const int rc = rr < slo ? slo : (rr >= shi ? shi - 1 : rr);
                    rv[i] = *(const u32x4*)(Z + (size_t)rc * ZC + xc0 + seg * 8); }
#pragma unroll
                for (int i = 0; i < 5; ++i) { const int t = tid + 512 * i, row = t >> 4, seg = t & 15, rr = r0 - 2 + row; const bool ok = rr >= slo && rr < shi;
                    if (t < 132 * 16) *(LAS u32x4*)(RAW + row * 128 + seg * 8) = ok ? rv[i] : (u32x4){0u, 0u, 0u, 0u}; } }
            __syncthreads();
            const int ch = tid & 127;
            float w[5];
#pragma unroll
            for (int k = 0; k < 5; ++k) w[k] = scw[k * 768 + xc0 + ch];
            const float bias = scb[xc0 + ch];
#pragma unroll 2
            for (int i = 0; i < 4; ++i) { const int lb = (tid >> 7) + 4 * i;
                const LAS bf16* rp = RAW + (8 * lb) * 128 + ch;
                float in[12];
#pragma unroll
                for (int t = 0; t < 12; ++t) in[t] = __uint_as_float((unsigned)rp[t * 128] << 16);
                float o[8];
#pragma unroll
                for (int jj = 0; jj < 8; ++jj) { float sacc = bias;
#pragma unroll
                    for (int k = 0; k < 5; ++k) sacc += w[k] * in[jj + k];
                    o[jj] = silu_f(sacc); }
                if (pass == 0) {
                    *(LAS u32x4*)(BT + ch * 136 + 8 * lb) = pack8(o);
#pragma unroll
                    for (int jj = 0; jj < 8; ++jj) XBC[(size_t)(r0 + 8 * lb + jj) * 768 + xc0 + ch] = (bf16)(cvt_pk_bf16(o[jj], 0.f) & 0xffffu);
                } else {
                    *(u32x4*)(XT + ((size_t)c * 256 + xc0 + ch) * 128 + 8 * lb) = pack8(o);
                    const int h = 2 * g + (ch >> 6);
                    const f32x4 f0 = *(const LAS f32x4*)(wts + (h * 2) * 128 + 8 * lb), f1 = *(const LAS f32x4*)(wts + (h * 2) * 128 + 8 * lb + 4);
                    const f32x4 b0 = *(const LAS f32x4*)(wts + (h * 2 + 1) * 128 + 8 * lb), b1 = *(const LAS f32x4*)(wts + (h * 2 + 1) * 128 + 8 * lb + 4);
                    float of[8], ob[8];
#pragma unroll
                    for (int jj = 0; jj < 4; ++jj) { of[jj] = o[jj] * f0[jj]; of[4 + jj] = o[4 + jj] * f1[jj]; ob[jj] = o[jj] * b0[jj]; ob[4 + jj] = o[4 + jj] * b1[jj]; }
                    *(LAS u32x4*)(XF + ch * 136 + 8 * lb) = pack8(of); *(LAS u32x4*)(XB + ch * 136 + 8 * lb) = pack8(ob);
                }
            }
        }
        __syncthreads();
        {
            const int hl = wave >> 2, dir = (wave >> 1) & 1, nh = wave & 1, h = 2 * g + hl;
            const LAS bf16* Ub = BT + (64 * nh + lj) * 136 + 8 * lq;
            const LAS bf16* Vb = (dir ? XB : XF) + (64 * hl + lj) * 136 + 8 * lq;
            f32x4 acc[4][4];
#pragma unroll
            for (int nt = 0; nt < 4; ++nt)
#pragma unroll
                for (int pt = 0; pt < 4; ++pt) acc[nt][pt] = (f32x4){0.f, 0.f, 0.f, 0.f};
#pragma unroll
            for (int k = 0; k < 4; ++k) { bf16x8 uf[4], vf[4];
#pragma unroll
                for (int t = 0; t < 4; ++t) { uf[t] = *(const LAS bf16x8*)(Ub + t * 16 * 136 + 32 * k); vf[t] = *(const LAS bf16x8*)(Vb + t * 16 * 136 + 32 * k); }
#pragma unroll
                for (int nt = 0; nt < 4; ++nt)
#pragma unroll
                    for (int pt = 0; pt < 4; ++pt) acc[nt][pt] = __builtin_amdgcn_mfma_f32_16x16x32_bf16(uf[nt], vf[pt], acc[nt][pt], 0, 0, 0); }
            float* sp = ST + ((size_t)(c * 2 + dir) * 4 + h) * 8192;
#pragma unroll
            for (int nt = 0; nt < 4; ++nt)
#pragma unroll
                for (int pt = 0; pt < 4; ++pt) *(f32x4*)(sp + (16 * pt + lj) * 128 + 64 * nh + 16 * nt + 4 * lq) = acc[nt][pt];
        }
    }
    if (PART == 2) { LAS bf16* RAW2 = (LAS bf16*)(F.lds + 33792);
        { u32x4 rv[9];
#pragma unroll
            for (int i = 0; i < 9; ++i) { const int t = tid + 512 * i, row = t >> 5, seg = t & 31, rr = r0 - 2 + row; const int rc = rr < slo ? slo : (rr >= shi ? shi - 1 : rr);
                rv[i] = *(const u32x4*)(Z + (size_t)rc * ZC + ZO_C + seg * 8); }
#pragma unroll
            for (int i = 0; i < 9; ++i) { const int t = tid + 512 * i, row = t >> 5, seg = t & 31, rr = r0 - 2 + row; const bool ok = rr >= slo && rr < shi;
                if (t < 132 * 32) *(LAS u32x4*)(RAW2 + row * 256 + seg * 8) = ok ? rv[i] : (u32x4){0u, 0u, 0u, 0u}; } }
        __syncthreads();
        const int cg = tid & 31, ch = 512 + cg * 8;
        f32x4 cw0[5], cw1[5];
#pragma unroll
        for (int k = 0; k < 5; ++k) { cw0[k] = *(const f32x4*)(scw + k * 768 + ch); cw1[k] = *(const f32x4*)(scw + k * 768 + ch + 4); }
        const f32x4 cb0 = *(const f32x4*)(scb + ch), cb1 = *(const f32x4*)(scb + ch + 4);
#pragma unroll 2
        for (int i = 0; i < 8; ++i) { const int lr = (tid >> 5) + 16 * i;
            float acc[8];
            acc[0] = cb0[0]; acc[1] = cb0[1]; acc[2] = cb0[2]; acc[3] = cb0[3]; acc[4] = cb1[0]; acc[5] = cb1[1]; acc[6] = cb1[2]; acc[7] = cb1[3];
#pragma unroll
            for (int k = 0; k < 5; ++k) { float zv[8]; unpack8(*(const LAS u32x4*)(RAW2 + (lr + k) * 256 + cg * 8), zv);
                const f32x4 w0 = cw0[k], w1 = cw1[k];
                acc[0] += w0[0] * zv[0]; acc[1] += w0[1] * zv[1]; acc[2] += w0[2] * zv[2]; acc[3] += w0[3] * zv[3]; acc[4] += w1[0] * zv[4]; acc[5] += w1[1] * zv[5]; acc[6] += w1[2] * zv[6]; acc[7] += w1[3] * zv[7]; }
#pragma unroll
            for (int jj = 0; jj < 8; ++jj) acc[jj] = silu_f(acc[jj]);
            *(u32x4*)(XBC + (size_t)(r0 + lr) * 768 + ch) = pack8(acc); }
    }
}

__device__ __forceinline__ void a2_item(const Frame& F, ArgsP a, int l, int c) {
    unsigned char* ws = F.ws;
    const bf16* Z = (const bf16*)(ws + WS_Z); bf16* MIX = (bf16*)(ws + WS_H); const bf16* WSB = (const bf16*)(ws + WS_WSB);
    LAS bf16* VT = (LAS bf16*)F.lds;
    int lane = F.lane; asm volatile("" : "+v"(lane)); const int wave = F.wave, lj = lane & 15, lq = lane >> 4, r0 = c * 128;
    __syncthreads();
    {
        float gg[4], bbv[4];
#pragma unroll
        for (int e = 0; e < 4; ++e) { gg[e] = a->in[I_GNG][l * 256 + lane + 64 * e]; bbv[e] = a->in[I_GNB][l * 256 + lane + 64 * e]; }
#pragma unroll
        for (int hb = 0; hb < 2; ++hb) {
            bf16 raw[8][4];
#pragma unroll
            for (int i = 0; i < 8; ++i)
#pragma unroll
                for (int e = 0; e < 4; ++e) raw[i][e] = Z[(size_t)(r0 + 16 * wave + 8 * hb + i) * ZC + ZO_V + lane + 64 * e];
            float o[4][8];
#pragma unroll
            for (int i = 0; i < 8; ++i) { float v[4];
#pragma unroll
                for (int e = 0; e < 4; ++e) v[e] = gelu_tanh_f(__uint_as_float((unsigned)raw[i][e] << 16));
                const float mu = wave_sum((v[0] + v[1]) + (v[2] + v[3])) * (1.0f / 256.0f);
#pragma unroll
                for (int e = 0; e < 4; ++e) v[e] -= mu;
                const float rs = 1.0f / sqrtf(wave_sum((v[0] * v[0] + v[1] * v[1]) + (v[2] * v[2] + v[3] * v[3])) * (1.0f / 256.0f) + 1e-5f);
#pragma unroll
                for (int e = 0; e < 4; ++e) o[e][i] = v[e] * rs * gg[e] + bbv[e]; }
#pragma unroll
            for (int e = 0; e < 4; ++e) *(LAS u32x4*)(VT + (lane + 64 * e) * 136 + 16 * wave + 8 * hb) = pack8(o[e]);
        }
    }
    __syncthreads();
    const int g = wave >> 1, th = wave & 1;
    const LAS bf16* Ub = VT + (g * 64 + lj) * 136 + 8 * lq;
    const bf16* Vg = WSB + ((size_t)(l * 4 + g) * 128 + 64 * th + lj) * 128 + 8 * lq;
    f32x4 acc[4][4];
#pragma unroll
    for (int dt = 0; dt < 4; ++dt)
#pragma unroll
        for (int tt = 0; tt < 4; ++tt) acc[dt][tt] = (f32x4){0.f, 0.f, 0.f, 0.f};
    __builtin_amdgcn_sched_barrier(0);
    bf16x8 vfa[4][4];
#pragma unroll
    for (int k = 0; k < 4; ++k)
#pragma unroll
        for (int t = 0; t < 4; ++t) vfa[k][t] = *(const bf16x8*)(Vg + t * 16 * 128 + 32 * k);
#pragma unroll
    for (int k = 0; k < 4; ++k) { bf16x8 uf[4];
#pragma unroll
        for (int t = 0; t < 4; ++t) uf[t] = *(const LAS bf16x8*)(Ub + t * 16 * 136 + 32 * k);
#pragma unroll
        for (int dt = 0; dt < 4; ++dt)
#pragma unroll
            for (int tt = 0; tt < 4; ++tt) acc[dt][tt] = __builtin_amdgcn_mfma_f32_16x16x32_bf16(uf[dt], vfa[k][tt], acc[dt][tt], 0, 0, 0); }
    __builtin_amdgcn_sched_barrier(0);
    u32x2 uwa[4][4];
#pragma unroll
    for (int tt = 0; tt < 4; ++tt)
#pragma unroll
        for (int dt = 0; dt < 4; ++dt) uwa[tt][dt] = *(const u32x2*)(Z + (size_t)(r0 + 64 * th + 16 * tt + lj) * ZC + ZO_U + g * 64 + 16 * dt + 4 * lq);
#pragma unroll
    for (int tt = 0; tt < 4; ++tt) { const int t = 64 * th + 16 * tt + lj, r = r0 + t; const float bs = a->in[I_GBS][((size_t)l * 4 + g) * 128 + t];
#pragma unroll
        for (int dt = 0; dt < 4; ++dt) { const int ch0 = g * 64 + 16 * dt + 4 * lq; const u32x2 uw = uwa[tt][dt]; const f32x4 sv4 = acc[dt][tt];
            u32x2 ow; ow.x = cvt_pk_bf16(gelu_tanh_f(bflo(uw.x)) * (sv4[0] + bs), gelu_tanh_f(bfhi(uw.x)) * (sv4[1] + bs)); ow.y = cvt_pk_bf16(gelu_tanh_f(bflo(uw.y)) * (sv4[2] + bs), gelu_tanh_f(bfhi(uw.y)) * (sv4[3] + bs));
            *(u32x2*)(MIX + (size_t)r * D + 256 + ch0) = ow; } }
}

__device__ __forceinline__ void a3_item(const Frame& F, ArgsP a, int l, int c) {
    unsigned char* ws = F.ws;
    const bf16* Z = (const bf16*)(ws + WS_Z); bf16* MIX = (bf16*)(ws + WS_H);
    int lane = F.lane; asm volatile("" : "+v"(lane)); const int wave = F.wave, tid = wave * 64 + lane;
    int r0, slo, shi; chunk_geom(c, r0, slo, shi);
    {
        { const float* w = a->in[I_SCCW] + (size_t)l * 3 * 256; const int ch = (tid & 31) * 8;
            f32x4 sw0[3], sw1[3];
#pragma unroll
            for (int k = 0; k < 3; ++k) { sw0[k] = *(const f32x4*)(w + k * 256 + ch); sw1[k] = *(const f32x4*)(w + k * 256 + ch + 4); }
#pragma unroll 1
            for (int bt = 0; bt < 2; ++bt) {
                u32x4 gcv[4][3], xiv[4][3], gbv[4];
#pragma unroll
                for (int t4 = 0; t4 < 4; ++t4) { const int lr = (tid >> 5) + 16 * (4 * bt + t4), r = r0 + lr;
#pragma unroll
                    for (int k = 0; k < 3; ++k) { const int rr = r + k - 1; const int rc = rr < slo ? slo : (rr >= shi ? shi - 1 : rr);
                        gcv[t4][k] = *(const u32x4*)(Z + (size_t)rc * ZC + ZO_GC + ch); xiv[t4][k] = *(const u32x4*)(Z + (size_t)rc * ZC + ZO_XIN + ch); }
                    gbv[t4] = *(const u32x4*)(Z + (size_t)r * ZC + ZO_GB + ch); }
#pragma unroll
                for (int t4 = 0; t4 < 4; ++t4) { const int lr = (tid >> 5) + 16 * (4 * bt + t4), r = r0 + lr;
                    float acc[8];
#pragma unroll
                    for (int j = 0; j < 8; ++j) acc[j] = 0.f;
#pragma unroll
                    for (int k = 0; k < 3; ++k) { const int rr = r + k - 1; const float ok = (rr >= slo && rr < shi) ? 1.0f : 0.0f;
                        float gc[8], xi[8]; unpack8(gcv[t4][k], gc); unpack8(xiv[t4][k], xi);
                        const f32x4 w0 = sw0[k] * ok, w1 = sw1[k] * ok;
#pragma unroll
                        for (int j = 0; j < 4; ++j) { acc[j] += w0[j] * (gc[j] * xi[j]); acc[4 + j] += w1[j] * (gc[4 + j] * xi[4 + j]); } }
                    float gb[8]; unpack8(gbv[t4], gb);
#pragma unroll
                    for (int j = 0; j < 8; ++j) acc[j] *= gb[j];
                    *(u32x4*)(MIX + (size_t)r * D + 512 + ch) = pack8(acc); } } }
        {
            LAS bf16* glu = (LAS bf16*)F.lds;
            LAS float* cvb = (LAS float*)F.lds;
            __syncthreads();
#pragma unroll 1
            for (int bt = 0; bt < 2; ++bt) {
                u32x4 cav[5], cgv[5];
#pragma unroll
                for (int t5 = 0; t5 < 5; ++t5) { const int task = tid + 512 * (5 * bt + t5), i = task >> 5, ch = (task & 31) * 8, rr = r0 - 15 + i; const int rc = rr < slo ? slo : (rr >= shi ? shi - 1 : rr);
                    cav[t5] = *(const u32x4*)(Z + (size_t)rc * ZC + ZO_CA + ch); cgv[t5] = *(const u32x4*)(Z + (size_t)rc * ZC + ZO_CG + ch); }
#pragma unroll
                for (int t5 = 0; t5 < 5; ++t5) { const int task = tid + 512 * (5 * bt + t5), i = task >> 5, ch = (task & 31) * 8, rr = r0 - 15 + i; const float ok = (rr >= slo && rr < shi) ? 1.0f : 0.0f;
                    float ca[8], cg[8], o[8]; unpack8(cav[t5], ca); unpack8(cgv[t5], cg);
#pragma unroll
                    for (int j = 0; j < 8; ++j) o[j] = ok * ca[j] * sigmoid_f(cg[j]);
                    if (task < 158 * 32) *(LAS u32x4*)(glu + i * 256 + ch) = pack8(o); } }
            LAS float* wl = (LAS float*)(F.lds + 81920);
            { float wv[16];
#pragma unroll
                for (int i = 0; i < 16; ++i) { const int idx = tid + 512 * i; wv[i] = a->in[I_CFW][(size_t)l * 31 * 256 + (idx < 31 * 256 ? idx : 0)]; }
#pragma unroll
                for (int i = 0; i < 16; ++i) { const int idx = tid + 512 * i; if (idx < 31 * 256) wl[idx] = wv[i]; } }
            __syncthreads();
            const int ch = tid & 255, lh = tid >> 8;
            const LAS float* wp = wl + ch; const LAS bf16* gp = glu + (64 * lh) * 256 + ch; LAS float* cp = cvb + (64 * lh) * 256 + ch;
            float w[31];
#pragma unroll
            for (int k = 0; k < 31; ++k) w[k] = wp[k * 256];
            const float cfb = a->in[I_CFB][l * 256 + ch];
            float res[8][8];
#pragma unroll
            for (int jb = 0; jb < 8; ++jb) {
                bf16 gv[38];
#pragma unroll
                for (int i = 0; i < 38; ++i) gv[i] = gp[(8 * jb + i) * 256];
                __builtin_amdgcn_sched_barrier(0);
#pragma unroll
                for (int j = 0; j < 8; ++j) res[jb][j] = cfb;
#pragma unroll
                for (int i = 0; i < 38; ++i) { const float g = __uint_as_float((unsigned)gv[i] << 16);
#pragma unroll
                    for (int k = 0; k < 31; ++k) { const int lo = i - k; if (lo >= 0 && lo < 8) res[jb][lo] += w[k] * g; } }
                __builtin_amdgcn_sched_barrier(0);
            }
            __syncthreads();
#pragma unroll
            for (int jb = 0; jb < 8; ++jb)
#pragma unroll
                for (int j = 0; j < 8; ++j) cp[(8 * jb + j) * 256] = res[jb][j];
            __syncthreads();
            const f32x4 g = *(const f32x4*)(a->in[I_CFG] + l * 256 + 4 * lane), bb = *(const f32x4*)(a->in[I_CFNB] + l * 256 + 4 * lane);
            for (int lr = wave; lr < 128; lr += 8) { f32x4 v = *(const LAS f32x4*)(cvb + lr * 256 + 4 * lane);
                const float mu = wave_sum((v[0] + v[1]) + (v[2] + v[3])) * (1.0f / 256.0f); v = v - mu;
                const float var = wave_sum((v[0] * v[0] + v[1] * v[1]) + (v[2] * v[2] + v[3] * v[3])) * (1.0f / 256.0f);
                const f32x4 o = v * (1.0f / sqrtf(var + 1e-5f)) * g + bb;
                u32x2 ow; ow.x = cvt_pk_bf16(silu_f(o[0]), silu_f(o[1])); ow.y = cvt_pk_bf16(silu_f(o[2]), silu_f(o[3]));
                *(u32x2*)(MIX + (size_t)(r0 + lr) * D + 768 + 4 * lane) = ow; }
            __syncthreads();
        }
    }
}

__device__ __forceinline__ void pa_phase(const Frame& F, ArgsP a, int l, int nfull, int nall) {
    const int n2 = nfull, n3 = 2 * nfull, n4 = n3 + nall, n5 = n4 + nall, n6 = n5 + nall;
    for (int it = F.vcu; it < n6; it += F.G) {
        if (it < n2) a2_item(F, a, l, it);
        else if (it < n3) a3_item(F, a, l, it - n2);
        else if (it < n4) a1_item<0>(F, a, l, it - n3);
        else if (it < n5) a1_item<1>(F, a, l, it - n4);
        else a1_item<2>(F, a, l, it - n5);
    }
    __syncthreads();
}

__device__ __forceinline__ void m3_phase(const Frame& F) {
    unsigned char* ws = F.ws; const float* ST = (const float*)(ws + WS_ST); bf16* STE = (bf16*)(ws + WS_STE); const float* ACS = (const float*)(ws + WS_ACS);
    for (int task = F.vcu * 512 + F.tid; task < BATCH * 2 * 4 * 2048; task += F.G * 512) {
        const int q = task & 2047, h = (task >> 11) & 3, dir = (task >> 13) & 1, b = task >> 14;
        f32x4 e = {0.f, 0.f, 0.f, 0.f};
        for (int step = 0; step < 18; ++step) {
            int c;
            if (dir == 0) c = step < 2 ? NCHX + 2 * b + step : 16 * b + (step - 2);
            else c = step < 2 ? NCHX + 2 * b + (1 - step) : 16 * b + (17 - step);
            const float dec = __expf(dir == 0 ? ACS[(size_t)(c * 128 + 127) * 8 + h] : ACS[(size_t)(c * 128) * 8 + 4 + h]);
            const size_t eo = ((size_t)(c * 2 + dir) * 4 + h) * 8192 + (size_t)q * 4;
            const f32x4 s = *(const f32x4*)(ST + eo);
            u32x2 w; w.x = cvt_pk_bf16(e[0], e[1]); w.y = cvt_pk_bf16(e[2], e[3]); *(u32x2*)(STE + eo) = w;
            e = e * dec + s;
        }
    }
}

__device__ __forceinline__ void pc_phase(const Frame& F, ArgsP a, int l, int nchunks) {
    unsigned char* ws = F.ws;
    const bf16* Z = (const bf16*)(ws + WS_Z); const bf16* XBC = (const bf16*)(ws + WS_XBC); const bf16* XT = (const bf16*)(ws + WS_XT); const bf16* STE = (const bf16*)(ws + WS_STE);
    const float* DT = (const float*)(ws + WS_DT); const float* ACS = (const float*)(ws + WS_ACS); bf16* MIX = (bf16*)(ws + WS_H);
    LAS unsigned char* BL = F.lds;
    LAS unsigned char* XL = F.lds + 32768;
    LAS unsigned char* SL = F.lds + 65536;
    LAS float* sv = (LAS float*)(F.lds + 131072);
    LAS float* exch = sv + 2048;
    const int tid = F.tid, lane = F.lane, wave = F.wave, j = lane & 15, q = lane >> 4, lt = wave >> 1, hl = wave & 1;
    const int srow = tid >> 4, cpos = tid & 15;
    const unsigned ldsw = (unsigned)wave * 1024u;
    for (int item = F.vcu; item < nchunks * 2; item += F.G) {
        const int c = item >> 1, r0 = c * 128, l0 = 64 * (item & 1) + 16 * lt, lrow = l0 + j;
        __syncthreads();
        for (int i = tid; i < 1024; i += 512) { const int row = i >> 3, col = i & 7; sv[(col >> 2) * 512 + (col & 3) * 128 + row] = ACS[(size_t)(r0 + row) * 8 + col]; sv[1024 + (col >> 2) * 512 + (col & 3) * 128 + row] = DT[(size_t)(r0 + row) * 8 + col]; }
        f32x4 Yt[2][4];
#pragma unroll
        for (int g = 0; g < 2; ++g) {
            const int h = 2 * g + hl;
#pragma unroll
            for (int jj = 0; jj < 4; ++jj) { const int row = srow + 32 * jj; const int sc = 8 * (cpos ^ (row & 15));
                __builtin_amdgcn_global_load_lds((const unsigned*)(XBC + (size_t)(r0 + row) * 768 + 256 + g * 128 + sc), (LAS unsigned*)(BL + jj * 8192 + ldsw), 16, 0, 0);
                __builtin_amdgcn_global_load_lds((const unsigned*)(XT + ((size_t)c * 256 + g * 128 + row) * 128 + sc), (LAS unsigned*)(XL + jj * 8192 + ldsw), 16, 0, 0); }
#pragma unroll
            for (int b = 0; b < 4; ++b)
#pragma unroll
                for (int jj = 0; jj < 2; ++jj) { const int row = srow + 32 * jj; const int sc = 8 * (cpos ^ (row & 15));
                    __builtin_amdgcn_global_load_lds((const unsigned*)(STE + (((size_t)(c * 2 + (b & 1)) * 4 + 2 * g + (b >> 1)) * 64 + row) * 128 + sc), (LAS unsigned*)(SL + b * 16384 + jj * 8192 + ldsw), 16, 0, 0); }
            bf16x8 cf[4];
            { const bf16* Cn = XBC + (size_t)(r0 + lrow) * 768 + 512 + g * 128 + 8 * q;
#pragma unroll
                for (int k = 0; k < 4; ++k) cf[k] = *(const bf16x8*)(Cn + 32 * k); }
            asm volatile("s_waitcnt vmcnt(0)" ::: "memory");
            __syncthreads();
            f32x4 G[8];
#pragma unroll
            for (int st = 0; st < 8; ++st) { G[st] = (f32x4){0.f, 0.f, 0.f, 0.f};
#pragma unroll
                for (int k = 0; k < 4; ++k) G[st] = __builtin_amdgcn_mfma_f32_16x16x32_bf16(*(const LAS bf16x8*)(BL + (16 * st + j) * 256 + 16 * ((4 * k + q) ^ j)), cf[k], G[st], 0, 0, 0); }
            const float afl = sv[h * 128 + lrow], abl = sv[512 + h * 128 + lrow], Dh = a->in[I_SSDD][l * 4 + h];
            bf16x8 wf[4];
#pragma unroll
            for (int J = 0; J < 4; ++J) { float wv[8];
#pragma unroll
                for (int hf = 0; hf < 2; ++hf)
#pragma unroll
                    for (int r = 0; r < 4; ++r) { const int st = 2 * J + hf, sidx = 16 * st + 4 * q + r; float m = 0.f;
                        if (sidx <= lrow) m += fexp(afl - sv[h * 128 + sidx]) * sv[1024 + h * 128 + sidx];
                        if (sidx >= lrow) m += fexp(abl - sv[512 + h * 128 + sidx]) * sv[1536 + h * 128 + sidx];
                        wv[4 * hf + r] = G[st][r] * m + (sidx == lrow ? Dh : 0.f); }
                const u32x4 pk = pack8(wv); wf[J] = __builtin_bit_cast(bf16x8, pk); }
            f32x4 Y[4];
#pragma unroll
            for (int pt = 0; pt < 4; ++pt) { Y[pt] = (f32x4){0.f, 0.f, 0.f, 0.f}; const int row = hl * 64 + 16 * pt + j; const LAS unsigned char* xp = XL + row * 256 + 8 * (q & 1);
#pragma unroll
                for (int J = 0; J < 4; ++J) { const u32x2 lo = *(const LAS u32x2*)(xp + 16 * ((4 * J + (q >> 1)) ^ j)), hi = *(const LAS u32x2*)(xp + 16 * ((4 * J + 2 + (q >> 1)) ^ j)); const u32x4 xw = {lo.x, lo.y, hi.x, hi.y};
                    Y[pt] = __builtin_amdgcn_mfma_f32_16x16x32_bf16(__builtin_bit_cast(bf16x8, xw), wf[J], Y[pt], 0, 0, 0); } }
#pragma unroll
            for (int dir = 0; dir < 2; ++dir) { const float e = fexp(dir == 0 ? afl : abl); const LAS unsigned char* sp = SL + (hl * 2 + dir) * 16384;
#pragma unroll
                for (int pt = 0; pt < 4; ++pt) { f32x4 yd = {0.f, 0.f, 0.f, 0.f};
#pragma unroll
                    for (int k = 0; k < 4; ++k) yd = __builtin_amdgcn_mfma_f32_16x16x32_bf16(*(const LAS bf16x8*)(sp + (16 * pt + j) * 256 + 16 * ((4 * k + q) ^ j)), cf[k], yd, 0, 0, 0);
                    Y[pt] += yd * e; } }
#pragma unroll
            for (int pt = 0; pt < 4; ++pt) Yt[g][pt] = Y[pt];
            if (g == 0) __syncthreads();
        }
        float ssq = 0.f;
#pragma unroll
        for (int g = 0; g < 2; ++g)
#pragma unroll
            for (int pt = 0; pt < 4; ++pt) { const int ch = (2 * g + hl) * 64 + 16 * pt + 4 * q; const u32x2 zw = *(const u32x2*)(Z + (size_t)(r0 + lrow) * ZC + ZO_Z + ch);
                f32x4 v = Yt[g][pt]; v[0] *= silu_f(bflo(zw.x)); v[1] *= silu_f(bfhi(zw.x)); v[2] *= silu_f(bflo(zw.y)); v[3] *= silu_f(bfhi(zw.y)); Yt[g][pt] = v;
                ssq += (v[0] * v[0] + v[1] * v[1]) + (v[2] * v[2] + v[3] * v[3]); }
        ssq += __shfl_xor(ssq, 16); ssq += __shfl_xor(ssq, 32);
        if (q == 0) exch[(hl * 4 + lt) * 16 + j] = ssq;
        __syncthreads();
        const float rstd = 1.0f / sqrtf((exch[lt * 16 + j] + exch[(4 + lt) * 16 + j]) * (1.0f / 256.0f) + 1e-6f);
#pragma unroll
        for (int g = 0; g < 2; ++g)
#pragma unroll
            for (int pt = 0; pt < 4; ++pt) { const int ch = (2 * g + hl) * 64 + 16 * pt + 4 * q; const f32x4 ng = *(const f32x4*)(a->in[I_SNG] + l * 256 + ch); const f32x4 o = Yt[g][pt] * rstd * ng;
                u32x2 ow; ow.x = cvt_pk_bf16(o[0], o[1]); ow.y = cvt_pk_bf16(o[2], o[3]); *(u32x2*)(MIX + (size_t)(r0 + lrow) * D + ch) = ow; }
    }
    __syncthreads();
}

__device__ __forceinline__ void moe_assign(const Frame& F) {
    unsigned char* ws = F.ws; const unsigned* cnt = (const unsigned*)(ws + WS_CTL) + CW_CNT; unsigned* run = (unsigned*)(ws + WS_CTL) + CW_RUN;
    const int* tope = (const int*)(ws + WS_TOPE); const float* topp = (const float*)(ws + WS_TOPP); int* rowtok = (int*)(ws + WS_ROWTOK); float* rowp = (float*)(ws + WS_ROWP);
    int pre[2][8];
#pragma unroll
    for (int k = 0; k < 2; ++k) { int s = 0;
#pragma unroll
        for (int e = 0; e < 8; ++e) { pre[k][e] = s; s += ((int)__hip_atomic_load(cnt + k * 8 + e, RLX_AGENT) + 255) >> 8; } }
    const int gw = F.vcu * 8 + F.wave, NGW = F.G * 8, lane = F.lane;
    for (int base = gw * 64; base < RX; base += NGW * 64) {
        const int tok = base + lane;
#pragma unroll
        for (int k = 0; k < 2; ++k) { const int e = tope[(size_t)tok * 2 + k]; int slot = 0;
#pragma unroll
            for (int q = 0; q < 8; ++q) { const unsigned long long m = __ballot(e == q);
                if (m != 0ull) { unsigned b0 = 0; if (lane == 0) b0 = __hip_atomic_fetch_add(run + k * 8 + q, (unsigned)__popcll(m), RLX_AGENT); b0 = __shfl(b0, 0);
                    if (e == q) slot = 256 * pre[k][q] + (int)b0 + __popcll(m & ((1ull << lane) - 1ull)); } }
            rowtok[k * MOE_ROWS + slot] = tok; rowp[k * MOE_ROWS + slot] = topp[(size_t)tok * 2 + k]; ((int*)(ws + WS_SLOT))[k * RX + tok] = slot; }
    }
}

__device__ __forceinline__ void final_norm(const Frame& F, ArgsP a) {
    const int gw = F.vcu * 8 + F.wave, NGW = F.G * 8, lane = F.lane;
    f32x4 gv[4];
#pragma unroll
    for (int j = 0; j < 4; ++j) gv[j] = *(const f32x4*)(a->in[I_FNG] + 4 * lane + 256 * j);
    for (int r = gw; r < RX; r += NGW) { float* xr = a->out + (size_t)r * D; f32x4 v[4]; float ss = 0.f;
#pragma unroll
        for (int j = 0; j < 4; ++j) v[j] = *(const f32x4*)(xr + 4 * lane + 256 * j);
#pragma unroll
        for (int k = 0; k < 2; ++k) { const int sl = ((const int*)(F.ws + WS_SLOT))[k * RX + r];
            if (sl >= 128 * 256) {
                const bf16* sb = (const bf16*)(F.ws + (k == 0 ? WS_MSLAB0 : WS_MSLAB1)) + (size_t)(sl & 255) * 256 + 4 * lane; const int tl = (sl >> 8) - 128;
#pragma unroll
                for (int j = 0; j < 4; ++j)
#pragma unroll
                    for (int part = 0; part < MOE_P; ++part) { const u32x2 w = *(const u32x2*)(sb + ((size_t)((tl * 4 + j) * MOE_P + part) << 16)); v[j][0] += bflo(w.x); v[j][1] += bfhi(w.x); v[j][2] += bflo(w.y); v[j][3] += bfhi(w.y); } } }
#pragma unroll
        for (int j = 0; j < 4; ++j) ss += (v[j][0] * v[j][0] + v[j][1] * v[j][1]) + (v[j][2] * v[j][2] + v[j][3] * v[j][3]);
        const float rstd = 1.0f / sqrtf(wave_sum(ss) * (1.0f / D) + 1e-6f);
#pragma unroll
        for (int j = 0; j < 4; ++j) *(f32x4*)(xr + 4 * lane + 256 * j) = v[j] * rstd * gv[j]; }
}

__device__ __forceinline__ void phase_begin(Frame& F, int wave0) {
    int w = wave0; asm volatile("" : "+s"(w));
    int ln = (int)__builtin_amdgcn_mbcnt_hi(~0u, __builtin_amdgcn_mbcnt_lo(~0u, 0u)); asm volatile("" : "+v"(ln));
    F.wave = w; F.lane = ln; F.tid = w * 64 + ln; }
enum { PH_P0 = 0, PH0_N1, PH0_WIN, PH0_MA, PH0_M3, PH0_MC, PH0_WOUT, PH0_N2, PH0_UP, PH0_DN,
       PH1_N1, PH1_WIN, PH1_MA, PH1_M3, PH1_MC, PH1_WOUT, PH1_N2R, PH1_ASG, PH1_UP, PH1_DN0, PH1_DN1, PH_FIN, NPHASE };
__global__ void __launch_bounds__(512, 2) fwd_kernel(Args args_unused) {
    extern __shared__ __attribute__((aligned(16))) unsigned char lds_raw[];
    ArgsP ap = (ArgsP)__builtin_amdgcn_kernarg_segment_ptr();
    Frame F;
    F.lds = (LAS unsigned char*)lds_raw;
    const int wave0 = __builtin_amdgcn_readfirstlane((int)threadIdx.x >> 6);
    phase_begin(F, wave0);
    F.G = gridDim.x; { const int bx = blockIdx.x; F.vcu = (F.G % 8 == 0) ? (bx % 8) * (F.G / 8) + bx / 8 : bx; }
    F.ws = ap->ws;
    volatile LAS unsigned* MISC = (volatile LAS unsigned*)(F.lds + MISC_OFF);
    if (F.tid < 64) MISC[F.tid] = 0u;
    __syncthreads();
    XcdBarrier bar; bar.bar = (unsigned*)(ap->ws + WS_CTL) + CW_BAR; bar.x = 0; bar.st = nullptr;
    const int lo = ap->ph_lo, hi = ap->ph_hi;
    if (hi - lo > 1) bar = xcd_barrier_post((unsigned*)(ap->ws + WS_CTL) + CW_BAR, MISC + 8, F.tid);
#define IN(k) (phase_begin(F, wave0), ({ asm volatile("" : "+s"(ap)); }), F.ws = ap->ws, lo <= (k) && (k) < hi)
#define SEAM(k) do { if (IN(k) && IN((k) + 1)) xcd_barrier(bar, F.tid); } while (0)
    const int c = (int)blockIdx.x;
#define XC ((float*)(F.ws + WS_XC))
#define H ((bf16*)(F.ws + WS_H))
#define Zb ((bf16*)(F.ws + WS_Z))
#define modv ((const float*)(F.ws + WS_MODV))
#define ctl ((unsigned*)(F.ws + WS_CTL))

    if (IN(PH_P0)) { p0_prologue(F, ap); } SEAM(PH_P0);
    if (IN(PH0_N1)) { norm_phase<0>(F, ap, 0, RT, ap->in[I_X], ap->in[I_CTX], ap->in[I_N1G], 0, 1); } SEAM(PH0_N1);
    if (IN(PH0_WIN)) { pg8::RegSched S; S.init(H, F.ws + WS_WIN, D, RT / 256, ZC / 256, 0, 1, 0, F.G, c); pg8::EpiStoreBf16 E{Zb, ZC};
        pg8::gemm_phase<pg8::EpiStoreBf16, pg8::RegSched, false>(F.lds, D, S, E, F.tid); } SEAM(PH0_WIN);
    if (IN(PH0_MA)) { pa_phase(F, ap, 0, NCH, NCH); } SEAM(PH0_MA);
    if (IN(PH0_M3)) { m3_phase(F); } SEAM(PH0_M3);
    if (IN(PH0_MC)) { pc_phase(F, ap, 0, NCH); } SEAM(PH0_MC);
    if (IN(PH0_WOUT)) { pg8::RegSched S; S.init(H, F.ws + WS_WOUT, D, RT / 256, D / 256, 0, 1, 0, F.G, c); { pg8::EpiResid E{ap->in[I_X], ap->out, ap->in[I_CTX], XC, modv + 2 * 1024, (float*)(F.ws + WS_FSLAB)};
        pg8::gemm_phase<pg8::EpiResid, pg8::RegSched, false>(F.lds, D, S, E, F.tid); } } SEAM(PH0_WOUT);
#if FFN8
    if (IN(PH0_N2)) { norm_phase<3>(F, ap, 0, RT, ap->out, XC, ap->in[I_N2G], 3, 4); } SEAM(PH0_N2);
    if (IN(PH0_UP)) { g8::SchedD S; S.nMw = RT / 256; S.nN = 2 * DFF / 256; S.nMt = 0; S.G = F.G; S.c = c; S.nt = D / 128; S.P = 1; S.A = (const char*)H; S.tstepA = (size_t)256 * D; S.W = (const char*)(F.ws + WS_WUP); S.tstepB = (size_t)256 * D;
        g8::EpiSwiglu8<DFF> E{F.ws + WS_Z, 1.0f / 64.0f};
        g8::gemm8_phase<g8::EpiSwiglu8<DFF>, g8::SchedD, false>(F.lds, D, S, E, nullptr, F.tid); } SEAM(PH0_UP);
    if (IN(PH0_DN)) { g8::SchedD S; S.nMw = RX / 256; S.nN = D / 256; S.nMt = RC / 256; S.G = F.G; S.c = c; S.nt = DFF / 128; S.P = FFN_P; S.A = (const char*)(F.ws + WS_Z); S.tstepA = (size_t)256 * DFF; S.W = (const char*)(F.ws + WS_WDN); S.tstepB = (size_t)256 * DFF;
        g8::EpiResid8 E{ap->out, XC, modv + 5 * 1024, (float*)(F.ws + WS_FSLAB), 1.0f / 64.0f};
        g8::gemm8_phase<g8::EpiResid8, g8::SchedD, false>(F.lds, DFF, S, E, nullptr, F.tid); } SEAM(PH0_DN);
#else
    if (IN(PH0_N2)) { norm_phase<1>(F, ap, 0, RT, ap->out, XC, ap->in[I_N2G], 3, 4); } SEAM(PH0_N2);
    if (IN(PH0_UP)) { pg8::RegSched S; S.init(H, F.ws + WS_WUP, D, RT / 256, 2 * DFF / 256, 0, 1, 0, F.G, c); pg8::EpiSwiglu E{Zb, DFF};
        pg8::gemm_phase<pg8::EpiSwiglu, pg8::RegSched, false>(F.lds, D, S, E, F.tid); } SEAM(PH0_UP);
    if (IN(PH0_DN)) { pg8::RegSched S; S.init(Zb, F.ws + WS_WDN, DFF, RX / 256, D / 256, RC / 256, D / 256, RX / 256, F.G, c, FFN_P); { pg8::EpiResid E{ap->out, ap->out, XC, XC, modv + 5 * 1024, (float*)(F.ws + WS_FSLAB)};
        pg8::gemm_phase<pg8::EpiResid, pg8::RegSched, false>(F.lds, DFF, S, E, F.tid); } } SEAM(PH0_DN);
#endif
    if (IN(PH1_N1)) { norm_phase<0>(F, ap, 1, RT, ap->out, XC, ap->in[I_N1G] + D, 0, 1, (const float*)(F.ws + WS_FSLAB)); } SEAM(PH1_N1);
    if (IN(PH1_WIN)) { pg8::RegSched S; S.init(H, F.ws + WS_WIN + (size_t)ZC * D * 2, D, RX / 256, ZC / 256, RC / 256, 3, RX / 256, F.G, c); pg8::EpiStoreBf16 E{Zb, ZC};
        pg8::gemm_phase<pg8::EpiStoreBf16, pg8::RegSched, false>(F.lds, D, S, E, F.tid); } SEAM(PH1_WIN);
    if (IN(PH1_MA)) { pa_phase(F, ap, 1, NCHX, NCH); } SEAM(PH1_MA);
    if (IN(PH1_M3)) { m3_phase(F); } SEAM(PH1_M3);
    if (IN(PH1_MC)) { pc_phase(F, ap, 1, NCHX); } SEAM(PH1_MC);
    if (IN(PH1_WOUT)) { pg8::RegSched S; S.init(H, F.ws + WS_WOUT + (size_t)D * D * 2, D, RX / 256, D / 256, 0, 1, 0, F.G, c); { pg8::EpiResid E{ap->out, ap->out, XC, XC, modv + 17 * 6144 + 2 * 1024, (float*)(F.ws + WS_FSLAB)};
        pg8::gemm_phase<pg8::EpiResid, pg8::RegSched, false>(F.lds, D, S, E, F.tid); } } SEAM(PH1_WOUT);
    if (IN(PH1_N2R)) { norm_phase<2>(F, ap, 1, RX, ap->out, XC, ap->in[I_N2G] + D, 3, 4); moe_convert(F, ap); } SEAM(PH1_N2R);
    if (IN(PH1_ASG)) { moe_assign(F); } SEAM(PH1_ASG);
    if (IN(PH1_UP) || IN(PH1_DN0) || IN(PH1_DN1)) {
        g8::Sched S;
#pragma unroll
        for (int k = 0; k < 2; ++k) { int sacc = 0;
#pragma unroll
            for (int e = 0; e < 8; ++e) { if (k == 0) S.pre0[e] = sacc; else S.pre1[e] = sacc; sacc += (__builtin_amdgcn_readfirstlane((int)__hip_atomic_load(ctl + CW_CNT + k * 8 + e, RLX_AGENT)) + 255) >> 8; } if (k == 0) S.pre0[8] = sacc; else S.pre1[8] = sacc; }
        S.G = F.G; S.c = c;
        if (IN(PH1_UP)) {
            S.k0 = 0; S.npass = 2; S.P = 1; S.nN = 2 * EFF / 256; S.nt = D / 128; S.Abase = (const char*)H; S.arow = 0; S.apass = 0; S.Wbase = (const char*)(F.ws + WS_WMUP); S.wstride = (size_t)2 * EFF * D; S.tstepB = (size_t)256 * D;
            g8::EpiSwiglu8<EFF> E{F.ws + WS_T, 1.0f / 64.0f};
            g8::gemm8_phase<g8::EpiSwiglu8<EFF>, g8::Sched, true>(F.lds, D, S, E, (const int*)(F.ws + WS_ROWTOK), F.tid); }
        SEAM(PH1_UP);
#pragma unroll
        for (int k = 0; k < 2; ++k) {
            if (IN(PH1_DN0 + k)) { S.k0 = k; S.npass = 1; S.P = MOE_P; S.nN = D / 256; S.nt = EFF / 128; S.Abase = (const char*)(F.ws + WS_T); S.arow = EFF; S.apass = (size_t)MOE_ROWS * EFF; S.Wbase = (const char*)(F.ws + WS_WMDN); S.wstride = (size_t)D * EFF; S.tstepB = (size_t)256 * EFF;
                g8::EpiMoeDown8 E{(const int*)(F.ws + WS_ROWTOK), (const float*)(F.ws + WS_ROWP), modv + 17 * 6144 + 5 * 1024, ap->out, 1.0f / 64.0f, (bf16*)(F.ws + WS_MSLAB0), (bf16*)(F.ws + WS_MSLAB1), (float*)(F.ws + WS_DUMP)};
                g8::gemm8_phase<g8::EpiMoeDown8, g8::Sched, false>(F.lds, EFF, S, E, nullptr, F.tid); }
            SEAM(PH1_DN0 + k);
        }
    }
    if (IN(PH_FIN)) { final_norm(F, ap); }
#undef IN
#undef SEAM
#undef XC
#undef H
#undef Zb
#undef modv
#undef ctl
}

extern "C" void kernel_launch(void* const* d_in, const int* in_sizes, int n_in, void* d_out, int out_size, void* d_ws, size_t ws_size, hipStream_t stream) {
    static int grid = 0;
    if (grid == 0) {
        if (n_in != 33 || out_size != RX * D || ws_size < WS_NEED) { fprintf(stderr, "kernel_launch: unexpected problem (n_in %d, out %d, ws %zu, need %zu); nothing launched\n", n_in, out_size, ws_size, (size_t)WS_NEED); grid = -1; return; }
        int dev = 0, cus = 0, per_cu = 0;
        if (hipGetDevice(&dev) != hipSuccess || hipDeviceGetAttribute(&cus, hipDeviceAttributeMultiprocessorCount, dev) != hipSuccess) { grid = -1; return; }
        if (hipFuncSetAttribute((const void*)fwd_kernel, hipFuncAttributeMaxDynamicSharedMemorySize, LDS_BYTES) != hipSuccess) { fprintf(stderr, "kernel_launch: hipFuncSetAttribute failed\n"); grid = -1; return; }
        if (hipOccupancyMaxActiveBlocksPerMultiprocessor(&per_cu, (const void*)fwd_kernel, 512, LDS_BYTES) != hipSuccess || per_cu < 1) fprintf(stderr, "kernel_launch: occupancy query reports %d\n", per_cu);
        (void)hipGetLastError();
        grid = cus;
    }
    if (grid < 0) return;
    (void)hipMemsetAsync((char*)d_ws + WS_CTL, 0, CTL_BYTES, stream);
    Args a{};
    for (int i = 0; i < 33; ++i) a.in[i] = (const float*)d_in[i];
    a.out = (float*)d_out; a.ws = (unsigned char*)d_ws;
#if ONE_LAUNCH
    a.ph_lo = 0; a.ph_hi = NPHASE;
    hipLaunchKernelGGL(fwd_kernel, dim3(grid), dim3(512), LDS_BYTES, stream, a);
#else
    for (int p = 0; p < NPHASE; ++p) { a.ph_lo = p; a.ph_hi = p + 1; hipLaunchKernelGGL(fwd_kernel, dim3(grid), dim3(512), LDS_BYTES, stream, a); }
#endif
}
```

```cpp
#include <hip/hip_runtime.h>
#include <cstdio>
#include <cstdint>

#ifndef PROBE_MASK
#define PROBE_MASK 0u
#endif
#define REPS(k) (((PROBE_MASK >> (k)) & 1u) ? 2 : 1)
#ifndef ONE_LAUNCH
#define ONE_LAUNCH 1
#endif
#ifndef G8_PIPE
#define G8_PIPE 1
#endif
#ifndef PROBE_EPI
#define PROBE_EPI 0
#endif
#ifndef FFN8
#define FFN8 1
#endif

#define GAS __attribute__((address_space(1)))
#define LAS __attribute__((address_space(3)))
typedef unsigned short bf16;
typedef short bf16x8 __attribute__((ext_vector_type(8)));
typedef float f32x4 __attribute__((ext_vector_type(4)));
typedef float f32x2 __attribute__((ext_vector_type(2)));
typedef unsigned u32x4 __attribute__((ext_vector_type(4)));
typedef unsigned u32x2 __attribute__((ext_vector_type(2)));
typedef int i32x4 __attribute__((ext_vector_type(4)));
typedef int i32x8 __attribute__((ext_vector_type(8)));

constexpr int D = 1024, BATCH = 16, SEQ = 2048, CTXL = 256;
constexpr int RX = BATCH * SEQ, RC = BATCH * CTXL, RT = RX + RC;
constexpr int INC = 2824, ZC = 2816, DFF = 2816, EFF = 3584, NE = 8;
constexpr int NCHX = RX / 128, NCHC = RC / 128, NCH = NCHX + NCHC;
constexpr int MOE_ROWS = 34816;
constexpr int MOE_TILES = MOE_ROWS / 256;
constexpr int ZO_X = 0, ZO_B = 256, ZO_C = 512, ZO_Z = 768, ZO_U = 1024, ZO_V = 1280, ZO_GB = 1536, ZO_GC = 1792, ZO_XIN = 2048, ZO_CA = 2304, ZO_CG = 2560;

constexpr size_t al256(size_t x) { return (x + 255) & ~(size_t)255; }
constexpr size_t WS_CTL = 0, CTL_BYTES = 1u << 20;
constexpr size_t WS_MODV = WS_CTL + CTL_BYTES;
constexpr size_t WS_DT = WS_MODV + al256((size_t)2 * 17 * 6144 * 4);
constexpr size_t WS_ACS = WS_DT + (size_t)RT * 8 * 4;
constexpr size_t WS_TOPE = WS_ACS + (size_t)RT * 8 * 4;
constexpr size_t WS_TOPP = WS_TOPE + (size_t)RX * 2 * 4;
constexpr size_t WS_ROWTOK = WS_TOPP + (size_t)RX * 2 * 4;
constexpr size_t WS_ROWP = WS_ROWTOK + (size_t)2 * MOE_ROWS * 4;
constexpr size_t WS_SLOT = WS_ROWP + (size_t)2 * MOE_ROWS * 4;
constexpr size_t WS_DUMP = WS_SLOT + (size_t)2 * RX * 4;
constexpr size_t WS_WIN = WS_DUMP + 4096;
constexpr size_t WS_WOUT = WS_WIN + (size_t)2 * ZC * D * 2;
constexpr size_t WS_WUP = WS_WOUT + (size_t)2 * D * D * 2;
constexpr size_t WS_WDN = WS_WUP + (size_t)2 * DFF * D * 2;
constexpr size_t WS_XC = WS_WDN + (size_t)D * DFF * 2;
constexpr size_t WS_H = WS_XC + (size_t)RC * D * 4;
constexpr size_t WS_Z = WS_H + (size_t)RT * D * 2;
constexpr size_t WS_XBC = WS_Z + (size_t)RT * ZC * 2;
constexpr size_t WS_ST = WS_XBC + (size_t)RT * 768 * 2;
constexpr size_t WS_STE = WS_ST + (size_t)NCH * 2 * 4 * 8192 * 4;
constexpr size_t WS_XT = WS_STE + (size_t)NCH * 2 * 4 * 8192 * 2;
constexpr size_t WS_WSB = WS_XT + (size_t)NCH * 256 * 128 * 2;
constexpr size_t WS_END_MIX = WS_WSB + (size_t)2 * 4 * 128 * 128 * 2;
constexpr int FFN_P = 4;
constexpr size_t WS_FSLAB = WS_ST;
static_assert((size_t)16 * 4 * FFN_P * 65536 * 4 <= (size_t)NCH * 2 * 4 * 8192 * 4, "ffn slabs fit the chunk-state buffer");
constexpr size_t WS_WMUP = WS_Z;
constexpr size_t WS_WMDN = WS_WMUP + (size_t)NE * 2 * EFF * D;
constexpr size_t WS_T = WS_WMDN + (size_t)NE * D * EFF;
constexpr int MOE_P = 7, MOE_TAIL_TILES = MOE_TILES - 128;
constexpr size_t MOE_SLAB_BYTES = (size_t)MOE_TAIL_TILES * 4 * MOE_P * 65536 * 2;
constexpr int MOE_YROWS = 128 * 256;
constexpr size_t WS_Y = WS_H;
static_assert(WS_H + (size_t)2 * MOE_YROWS * D * 2 <= WS_WMDN, "y rows end below the down weights");
constexpr size_t WS_MSLAB0 = WS_WIN;
constexpr size_t WS_MSLAB1 = WS_T + (size_t)2 * MOE_ROWS * EFF;
constexpr size_t WS_END_MOE = WS_MSLAB1 + MOE_SLAB_BYTES;
static_assert(WS_MSLAB0 + MOE_SLAB_BYTES <= WS_H, "pass-0 slabs fit below the activation buffer");
constexpr size_t WS_NEED = WS_END_MOE > WS_END_MIX ? WS_END_MOE : WS_END_MIX;
static_assert(WS_NEED < (size_t)612 * 1000 * 1000, "workspace budget");
constexpr int CW_BAR = 4096;
constexpr int CW_CNT = 8192;
constexpr int CW_RUN = 8192 + 64;
constexpr int CW_TMO = 0;

constexpr int RING_BYTES = 131072;
constexpr int LDS_BYTES = 147456;
constexpr int MISC_OFF = LDS_BYTES - 256;

#define RLX_AGENT __ATOMIC_RELAXED, __HIP_MEMORY_SCOPE_AGENT
__device__ __forceinline__ float bflo(unsigned w) { return __uint_as_float(w << 16); }
__device__ __forceinline__ float bfhi(unsigned w) { return __uint_as_float(w & 0xffff0000u); }
__device__ __forceinline__ unsigned cvt_pk_bf16(float lo, float hi) { unsigned r; asm volatile("v_cvt_pk_bf16_f32 %0, %1, %2" : "=v"(r) : "v"(lo), "v"(hi)); return r; }
__device__ __forceinline__ float fexp(float x) { return __builtin_amdgcn_exp2f(x * 1.4426950408889634f); }
__device__ __forceinline__ float silu_f(float x) { return x * __builtin_amdgcn_rcpf(1.0f + fexp(-x)); }
__device__ __forceinline__ float sigmoid_f(float x) { return __builtin_amdgcn_rcpf(1.0f + fexp(-x)); }
__device__ __forceinline__ float gelu_tanh_f(float x) { const float u = 0.7978845608028654f * (x + 0.044715f * x * x * x); return x * __builtin_amdgcn_rcpf(1.0f + fexp(-2.0f * u)); }
__device__ __forceinline__ unsigned pk4_fp8(float a, float b, float c, float d) { int w = __builtin_amdgcn_cvt_pk_fp8_f32(a, b, 0, false); w = __builtin_amdgcn_cvt_pk_fp8_f32(c, d, w, true); return (unsigned)w; }
__device__ __forceinline__ float softplus_f(float x) { return fmaxf(x, 0.0f) + log1pf(__expf(-fabsf(x))); }
__device__ __forceinline__ float wave_sum(float v) {
#pragma unroll
    for (int o = 1; o < 64; o <<= 1) v += __shfl_xor(v, o);
    return v;
}
__device__ __forceinline__ void unpack8(const u32x4 w, float (&f)[8]) { f[0] = bflo(w.x); f[1] = bfhi(w.x); f[2] = bflo(w.y); f[3] = bfhi(w.y); f[4] = bflo(w.z); f[5] = bfhi(w.z); f[6] = bflo(w.w); f[7] = bfhi(w.w); }
__device__ __forceinline__ u32x4 pack8(const float (&f)[8]) { u32x4 w; w.x = cvt_pk_bf16(f[0], f[1]); w.y = cvt_pk_bf16(f[2], f[3]); w.z = cvt_pk_bf16(f[4], f[5]); w.w = cvt_pk_bf16(f[6], f[7]); return w; }

#define XB_TMO      128
#define XB_XCNT(j)  (256  + 64 * (j))
#define XB_XSUB(j)  (1280 + 64 * (j))
#define XB_XGEN(j)  (2304 + 64 * (j))
#define XB_TOP      3328
#define XB_TOPGEN   3392
#define XCD_BAR_WORDS 3456
#define XB_SPIN_CAP (1u << 22)
__device__ __forceinline__ unsigned xb_ld(unsigned* p)              { return __hip_atomic_load(p, __ATOMIC_RELAXED, __HIP_MEMORY_SCOPE_AGENT); }
__device__ __forceinline__ unsigned xb_add(unsigned* p, unsigned v) { return __hip_atomic_fetch_add(p, v, __ATOMIC_RELAXED, __HIP_MEMORY_SCOPE_AGENT); }
__device__ __forceinline__ unsigned xb_xcc_id() { return (unsigned)__builtin_amdgcn_s_getreg((3 << 11) | 20) & 0xFu; }
#define XB_SPIN(cond, bar) do { unsigned _sp = 0; while (cond) { __builtin_amdgcn_s_sleep(1); \
    if ((++_sp & 255u) == 0u) { if (xb_ld(&(bar)[XB_TMO])) break; if (_sp > XB_SPIN_CAP) { atomicAdd(&(bar)[XB_TMO], 1u); break; } } } } while (0)
struct XcdBarrier { unsigned* bar; unsigned x; volatile LAS unsigned* st; };
__device__ __forceinline__ XcdBarrier xcd_barrier_post(unsigned* bar, volatile LAS unsigned* st, int tid) {
    XcdBarrier b; b.bar = bar; b.x = xb_xcc_id(); b.st = st;
    if (tid == 0) (void)xb_add(&bar[XB_XCNT(b.x)], 1u);
    return b;
}
__device__ __forceinline__ void xcd_barrier_complete(unsigned* bar, unsigned x, unsigned& nloc, unsigned& nx) {
    const unsigned G = gridDim.x * gridDim.y * gridDim.z;
    unsigned sum, cnt, mine, sp = 0u;
    for (;;) {
        sum = 0u; cnt = 0u; mine = 0u;
#pragma unroll
        for (unsigned j = 0; j < 16; ++j) { const unsigned c = xb_ld(&bar[XB_XCNT(j)]); sum += c; cnt += (c > 0u) ? 1u : 0u; mine = (j == x) ? c : mine; }
        if (sum == G) break;
        __builtin_amdgcn_s_sleep(1);
        if ((++sp & 255u) == 0u) { if (xb_ld(&bar[XB_TMO])) break; if (sp > XB_SPIN_CAP) { atomicAdd(&bar[XB_TMO], 1u); break; } }
    }
    nloc = mine > 0u ? mine : 1u; nx = cnt > 0u ? cnt : 1u;
}
__device__ __forceinline__ void xcd_barrier(const XcdBarrier& b, int tid) {
    asm volatile("s_waitcnt vmcnt(0)" ::: "memory");
    __syncthreads();
    if (tid == 0) {
        unsigned* bar = b.bar;
        __builtin_amdgcn_s_waitcnt(0);
        unsigned nloc = b.st[0], nx = b.st[1];
        if (nloc == 0u) { xcd_barrier_complete(bar, b.x, nloc, nx); b.st[0] = nloc; b.st[1] = nx; }
        const unsigned k = b.st[2] + 1u; b.st[2] = k;
        const unsigned old = xb_add(&bar[XB_XSUB(b.x)], 1u);
        if (old + 1u == k * nloc) {
            __builtin_amdgcn_fence(__ATOMIC_RELEASE, "agent");
            asm volatile("s_waitcnt vmcnt(0)" ::: "memory");
            xb_add(&bar[XB_TOP], 1u);
        }
        { unsigned sp = 0u; while (xb_add(&bar[XB_TOP], 0u) < k * nx) {
            __builtin_amdgcn_s_sleep(2); if ((++sp & 255u) == 0u) { if (xb_ld(&bar[XB_TMO])) break; if (sp > XB_SPIN_CAP) { atomicAdd(&bar[XB_TMO], 1u); break; } } } }
        __builtin_amdgcn_fence(__ATOMIC_ACQUIRE, "agent");
        asm volatile("s_waitcnt vmcnt(0)" ::: "memory");
    }
    __syncthreads();
}

namespace pg8 {
constexpr int BM = 256, BK = 64, HALF = 128, HTB = HALF * BK * 2, STAGE_BYTES = 8 * HTB, NXCD = 8, WGM = 8;
__host__ __device__ __forceinline__ int lds_byte(int r, int c) { const int st = (r >> 4) * 2 + (c >> 5), rr = r & 15, cc = c & 31, ob = rr * 64 + cc * 2; return st * 1024 + (ob ^ (((ob >> 9) & 1) << 5)); }
__host__ __device__ __forceinline__ void stage_rc(int b, int& R, int& C) { const int st = b / 1024, sb = b % 1024, swz = sb ^ (((sb >> 9) & 1) << 5); R = (st >> 1) * 16 + swz / 64; C = (st & 1) * 32 + (swz % 64) / 2; }
__host__ __device__ __forceinline__ int perm32(int rho) { const int n = rho >> 4, i = rho & 15; return 8 * (i >> 2) + 4 * n + (i & 3); }
__device__ __forceinline__ const char* uptr(const char* p) { const unsigned long long v = (unsigned long long)p; const unsigned lo = __builtin_amdgcn_readfirstlane((unsigned)v), hi = __builtin_amdgcn_readfirstlane((unsigned)(v >> 32)); return (const char*)(((unsigned long long)hi << 32) | lo); }
struct Unit { int pm, pn; const char* a; const char* b; int nt, split, part; };
__device__ __forceinline__ void tile_map(int L, int nM, int nN, int& pm, int& pn) {
    const int nwg = nM * nN; int wgid = L;
    { const int q = nwg / NXCD, r = nwg % NXCD, xcd = wgid % NXCD, off = wgid / NXCD; wgid = (xcd < r ? xcd * (q + 1) : r * (q + 1) + (xcd - r) * q) + off; }
    const int nig = WGM * nN, gid = wgid / nig, fm = gid * WGM, gsz = (nM - fm) < WGM ? (nM - fm) : WGM;
    pm = fm + ((wgid % nig) % gsz); pn = (wgid % nig) / gsz;
}
__device__ __forceinline__ bool tail_split(long L, int nu, int nwhole, int npairs, int P, int& tile, int& kt0, int& nt, int& split, int& part) {
    if (L < nwhole) { tile = (int)L; kt0 = 0; nt = 2 * npairs; split = 0; part = 0; return true; }
    const int Lt = (int)L - nwhole; if (Lt >= (nu - nwhole) * P) return false;
    part = Lt % P; const int base = npairs / P, rem = npairs % P, start = part * base + (part < rem ? part : rem), cnt = base + (part < rem ? 1 : 0);
    tile = nwhole + Lt / P; kt0 = 2 * start; nt = 2 * cnt; split = 1; return true;
}
struct RegSched {
    int nM0, nN0, n0, nM1, nN1, n1, pm1off, G, c, npairs, P; const char* A; const char* B; size_t tstep;
    __device__ __forceinline__ void init(const void* A_, const void* B_, int K, int nM0_, int nN0_, int nM1_, int nN1_, int pm1off_, int G_, int c_, int P_ = 1) {
        A = (const char*)A_; B = (const char*)B_; tstep = (size_t)256 * K * 2; nM0 = nM0_; nN0 = nN0_; n0 = nM0_ * nN0_; nM1 = nM1_; nN1 = nN1_; n1 = nM1_ * nN1_; pm1off = pm1off_; G = G_; c = c_; npairs = K / 128; P = P_; }
    __device__ __forceinline__ bool next(int i, Unit& u) const {
        const long L = (long)i * G + c; int tile, kt0;
        if (!tail_split(L, n0 + n1, P > 1 ? n0 : n0 + n1, npairs, P, tile, kt0, u.nt, u.split, u.part)) return false;
        int pm, pn;
        if (tile < n0) tile_map(tile, nM0, nN0, pm, pn); else { tile_map(tile - n0, nM1, nN1, pm, pn); pm += pm1off; }
        u.pm = pm; u.pn = pn; u.a = A + (size_t)pm * tstep + (size_t)kt0 * 128; u.b = B + (size_t)pn * tstep + (size_t)kt0 * 128; return true;
    }
    __device__ __forceinline__ void gather(const Unit&, int, unsigned (&)[2][2]) const {}
};
template <class Epi, class Sched, bool GATHER>
__device__ __forceinline__ void gemm_phase(LAS unsigned char* lds, const int K, const Sched& S, const Epi& E, int tid) {
    asm volatile("" : "+v"(tid));
    const int wid = __builtin_amdgcn_readfirstlane(tid >> 6), lane = tid & 63, wr = wid >> 2, wc = wid & 3, fr = lane & 15, fq = lane >> 4;
    unsigned voffA[2], voffB[2];
#pragma unroll
    for (int i = 0; i < 2; ++i) { int R, C; stage_rc(tid * 16 + i * 8192, R, C); const int Rb = Epi::PERM ? ((R & ~31) + perm32(R & 31)) : R;
        voffA[i] = (unsigned)(R * K + C) * 2u; voffB[i] = (unsigned)(Rb * K + C) * 2u; }
    const size_t kstep = (size_t)(BK * 2);
    const size_t hstep = (size_t)HALF * K * 2;
    const unsigned ldsw = (unsigned)wid * 1024u;
    const int aoff = lds_byte(wr * 64 + fr, fq * 8), boff = lds_byte(wc * 32 + fr, fq * 8);
#define PG8_SA(b, h) (((b) * 2 + (h)) * HTB)
#define PG8_SB(b, h) ((4 + (b) * 2 + (h)) * HTB)
#define PG8_STAGE(bufoff, gbase, voff) do { _Pragma("unroll") for (int _i = 0; _i < 2; ++_i) \
        __builtin_amdgcn_global_load_lds((const unsigned*)((const char*)(gbase) + (voff)[_i]), (LAS unsigned*)(lds + (bufoff) + ldsw + _i * 8192), 16, 0, 0); } while (0)
#define PG8_STAGE_A(bufoff, kptr, h, SEL) do { if constexpr (GATHER) { unsigned _vo[2]; _vo[0] = (SEL) ? nva[h][0] : cva[h][0]; _vo[1] = (SEL) ? nva[h][1] : cva[h][1]; PG8_STAGE(bufoff, kptr, _vo); } else { PG8_STAGE(bufoff, (kptr) + (h) * hstep, voffA); } } while (0)
#define PG8_LDA(dst, b, h) do { _Pragma("unroll") for (int m = 0; m < 4; ++m) _Pragma("unroll") for (int k = 0; k < 2; ++k) dst[m][k] = *(const LAS bf16x8*)(lds + PG8_SA(b, h) + aoff + m * 2048 + k * 1024); } while (0)
#define PG8_LDB(dst, b, h) do { _Pragma("unroll") for (int n = 0; n < 2; ++n) _Pragma("unroll") for (int k = 0; k < 2; ++k) dst[n][k] = *(const LAS bf16x8*)(lds + PG8_SB(b, h) + boff + n * 2048 + k * 1024); } while (0)
#define PG8_MMA(ai, bj, At, Bt) do { __builtin_amdgcn_s_setprio(1); _Pragma("unroll") for (int m = 0; m < 4; ++m) _Pragma("unroll") for (int n = 0; n < 2; ++n) _Pragma("unroll") for (int k = 0; k < 2; ++k) \
        acc[ai][bj][m][n] = __builtin_amdgcn_mfma_f32_16x16x32_bf16(Bt[n][k], At[m][k], acc[ai][bj][m][n], 0, 0, 0); __builtin_amdgcn_s_setprio(0); } while (0)
#define PG8_WAIT_V(n) asm volatile("s_waitcnt vmcnt(" #n ")" ::: "memory")
#define PG8_WAIT_L(n) asm volatile("s_waitcnt lgkmcnt(" #n ")" ::: "memory")
#define PG8_BAR __builtin_amdgcn_s_barrier()
#define PG8_SCHED __builtin_amdgcn_sched_barrier(0)
    Unit cur, nxt; int ui = 0;
    if (!S.next(0, cur)) return;
    f32x4 acc[2][2][4][2];
#pragma unroll
    for (int a = 0; a < 2; ++a)
#pragma unroll
        for (int b = 0; b < 2; ++b)
#pragma unroll
            for (int m = 0; m < 4; ++m)
#pragma unroll
                for (int n = 0; n < 2; ++n) acc[a][b][m][n] = (f32x4){0.f, 0.f, 0.f, 0.f};
    bf16x8 At[4][2], B0[2][2], B1[2][2];
    unsigned cva[2][2] = {{0u, 0u}, {0u, 0u}}, nva[2][2] = {{0u, 0u}, {0u, 0u}};
    if constexpr (GATHER) S.gather(cur, tid, cva);
    const char* cA = uptr(cur.a); const char* cB = uptr(cur.b);
    PG8_STAGE(PG8_SB(0, 0), cB, voffB); PG8_STAGE(PG8_SB(0, 1), cB + hstep, voffB); PG8_STAGE_A(PG8_SA(0, 0), cA, 0, false); PG8_STAGE_A(PG8_SA(0, 1), cA, 1, false);
    if (wr == 1) PG8_BAR;
    PG8_WAIT_V(2); PG8_BAR;
    PG8_STAGE(PG8_SB(1, 0), cB + kstep, voffB); PG8_STAGE_A(PG8_SA(1, 0), cA + kstep, 0, false); PG8_STAGE(PG8_SB(1, 1), cB + hstep + kstep, voffB);
    PG8_WAIT_V(6); PG8_BAR;
    for (;;) {
        const bool has_next = S.next(ui + 1, nxt);
        const char* nA = uptr(has_next ? nxt.a : cA); const char* nB = uptr(has_next ? nxt.b : cB);
        if constexpr (GATHER) { if (has_next) S.gather(nxt, tid, nva); else {
#pragma unroll
            for (int h = 0; h < 2; ++h)
#pragma unroll
                for (int i = 0; i < 2; ++i) nva[h][i] = cva[h][i]; } }
        const int nt = cur.nt;
        for (int t = 0; t < nt; t += 2) {
            const bool last = (t == nt - 2);
            asm volatile("" : "+v"(voffA[0]), "+v"(voffA[1]), "+v"(voffB[0]), "+v"(voffB[1]));
            const char* a1 = uptr(cA + (size_t)(t + 1) * kstep);
            const char* a2 = uptr(last ? nA : cA + (size_t)(t + 2) * kstep); const char* b2 = uptr(last ? nB : cB + (size_t)(t + 2) * kstep);
            const char* a3 = a2 + kstep; const char* b3 = b2 + kstep;
            PG8_LDB(B0, 0, 0); PG8_LDB(B1, 0, 1); PG8_SCHED; PG8_LDA(At, 0, 0); PG8_STAGE_A(PG8_SA(1, 1), a1, 1, false);
            PG8_WAIT_V(8); PG8_WAIT_L(0); PG8_BAR; PG8_MMA(0, 0, At, B0); PG8_MMA(0, 1, At, B1); PG8_BAR; PG8_SCHED;
            PG8_LDA(At, 0, 1); PG8_STAGE(PG8_SB(0, 0), b2, voffB); PG8_STAGE(PG8_SB(0, 1), b2 + hstep, voffB); PG8_STAGE_A(PG8_SA(0, 0), a2, 0, last);
            PG8_WAIT_V(8); PG8_WAIT_L(0); PG8_BAR; PG8_MMA(1, 0, At, B0); PG8_MMA(1, 1, At, B1); PG8_BAR; PG8_SCHED;
            PG8_LDB(B0, 1, 0); PG8_LDB(B1, 1, 1); PG8_SCHED; PG8_LDA(At, 1, 0); PG8_STAGE_A(PG8_SA(0, 1), a2, 1, last);
            PG8_WAIT_V(8); PG8_WAIT_L(0); PG8_BAR; PG8_MMA(0, 0, At, B0); PG8_MMA(0, 1, At, B1); PG8_BAR; PG8_SCHED;
            PG8_LDA(At, 1, 1); PG8_STAGE(PG8_SB(1, 0), b3, voffB); PG8_STAGE(PG8_SB(1, 1), b3 + hstep, voffB); PG8_STAGE_A(PG8_SA(1, 0), a3, 0, last);
            PG8_WAIT_V(8); PG8_WAIT_L(0); PG8_BAR; PG8_MMA(1, 0, At, B0); PG8_MMA(1, 1, At, B1); PG8_BAR; PG8_SCHED;
        }
        if (wr == 0) PG8_BAR;
        { Unit eu = cur; int efr = fr, efq = fq; asm volatile("" : "+s"(eu.pm), "+s"(eu.pn), "+s"(eu.split), "+s"(eu.part), "+v"(efr), "+v"(efq));
          E(acc, eu, wr, wc, efr, efq);
#if PROBE_EPI
          if constexpr (!Epi::RMW && ((PROBE_EPI >> Epi::PB) & 1)) { asm volatile("" ::: "memory");
#pragma unroll
            for (int a_ = 0; a_ < 2; ++a_)
#pragma unroll
              for (int b_ = 0; b_ < 2; ++b_)
#pragma unroll
                for (int m_ = 0; m_ < 4; ++m_)
#pragma unroll
                  for (int n_ = 0; n_ < 2; ++n_) asm volatile("" : "+v"(acc[a_][b_][m_][n_]));
            E(acc, eu, wr, wc, efr, efq); }
#endif
          }
        if (!has_next) break;
#pragma unroll
        for (int a = 0; a < 2; ++a)
#pragma unroll
            for (int b = 0; b < 2; ++b)
#pragma unroll
                for (int m = 0; m < 4; ++m)
#pragma unroll
                    for (int n = 0; n < 2; ++n) acc[a][b][m][n] = (f32x4){0.f, 0.f, 0.f, 0.f};
        cur = nxt; cA = nA; cB = nB; ++ui;
        if constexpr (GATHER) {
#pragma unroll
            for (int h = 0; h < 2; ++h)
#pragma unroll
                for (int i = 0; i < 2; ++i) cva[h][i] = nva[h][i]; }
        if (wr == 1) PG8_BAR;
    }
    PG8_WAIT_V(0);
    PG8_BAR;
#undef PG8_SA
#undef PG8_SB
#undef PG8_STAGE
#undef PG8_STAGE_A
#undef PG8_LDA
#undef PG8_LDB
#undef PG8_MMA
#undef PG8_WAIT_V
#undef PG8_WAIT_L
#undef PG8_BAR
#undef PG8_SCHED
}

struct EpiStoreBf16 {
    static constexpr bool PERM = true, RMW = false; static constexpr int PB = 3;
    bf16* O; int ldc;
    __device__ __forceinline__ void operator()(const f32x4 (&acc)[2][2][4][2], const Unit& u, int wr, int wc, int fr, int fq) const {
        const int row0 = u.pm * BM + wr * 64 + fr, col0 = u.pn * BM + wc * 32 + 8 * fq;
#pragma unroll
        for (int ai = 0; ai < 2; ++ai)
#pragma unroll
            for (int m = 0; m < 4; ++m) { bf16* rowp = O + (size_t)(row0 + ai * HALF + m * 16) * ldc + col0;
#pragma unroll
                for (int bj = 0; bj < 2; ++bj) { const f32x4 v0 = acc[ai][bj][m][0], v1 = acc[ai][bj][m][1];
                    u32x4 w; w.x = cvt_pk_bf16(v0[0], v0[1]); w.y = cvt_pk_bf16(v0[2], v0[3]); w.z = cvt_pk_bf16(v1[0], v1[1]); w.w = cvt_pk_bf16(v1[2], v1[3]);
                    *(u32x4*)(rowp + bj * HALF) = w; } }
    }
};
struct EpiSwiglu {
    static constexpr bool PERM = true, RMW = false; static constexpr int PB = 4;
    bf16* O; int ldc;
    __device__ __forceinline__ void operator()(const f32x4 (&acc)[2][2][4][2], const Unit& u, int wr, int wc, int fr, int fq) const {
        const int row0 = u.pm * BM + wr * 64 + fr, col0 = u.pn * HALF + wc * 32 + 8 * fq;
#pragma unroll
        for (int ai = 0; ai < 2; ++ai)
#pragma unroll
            for (int m = 0; m < 4; ++m) { bf16* rowp = O + (size_t)(row0 + ai * HALF + m * 16) * ldc + col0;
                float t[8];
#pragma unroll
                for (int n = 0; n < 2; ++n)
#pragma unroll
                    for (int j = 0; j < 4; ++j) t[4 * n + j] = silu_f(acc[ai][0][m][n][j]) * acc[ai][1][m][n][j];
                *(u32x4*)rowp = pack8(t); }
    }
};
struct EpiResid {
    static constexpr bool PERM = false, RMW = true; static constexpr int PB = 5;
    const float* xbase; float* xout; const float* cbase; float* cout; const float* gate; float* slab;
    __device__ __forceinline__ void operator()(const f32x4 (&acc)[2][2][4][2], const Unit& u, int wr, int wc, int fr, int fq) const {
        const float* base; float* out; const float* g;
        if (u.pm < RX / 256) { base = xbase + (size_t)u.pm * 256 * D; out = xout + (size_t)u.pm * 256 * D; g = gate + (size_t)(u.pm >> 3) * 6144; }
        else { const int pc = u.pm - RX / 256; base = cbase + (size_t)pc * 256 * D; out = cout + (size_t)pc * 256 * D; g = gate + (size_t)16 * 6144; }
        const int col0 = u.pn * BM + wc * 32 + 4 * fq;
        f32x4 gv[2][2];
#pragma unroll
        for (int bj = 0; bj < 2; ++bj)
#pragma unroll
            for (int n = 0; n < 2; ++n) gv[bj][n] = *(const f32x4*)(g + col0 + bj * HALF + n * 16);
#pragma unroll
        for (int ai = 0; ai < 2; ++ai) {
            f32x4 bs[4][2][2];
            if (!u.split) {
#pragma unroll
                for (int m = 0; m < 4; ++m)
#pragma unroll
                    for (int bj = 0; bj < 2; ++bj)
#pragma unroll
                        for (int n = 0; n < 2; ++n) bs[m][bj][n] = *(const f32x4*)(base + (size_t)(wr * 64 + fr + ai * HALF + m * 16) * D + col0 + bj * HALF + n * 16); }
            __builtin_amdgcn_sched_barrier(0);
#pragma unroll
            for (int m = 0; m < 4; ++m) { const size_t off = (size_t)(wr * 64 + fr + ai * HALF + m * 16) * D + col0;
#pragma unroll
                for (int bj = 0; bj < 2; ++bj)
#pragma unroll
                    for (int n = 0; n < 2; ++n) { const f32x4 v = gv[bj][n] * acc[ai][bj][m][n]; float* o = out + off + bj * HALF + n * 16;
                        if (u.split) *(f32x4*)(slab + ((size_t)(((u.pm - RX / 256) * 4 + u.pn) * FFN_P + u.part) << 16) + (size_t)(wr * 64 + fr + ai * HALF + m * 16) * 256 + wc * 32 + 4 * fq + bj * HALF + n * 16) = v;
                        else *(f32x4*)o = bs[m][bj][n] + v; } }
            __builtin_amdgcn_sched_barrier(0); }
    }
};
}


namespace g8 {
constexpr int TA = 32768, TB = 32768, STG = TA + TB, NSTG = 2;
struct Unit { const char* a; const char* b; int row0, k, pn, nt, split, part; };
__device__ __forceinline__ const char* uptr(const char* p) { const unsigned long long v = (unsigned long long)p; const unsigned lo = __builtin_amdgcn_readfirstlane((unsigned)v), hi = __builtin_amdgcn_readfirstlane((unsigned)(v >> 32)); return (const char*)(((unsigned long long)hi << 32) | lo); }

struct Sched {
    int pre0[9], pre1[9]; int k0, npass, nN, G, c, nt, P; const char* Abase; size_t arow;   size_t apass; const char* Wbase; size_t wstride, tstepB;
    __device__ __forceinline__ bool next(int i, Unit& u) const {
        long L = (long)i * G + c; int k = k0;
        const int nm0 = (k0 == 0 ? pre0[8] : pre1[8]);
        if (P == 1 && L >= (long)nm0 * nN) { if (npass < 2) return false; L -= (long)nm0 * nN; k = 1; if (L >= (long)pre1[8] * nN) return false; }
        const int nm = (k == 0 ? pre0[8] : pre1[8]);
        int pm, pn, kt0 = 0; u.split = 0; u.part = 0; u.nt = nt;
        if (P > 1) {
            if (L < 128 * nN) pg8::tile_map((int)L, 128, nN, pm, pn);
            else { const int Lt = (int)L - 128 * nN; if (Lt >= (nm - 128) * nN * P) return false; const int tile = Lt / P; pm = 128 + tile / nN; pn = tile % nN; u.part = Lt % P; u.split = 1; u.nt = nt / P; kt0 = u.part * (nt / P); }
        } else pg8::tile_map((int)L, nm, nN, pm, pn);
        int e = 0;
#pragma unroll
        for (int j = 1; j < 8; ++j) e += (pm >= (k == 0 ? pre0[j] : pre1[j])) ? 1 : 0;
        u.row0 = pm * 256; u.k = k; u.pn = pn;
        u.a = Abase + (size_t)k * apass + (size_t)u.row0 * arow + (size_t)kt0 * 128; u.b = Wbase + (size_t)e * wstride + (size_t)pn * tstepB + (size_t)kt0 * 128; return true;
    }
};

struct SchedD {
    int nMw, nN, nMt, G, c, nt, P; const char* A; size_t tstepA; const char* W; size_t tstepB;
    __device__ __forceinline__ bool next(int i, Unit& u) const {
        const long L = (long)i * G + c; int pm, pn, kt0 = 0; u.split = 0; u.part = 0; u.nt = nt; u.k = 0;
        if (L < (long)nMw * nN) pg8::tile_map((int)L, nMw, nN, pm, pn);
        else { const int Lt = (int)(L - (long)nMw * nN); if (Lt >= nMt * nN * P) return false; const int tile = Lt / P, part = Lt % P, base = nt / P, rem = nt % P;
            pm = nMw + tile / nN; pn = tile % nN; u.part = part; u.split = 1; u.nt = base + (part < rem ? 1 : 0); kt0 = part * base + (part < rem ? part : rem); }
        u.row0 = pm * 256; u.pn = pn; u.a = A + (size_t)pm * tstepA + (size_t)kt0 * 128; u.b = W + (size_t)pn * tstepB + (size_t)kt0 * 128; return true;
    }
};

template <class Epi, class Sched, bool GATHER>
__device__ __forceinline__ void gemm8_phase(LAS unsigned char* lds, const int rowbytes, const Sched& S, const Epi& E, const int* rowtok  , int tid) {
    asm volatile("" : "+v"(tid));
    const int wave = __builtin_amdgcn_readfirstlane(tid >> 6), lane = tid & 63, wr = wave >> 2, wc = wave & 3, i16 = lane & 15, q = lane >> 4;
    const int srow = tid >> 3, cpos = tid & 7;
    const unsigned soff = 16u * (unsigned)(cpos ^ (srow & 7));
    const unsigned voffB = (unsigned)srow * (unsigned)rowbytes + soff;
    unsigned voffA[4] = {voffB, voffB + 64u * (unsigned)rowbytes, voffB + 128u * (unsigned)rowbytes, voffB + 192u * (unsigned)rowbytes};
    const unsigned ldsw = (unsigned)wave * 1024u;
    const int swz = i16 & 7;
    const unsigned c0 = 16u * (unsigned)(q ^ swz), c1 = 16u * (unsigned)((4 + q) ^ swz);
    const unsigned ard = (unsigned)((128 * wr + i16) * 128), brd = (unsigned)(TA + (64 * wc + i16) * 128);
    Unit cu, su, nu;
    if (!S.next(0, cu)) return;
    su = cu; int si = 0, skt = 0; bool s_valid = true; bool n_valid = S.next(1, nu);
    unsigned gnext[4] = {0u, 0u, 0u, 0u};
    int issued = 0, pos = 0;
#define G8_GATHER(U, DST) do { if constexpr (GATHER) { _Pragma("unroll") for (int _j = 0; _j < 4; ++_j) { int tk = rowtok[(U).k * MOE_ROWS + (U).row0 + srow + 64 * _j]; tk = tk < 0 ? 0 : tk; DST[_j] = (unsigned)tk * (unsigned)rowbytes + soff; } } } while (0)
#define G8_STAGE() do { const int _sb = issued & 1; const char* _a = uptr(su.a + (size_t)skt * 128); const char* _b = uptr(su.b + (size_t)skt * 128); \
        _Pragma("unroll") for (int _j = 0; _j < 4; ++_j) __builtin_amdgcn_global_load_lds((const unsigned*)(_a + voffA[_j]), (LAS unsigned*)(lds + _sb * STG + _j * 8192 + ldsw), 16, 0, 0); \
        _Pragma("unroll") for (int _j = 0; _j < 4; ++_j) __builtin_amdgcn_global_load_lds((const unsigned*)(_b + voffB + (unsigned)(64 * _j) * (unsigned)rowbytes), (LAS unsigned*)(lds + _sb * STG + TA + _j * 8192 + ldsw), 16, 0, 0); \
        ++issued; if (++skt == su.nt) { skt = 0; ++si; su = nu; s_valid = n_valid; if constexpr (GATHER) { _Pragma("unroll") for (int _j = 0; _j < 4; ++_j) voffA[_j] = gnext[_j]; } \
            n_valid = s_valid && S.next(si + 1, nu); if (n_valid) G8_GATHER(nu, gnext); } } while (0)
    G8_GATHER(su, voffA);
    if (n_valid) G8_GATHER(nu, gnext);
    G8_STAGE();
    f32x4 acc[8][4];
    int ci = 0;
    for (;;) {
#pragma unroll
        for (int m = 0; m < 8; ++m)
#pragma unroll
            for (int n = 0; n < 4; ++n) acc[m][n] = (f32x4){0.f, 0.f, 0.f, 0.f};
#pragma unroll 1
        for (int kt = 0; kt < cu.nt; ++kt) {
            if (kt == 0 && ci > 0) asm volatile("s_waitcnt vmcnt(%0)" :: "n"(Epi::NST) : "memory");
            else asm volatile("s_waitcnt vmcnt(0)" ::: "memory");
            __builtin_amdgcn_s_barrier();
            asm volatile("" ::: "memory");
#if G8_PIPE
            if (wr == 0 && s_valid) G8_STAGE();
            __builtin_amdgcn_sched_barrier(0);
            const LAS unsigned char* sb = lds + (pos & 1) * STG;
            i32x8 bf[4], a0[2], a1[2];
#define G8_RDA(dst, m0) do { _Pragma("unroll") for (int _m = 0; _m < 2; ++_m) { dst[_m].lo = *(const LAS i32x4*)(sb + ard + ((m0) + _m) * 2048 + c0); dst[_m].hi = *(const LAS i32x4*)(sb + ard + ((m0) + _m) * 2048 + c1); } } while (0)
#define G8_MM(src, m0) do { _Pragma("unroll") for (int _m = 0; _m < 2; ++_m) _Pragma("unroll") for (int n = 0; n < 4; ++n) \
                acc[(m0) + _m][n] = __builtin_amdgcn_mfma_scale_f32_16x16x128_f8f6f4(bf[n], src[_m], acc[(m0) + _m][n], 0, 0, 0, 0x7f7f7f7f, 0, 0x7f7f7f7f); } while (0)
#pragma unroll
            for (int n = 0; n < 4; ++n) { bf[n].lo = *(const LAS i32x4*)(sb + brd + n * 2048 + c0); bf[n].hi = *(const LAS i32x4*)(sb + brd + n * 2048 + c1); }
            G8_RDA(a0, 0);
            __builtin_amdgcn_sched_barrier(0);
            G8_RDA(a1, 2);
            __builtin_amdgcn_sched_barrier(0);
            __builtin_amdgcn_s_setprio(1);
            G8_MM(a0, 0);
            __builtin_amdgcn_sched_barrier(0);
            G8_RDA(a0, 4);
            __builtin_amdgcn_sched_barrier(0);
            G8_MM(a1, 2);
            __builtin_amdgcn_sched_barrier(0);
#pragma unroll
            for (int m = 0; m < 4; ++m)
#pragma unroll
                for (int n = 0; n < 4; ++n) asm volatile("" : "+v"(acc[m][n]));
            G8_RDA(a1, 6);
            __builtin_amdgcn_sched_barrier(0);
            __builtin_amdgcn_s_setprio(0);
            if (wr == 1 && s_valid) G8_STAGE();
            __builtin_amdgcn_sched_barrier(0);
            __builtin_amdgcn_s_setprio(1);
            G8_MM(a0, 4);
            __builtin_amdgcn_sched_barrier(0);
            G8_MM(a1, 6);
            __builtin_amdgcn_s_setprio(0);
            __builtin_amdgcn_sched_barrier(0);
#undef G8_RDA
#undef G8_MM
#else
            if (s_valid) G8_STAGE();
            const LAS unsigned char* sb = lds + (pos & 1) * STG;
            i32x8 af[4], bf[4];
#pragma unroll
            for (int n = 0; n < 4; ++n) { bf[n].lo = *(const LAS i32x4*)(sb + brd + n * 2048 + c0); bf[n].hi = *(const LAS i32x4*)(sb + brd + n * 2048 + c1); }
#pragma unroll
            for (int mh = 0; mh < 2; ++mh) {
#pragma unroll
                for (int m = 0; m < 4; ++m) { af[m].lo = *(const LAS i32x4*)(sb + ard + (4 * mh + m) * 2048 + c0); af[m].hi = *(const LAS i32x4*)(sb + ard + (4 * mh + m) * 2048 + c1); }
                asm volatile("s_waitcnt lgkmcnt(0)" ::: "memory");
                __builtin_amdgcn_s_setprio(1);
#pragma unroll
                for (int m = 0; m < 4; ++m)
#pragma unroll
                    for (int n = 0; n < 4; ++n) acc[4 * mh + m][n] = __builtin_amdgcn_mfma_scale_f32_16x16x128_f8f6f4(bf[n], af[m], acc[4 * mh + m][n], 0, 0, 0, 0x7f7f7f7f, 0, 0x7f7f7f7f);
                __builtin_amdgcn_s_setprio(0);
                __builtin_amdgcn_sched_barrier(0);
            }
#endif
            ++pos;
        }
        { Unit eu = cu; eu.row0 = __builtin_amdgcn_readfirstlane(cu.row0); eu.k = __builtin_amdgcn_readfirstlane(cu.k); eu.pn = __builtin_amdgcn_readfirstlane(cu.pn); eu.split = __builtin_amdgcn_readfirstlane(cu.split); eu.part = __builtin_amdgcn_readfirstlane(cu.part); int ej = i16, eq = q; asm volatile("" : "+v"(ej), "+v"(eq)); E(acc, eu, wr, wc, ej, eq);
#if PROBE_EPI
          if (((PROBE_EPI >> Epi::PB) & 1) && !eu.split) { asm volatile("" ::: "memory");
#pragma unroll
            for (int m_ = 0; m_ < 8; ++m_)
#pragma unroll
              for (int n_ = 0; n_ < 4; ++n_) asm volatile("" : "+v"(acc[m_][n_]));
            Epi E2 = E; if constexpr (Epi::RMW) E2.s = 0.f; E2(acc, eu, wr, wc, ej, eq); }
#endif
          }
        ++ci; if (!S.next(ci, cu)) break;
    }
    asm volatile("s_waitcnt vmcnt(0)" ::: "memory");
    __builtin_amdgcn_s_barrier();
#undef G8_GATHER
#undef G8_STAGE
}

template <int LD>
struct EpiSwiglu8 {
    static constexpr bool RMW = false; static constexpr int NST = 8, PB = 0;
    unsigned char* T; float s;
    __device__ __forceinline__ void operator()(const f32x4 (&acc)[8][4], const Unit& u, int wr, int wc, int j, int q) const {
        unsigned char* base = T + ((size_t)u.k * MOE_ROWS + u.row0 + 128 * wr + j) * LD + u.pn * 128 + 32 * wc + 8 * q;
        const float kf = -s * 1.4426950408889634f, cf = 1.0f / (s * s);
        const f32x2 kk = {kf, kf}, cc = {cf, cf};
#pragma unroll
        for (int m = 0; m < 8; ++m) { f32x2 t[4];
#pragma unroll
            for (int n = 0; n < 2; ++n)
#pragma unroll
                for (int h = 0; h < 2; ++h) { const f32x2 a = {acc[m][n][2 * h], acc[m][n][2 * h + 1]}, b = {acc[m][n + 2][2 * h], acc[m][n + 2][2 * h + 1]};
                    const f32x2 ab = a * b, x = a * kk; f32x2 e; e[0] = __builtin_amdgcn_exp2f(x[0]); e[1] = __builtin_amdgcn_exp2f(x[1]);
                    const f32x2 d = e * cc + cc; f32x2 r; r[0] = __builtin_amdgcn_rcpf(d[0]); r[1] = __builtin_amdgcn_rcpf(d[1]);
                    t[2 * n + h] = ab * r; }
            u32x2 w; w.x = pk4_fp8(t[0][0], t[0][1], t[1][0], t[1][1]); w.y = pk4_fp8(t[2][0], t[2][1], t[3][0], t[3][1]); *(u32x2*)(base + (size_t)(16 * m) * LD) = w; }
    }
};
struct EpiMoeDown8 {
    static constexpr bool RMW = false; static constexpr int NST = 32, PB = 1;
    bf16* Y; float s; bf16* slab0; bf16* slab1;
    __device__ __forceinline__ void operator()(const f32x4 (&acc)[8][4], const Unit& u, int wr, int wc, int j, int q) const {
        bf16* dst; size_t rstride;
        if (u.split) { dst = (u.k == 0 ? slab0 : slab1) + ((size_t)((((u.row0 >> 8) - 128) * 4 + u.pn) * MOE_P + u.part) << 16) + (size_t)(128 * wr + j) * 256 + 64 * wc + 4 * q; rstride = 256; }
        else { dst = Y + ((size_t)u.k * MOE_YROWS + u.row0 + 128 * wr + j) * D + u.pn * 256 + 64 * wc + 4 * q; rstride = D; }
#pragma unroll
        for (int m = 0; m < 8; ++m)
#pragma unroll
            for (int n = 0; n < 4; ++n) { const f32x4 v = acc[m][n] * s; u32x2 w; w.x = cvt_pk_bf16(v[0], v[1]); w.y = cvt_pk_bf16(v[2], v[3]); *(u32x2*)(dst + (size_t)(16 * m) * rstride + 16 * n) = w; }
    }
};
struct EpiResid8 {
    static constexpr bool RMW = true; static constexpr int NST = 32, PB = 2;
    float* xio; float* cio; const float* gate; float* slab; float s;
    __device__ __forceinline__ void operator()(const f32x4 (&acc)[8][4], const Unit& u, int wr, int wc, int j, int q) const {
        const int pm = u.row0 >> 8; float* io; const float* g;
        if (pm < RX / 256) { io = xio + (size_t)u.row0 * D; g = gate + (size_t)(pm >> 3) * 6144; } else { io = cio + (size_t)(u.row0 - RX) * D; g = gate + (size_t)16 * 6144; }
        const int col0 = u.pn * 256 + 64 * wc + 4 * q;
        f32x4 gv[4];
#pragma unroll
        for (int n = 0; n < 4; ++n) gv[n] = *(const f32x4*)(g + col0 + 16 * n) * s;
        float* sl = slab + ((size_t)(((pm - RX / 256) * 4 + u.pn) * FFN_P + u.part) << 16) + 64 * wc + 4 * q;
#pragma unroll
        for (int mb = 0; mb < 2; ++mb) {
            f32x4 bs[4][4];
            if (!u.split) {
#pragma unroll
                for (int mm = 0; mm < 4; ++mm)
#pragma unroll
                    for (int n = 0; n < 4; ++n) bs[mm][n] = *(const f32x4*)(io + (size_t)(128 * wr + 16 * (4 * mb + mm) + j) * D + col0 + 16 * n); }
            __builtin_amdgcn_sched_barrier(0);
#pragma unroll
            for (int mm = 0; mm < 4; ++mm) { const int m = 4 * mb + mm, rit = 128 * wr + 16 * m + j; float* o = io + (size_t)rit * D + col0;
#pragma unroll
                for (int n = 0; n < 4; ++n) { const f32x4 v = gv[n] * acc[m][n];
                    if (u.split) *(f32x4*)(sl + (size_t)rit * 256 + 16 * n) = v;
                    else *(f32x4*)(o + 16 * n) = bs[mm][n] + v; } }
            __builtin_amdgcn_sched_barrier(0); }
    }
};
}

struct Args { const float* in[33]; float* out; unsigned char* ws; int ph_lo, ph_hi; };
enum { I_X = 0, I_C, I_CTX, I_CCTX, I_MODW, I_MODB, I_N1G, I_N2G, I_WIN, I_WOUT, I_SCW, I_SCB, I_DTB, I_ALOG, I_SSDD, I_SNG, I_GNG, I_GNB, I_GWS, I_GBS, I_SCCW, I_CFW, I_CFB, I_CFG, I_CFNB,
       I_F1, I_F3, I_F2, I_RT, I_M1, I_M3, I_M2, I_FNG };
typedef const __attribute__((address_space(4))) Args* ArgsP;
struct Frame { LAS unsigned char* lds; int tid, lane, wave, vcu, G; unsigned char* ws; };

__device__ __forceinline__ void conv_job(const Frame& F, const float* W, int ldw, int K, int c0, int ncols, bf16* WT, int rowbase, int blk, int blkstride) {
    LAS float* scr = (LAS float*)(F.lds + F.wave * 16384);
    const int gw = F.vcu * 8 + F.wave, NGW = F.G * 8, lane = F.lane;
    const int nblk = ncols / 32, nitems = (K / 64) * nblk;
    for (int it = gw; it < nitems; it += NGW) {
        const int kb = it / nblk, nb = it % nblk, k0 = 64 * kb, n0 = 32 * nb;
        const int drow0 = rowbase + (n0 / blk) * blkstride + (n0 % blk);
#pragma unroll 8
        for (int i = 0; i < 32; ++i) { const int kk = 2 * i + (lane >> 5); scr[kk * 33 + (lane & 31)] = W[(size_t)(k0 + kk) * ldw + c0 + n0 + (lane & 31)]; }
        asm volatile("s_waitcnt lgkmcnt(0)" ::: "memory");
        const int c = lane & 7;
#pragma unroll
        for (int j = 0; j < 4; ++j) { const int n = (lane >> 3) + 8 * j; const LAS float* s = scr + (8 * c) * 33 + n;
            u32x4 o; o.x = cvt_pk_bf16(s[0 * 33], s[1 * 33]); o.y = cvt_pk_bf16(s[2 * 33], s[3 * 33]); o.z = cvt_pk_bf16(s[4 * 33], s[5 * 33]); o.w = cvt_pk_bf16(s[6 * 33], s[7 * 33]);
            *(u32x4*)(WT + (size_t)(drow0 + n) * K + k0 + 8 * c) = o; }
        asm volatile("s_waitcnt lgkmcnt(0)" ::: "memory");
    }
}

__device__ __forceinline__ void conv_job8(const Frame& F, const float* W, int ldw, int K, int ncols, unsigned char* WT, int mode, int half, float scale) {
    LAS float* scr = (LAS float*)(F.lds + F.wave * 16384);
    const int gw = F.vcu * 8 + F.wave, NGW = F.G * 8, lane = F.lane;
    const int nblk = ncols / 32, nitems = (K / 64) * nblk;
    for (int it = gw; it < nitems; it += NGW) {
        const int kb = it / nblk, nb = it % nblk, k0 = 64 * kb, n0 = 32 * nb;
#pragma unroll 8
        for (int i = 0; i < 32; ++i) { const int kk = 2 * i + (lane >> 5); scr[kk * 33 + (lane & 31)] = W[(size_t)(k0 + kk) * ldw + n0 + (lane & 31)] * scale; }
        asm volatile("s_waitcnt lgkmcnt(0)" ::: "memory");
        const int c = lane & 3;
#pragma unroll
        for (int jj = 0; jj < 2; ++jj) { const int n = (lane >> 2) + 16 * jj; const LAS float* sp = scr + (16 * c) * 33 + n;
            const int drow = mode == 0 ? n0 + n : (n0 >> 7) * 256 + ((n0 & 127) >> 5) * 64 + half * 32 + (16 * ((n >> 2) & 1) + 4 * (n >> 3) + (n & 3));
            u32x4 o; o.x = pk4_fp8(sp[0 * 33], sp[1 * 33], sp[2 * 33], sp[3 * 33]); o.y = pk4_fp8(sp[4 * 33], sp[5 * 33], sp[6 * 33], sp[7 * 33]);
            o.z = pk4_fp8(sp[8 * 33], sp[9 * 33], sp[10 * 33], sp[11 * 33]); o.w = pk4_fp8(sp[12 * 33], sp[13 * 33], sp[14 * 33], sp[15 * 33]);
            *(u32x4*)(WT + (size_t)drow * K + k0 + 16 * c) = o; }
        asm volatile("s_waitcnt lgkmcnt(0)" ::: "memory");
    }
}

__device__ __forceinline__ void p0_prologue(const Frame& F, ArgsP a) {
    unsigned char* ws = F.ws;
    if (F.vcu < 192) {
        LAS float* sc = (LAS float*)F.lds;
        LAS float* red = sc + 17 * 1024;
        for (int i = F.tid; i < 17 * 1024; i += 512) { const int b = i >> 10, k = i & 1023; const float v = b < 16 ? a->in[I_C][b * 1024 + k] : a->in[I_CCTX][k]; sc[i] = silu_f(v); }
        __syncthreads();
        float* modv = (float*)(ws + WS_MODV);
        for (int item = F.vcu; item < 192; item += F.G) {
            const int l = item / 96, cb = item % 96, col = cb * 64 + F.lane;
            const float* W = a->in[I_MODW] + (size_t)l * 1024 * 6144 + col;
            float acc[17];
#pragma unroll
            for (int b = 0; b < 17; ++b) acc[b] = 0.f;
            for (int k = F.wave * 128; k < F.wave * 128 + 128; ++k) { const float w = W[(size_t)k * 6144];
#pragma unroll
                for (int b = 0; b < 17; ++b) acc[b] += sc[b * 1024 + k] * w; }
#pragma unroll
            for (int b = 0; b < 17; ++b) red[(F.wave * 17 + b) * 64 + F.lane] = acc[b];
            __syncthreads();
            for (int o = F.tid; o < 17 * 64; o += 512) { const int b = o >> 6, ln = o & 63; float s = a->in[I_MODB][l * 6144 + cb * 64 + ln];
#pragma unroll
                for (int w = 0; w < 8; ++w) s += red[(w * 17 + b) * 64 + ln];
                modv[(size_t)(l * 17 + b) * 6144 + cb * 64 + ln] = s; }
            __syncthreads();
        }
    }
    __syncthreads();
    for (int l = 0; l < 2; ++l) {
        const float* win = a->in[I_WIN] + (size_t)l * D * INC; bf16* wt = (bf16*)(ws + WS_WIN) + (size_t)l * ZC * D;
        conv_job(F, win, INC, D, 0, 768, wt, 0, 1 << 30, 0);
        conv_job(F, win, INC, D, 776, 2048, wt, 768, 1 << 30, 0);
        conv_job(F, a->in[I_WOUT] + (size_t)l * D * D, D, D, 0, D, (bf16*)(ws + WS_WOUT) + (size_t)l * D * D, 0, 1 << 30, 0);
    }
#if FFN8
    conv_job8(F, a->in[I_F1], DFF, D, DFF, ws + WS_WUP, 1, 0, 64.0f);
    conv_job8(F, a->in[I_F3], DFF, D, DFF, ws + WS_WUP, 1, 1, 64.0f);
    conv_job8(F, a->in[I_F2], D, DFF, D, ws + WS_WDN, 0, 0, 64.0f);
#else
    conv_job(F, a->in[I_F1], DFF, D, 0, DFF, (bf16*)(ws + WS_WUP), 0, 128, 256);
    conv_job(F, a->in[I_F3], DFF, D, 0, DFF, (bf16*)(ws + WS_WUP), 128, 128, 256);
    conv_job(F, a->in[I_F2], D, DFF, 0, D, (bf16*)(ws + WS_WDN), 0, 1 << 30, 0);
#endif
    int* rowtok = (int*)(ws + WS_ROWTOK);
    for (int i = F.vcu * 512 + F.tid; i < 2 * MOE_ROWS; i += F.G * 512) rowtok[i] = -1;
    for (int i = F.vcu * 512 + F.tid; i < 2 * 4 * 128 * 128 / 2; i += F.G * 512) { const f32x2 v = *(const f32x2*)(a->in[I_GWS] + 2 * i); ((unsigned*)(ws + WS_WSB))[i] = cvt_pk_bf16(v[0], v[1]); }
}
__device__ __forceinline__ void moe_convert(const Frame& F, ArgsP a) {
    for (int e = 0; e < NE; ++e) {
        unsigned char* up = F.ws + WS_WMUP + (size_t)e * 2 * EFF * D;
        conv_job8(F, a->in[I_M1] + (size_t)e * D * EFF, EFF, D, EFF, up, 1, 0, 64.0f);
        conv_job8(F, a->in[I_M3] + (size_t)e * D * EFF, EFF, D, EFF, up, 1, 1, 64.0f);
        conv_job8(F, a->in[I_M2] + (size_t)e * EFF * D, D, EFF, D, F.ws + WS_WMDN + (size_t)e * D * EFF, 0, 0, 64.0f);
    }
}

template <int MODE>
__device__ __forceinline__ void norm_phase(const Frame& F, ArgsP a, int l, int nrows, const float* xsrc, const float* csrc, const float* gain, int slot_shift, int slot_scale, const float* fslab = nullptr) {
    unsigned char* ws = F.ws;
    LAS float* wx = (LAS float*)F.lds;
    LAS int* hist = (LAS int*)(F.lds + 8 * 1024 * 4);
    if (MODE == 0 || MODE == 2) {
        for (int i = F.tid; i < 8192; i += 512) { const int k = i >> 3, j = i & 7; wx[j * 1024 + k] = (MODE == 0) ? a->in[I_WIN][(size_t)l * D * INC + (size_t)k * INC + 768 + j] : a->in[I_RT][k * 8 + j]; }
        if (F.tid < 16) hist[F.tid] = 0;
        __syncthreads();
    }
    const float* modv = (const float*)(ws + WS_MODV) + (size_t)l * 17 * 6144;
    bf16* H = (bf16*)(ws + WS_H);
    const int gw = F.vcu * 8 + F.wave, NGW = F.G * 8, lane = F.lane;
    f32x4 gv[4];
#pragma unroll
    for (int j = 0; j < 4; ++j) gv[j] = *(const f32x4*)(gain + 4 * lane + 256 * j);
    for (int r = gw; r < nrows; r += NGW) {
        const float* xr; int mb;
        if (r < RX) { xr = xsrc + (size_t)r * D; mb = r >> 11; } else { xr = csrc + (size_t)(r - RX) * D; mb = 16; }
        const float* mv = modv + (size_t)mb * 6144;
        f32x4 v[4]; float ss = 0.f;
#pragma unroll
        for (int j = 0; j < 4; ++j) { v[j] = *(const f32x4*)(xr + 4 * lane + 256 * j);
            if (fslab != nullptr && r >= RX) {
#pragma unroll
                for (int part = 0; part < FFN_P; ++part) v[j] += *(const f32x4*)(fslab + ((size_t)((((r - RX) >> 8) * 4 + j) * FFN_P + part) << 16) + (size_t)((r - RX) & 255) * 256 + 4 * lane); }
            ss += (v[j][0] * v[j][0] + v[j][1] * v[j][1]) + (v[j][2] * v[j][2] + v[j][3] * v[j][3]); }
        const float rstd = 1.0f / sqrtf(wave_sum(ss) * (1.0f / D) + 1e-6f);
        float e[8];
#pragma unroll
        for (int q = 0; q < 8; ++q) e[q] = 0.f;
#pragma unroll
        for (int j = 0; j < 4; ++j) {
            const f32x4 sh = *(const f32x4*)(mv + slot_shift * 1024 + 4 * lane + 256 * j), sc = *(const f32x4*)(mv + slot_scale * 1024 + 4 * lane + 256 * j);
            const f32x4 hv = (v[j] * rstd) * gv[j] * (sc + 1.0f) + sh;
            if (MODE >= 2) *(unsigned*)((unsigned char*)H + (size_t)r * D + 4 * lane + 256 * j) = pk4_fp8(hv[0], hv[1], hv[2], hv[3]);
            else { u32x2 w; w.x = cvt_pk_bf16(hv[0], hv[1]); w.y = cvt_pk_bf16(hv[2], hv[3]); *(u32x2*)(H + (size_t)r * D + 4 * lane + 256 * j) = w; }
            if (MODE == 0 || MODE == 2) {
#pragma unroll
                for (int q = 0; q < 8; ++q) { const f32x4 wv = *(const LAS f32x4*)(wx + q * 1024 + 4 * lane + 256 * j); e[q] += (hv[0] * wv[0] + hv[1] * wv[1]) + (hv[2] * wv[2] + hv[3] * wv[3]); }
            }
        }
        if (MODE == 0) {
#pragma unroll
            for (int q = 0; q < 8; ++q) e[q] = wave_sum(e[q]);
            float mine = 0.f;
#pragma unroll
            for (int q = 0; q < 8; ++q) mine = (lane == q) ? e[q] : mine;
            if (lane < 8) ((float*)(ws + WS_DT))[(size_t)r * 8 + lane] = softplus_f(mine + a->in[I_DTB][l * 8 + lane]);
        }
        if (MODE == 2) {
#pragma unroll
            for (int q = 0; q < 8; ++q) e[q] = wave_sum(e[q]);
            int i0 = 0; float v0 = e[0];
#pragma unroll
            for (int q = 1; q < 8; ++q) if (e[q] > v0) { v0 = e[q]; i0 = q; }
            int i1 = -1; float v1 = -3.0e38f;
#pragma unroll
            for (int q = 0; q < 8; ++q) if (q != i0 && e[q] > v1) { v1 = e[q]; i1 = q; }
            const float p0 = 1.0f / (1.0f + __expf(v1 - v0)), p1 = 1.0f - p0;
            if (lane == 0) { int* te = (int*)(ws + WS_TOPE) + (size_t)r * 2; te[0] = i0; te[1] = i1; float* tp = (float*)(ws + WS_TOPP) + (size_t)r * 2; tp[0] = p0; tp[1] = p1;
                __hip_atomic_fetch_add(&hist[i0], 1, __ATOMIC_RELAXED, __HIP_MEMORY_SCOPE_WORKGROUP); __hip_atomic_fetch_add(&hist[8 + i1], 1, __ATOMIC_RELAXED, __HIP_MEMORY_SCOPE_WORKGROUP); }
        }
    }
    if (MODE == 2) {
        __syncthreads();
        if (F.tid < 16 && hist[F.tid] != 0) atomicAdd((unsigned*)(ws + WS_CTL) + CW_CNT + F.tid, (unsigned)hist[F.tid]);
    }
    __syncthreads();
}

__device__ __forceinline__ void chunk_geom(int c, int& r0, int& seq_lo, int& seq_hi) {
    r0 = c * 128;
    if (c < NCHX) { seq_lo = (c >> 4) * SEQ; seq_hi = seq_lo + SEQ; } else { seq_lo = RX + ((c - NCHX) >> 1) * CTXL; seq_hi = seq_lo + CTXL; }
}

template <int PART>
__device__ __forceinline__ void a1_item(const Frame& F, ArgsP a, int l, int c) {
    unsigned char* ws = F.ws;
    const bf16* Z = (const bf16*)(ws + WS_Z); bf16* XBC = (bf16*)(ws + WS_XBC); bf16* XT = (bf16*)(ws + WS_XT);
    const float* DT = (const float*)(ws + WS_DT); float* ACS = (float*)(ws + WS_ACS); float* ST = (float*)(ws + WS_ST);
    const float* scw = a->in[I_SCW] + (size_t)l * 5 * 768; const float* scb = a->in[I_SCB] + (size_t)l * 768;
    LAS bf16* RAW = (LAS bf16*)F.lds;
    LAS bf16* BT = (LAS bf16*)(F.lds + 33792);
    LAS bf16* XF = (LAS bf16*)(F.lds + 68608);
    LAS bf16* XB = (LAS bf16*)(F.lds + 103424);
    LAS float* wts = (LAS float*)(F.lds + 138240);
    int lane = F.lane; asm volatile("" : "+v"(lane)); const int wave = F.wave, tid = wave * 64 + lane, lj = lane & 15, lq = lane >> 4;
    int r0, slo, shi; chunk_geom(c, r0, slo, shi);
    __syncthreads();
    if (PART < 2 && wave < 4) {
        const int h = 2 * PART + (wave >> 1), dir = wave & 1; const float av = -__expf(a->in[I_ALOG][l * 8 + dir * 4 + h]);
        const int la = dir == 0 ? 2 * lane : 127 - 2 * lane, lb = dir == 0 ? 2 * lane + 1 : 126 - 2 * lane;
        const float da = DT[(size_t)(r0 + la) * 8 + dir * 4 + h], db = DT[(size_t)(r0 + lb) * 8 + dir * 4 + h];
        const float s0 = av * da, s1 = s0 + av * db;
        float inc = s1;
#pragma unroll
        for (int o = 1; o < 64; o <<= 1) { const float t = __shfl_up(inc, o); if (lane >= o) inc += t; }
        const float pre = inc - s1, ca = pre + s0, cb = pre + s1, tot = __shfl(inc, 63);
        ACS[(size_t)(r0 + la) * 8 + dir * 4 + h] = ca; ACS[(size_t)(r0 + lb) * 8 + dir * 4 + h] = cb;
        wts[(h * 2 + dir) * 128 + la] = __expf(tot - ca) * da; wts[(h * 2 + dir) * 128 + lb] = __expf(tot - cb) * db;
    }
    if (PART < 2) { const int g = PART;
#pragma unroll
        for (int pass = 0; pass < 2; ++pass) {
            const int xc0 = pass == 0 ? 256 + g * 128 : g * 128;
            __syncthreads();
            { u32x4 rv[5];
#pragma unroll
                for (int i = 0; i < 5; ++i) { const int t = tid + 512 * i, row = t >> 4, seg = t & 15, rr = r0 - 2 + row; const int rc = rr < slo ? slo : (rr >= shi ? shi - 1 : rr);
                    rv[i] = *(const u32x4*)(Z + (size_t)rc * ZC + xc0 + seg * 8); }
#pragma unroll
                for (int i = 0; i < 5; ++i) { const int t = tid + 512 * i, row = t >> 4, seg = t & 15, rr = r0 - 2 + row; const bool ok = rr >= slo && rr < shi;
                    if (t < 132 * 16) *(LAS u32x4*)(RAW + row * 128 + seg * 8) = ok ? rv[i] : (u32x4){0u, 0u, 0u, 0u}; } }
            __syncthreads();
            const int ch = tid & 127;
            float w[5];
#pragma unroll
            for (int k = 0; k < 5; ++k) w[k] = scw[k * 768 + xc0 + ch];
            const float bias = scb[xc0 + ch];
#pragma unroll 2
            for (int i = 0; i < 4; ++i) { const int lb = (tid >> 7) + 4 * i;
                const LAS bf16* rp = RAW + (8 * lb) * 128 + ch;
                float in[12];
#pragma unroll
                for (int t = 0; t < 12; ++t) in[t] = __uint_as_float((unsigned)rp[t * 128] << 16);
                float o[8];
#pragma unroll
                for (int jj = 0; jj < 8; ++jj) { float sacc = bias;
#pragma unroll
                    for (int k = 0; k < 5; ++k) sacc += w[k] * in[jj + k];
                    o[jj] = silu_f(sacc); }
                if (pass == 0) {
                    *(LAS u32x4*)(BT + ch * 136 + 8 * lb) = pack8(o);
#pragma unroll
                    for (int jj = 0; jj < 8; ++jj) XBC[(size_t)(r0 + 8 * lb + jj) * 768 + xc0 + ch] = (bf16)(cvt_pk_bf16(o[jj], 0.f) & 0xffffu);
                } else {
                    *(u32x4*)(XT + ((size_t)c * 256 + xc0 + ch) * 128 + 8 * lb) = pack8(o);
                    const int h = 2 * g + (ch >> 6);
                    const f32x4 f0 = *(const LAS f32x4*)(wts + (h * 2) * 128 + 8 * lb), f1 = *(const LAS f32x4*)(wts + (h * 2) * 128 + 8 * lb + 4);
                    const f32x4 b0 = *(const LAS f32x4*)(wts + (h * 2 + 1) * 128 + 8 * lb), b1 = *(const LAS f32x4*)(wts + (h * 2 + 1) * 128 + 8 * lb + 4);
                    float of[8], ob[8];
#pragma unroll
                    for (int jj = 0; jj < 4; ++jj) { of[jj] = o[jj] * f0[jj]; of[4 + jj] = o[4 + jj] * f1[jj]; ob[jj] = o[jj] * b0[jj]; ob[4 + jj] = o[4 + jj] * b1[jj]; }
                    *(LAS u32x4*)(XF + ch * 136 + 8 * lb) = pack8(of); *(LAS u32x4*)(XB + ch * 136 + 8 * lb) = pack8(ob);
                }
            }
        }
        __syncthreads();
        {
            const int hl = wave >> 2, dir = (wave >> 1) & 1, nh = wave & 1, h = 2 * g + hl;
            const LAS bf16* Ub = BT + (64 * nh + lj) * 136 + 8 * lq;
            const LAS bf16* Vb = (dir ? XB : XF) + (64 * hl + lj) * 136 + 8 * lq;
            f32x4 acc[4][4];
#pragma unroll
            for (int nt = 0; nt < 4; ++nt)
#pragma unroll
                for (int pt = 0; pt < 4; ++pt) acc[nt][pt] = (f32x4){0.f, 0.f, 0.f, 0.f};
#pragma unroll
            for (int k = 0; k < 4; ++k) { bf16x8 uf[4], vf[4];
#pragma unroll
                for (int t = 0; t < 4; ++t) { uf[t] = *(const LAS bf16x8*)(Ub + t * 16 * 136 + 32 * k); vf[t] = *(const LAS bf16x8*)(Vb + t * 16 * 136 + 32 * k); }
#pragma unroll
                for (int nt = 0; nt < 4; ++nt)
#pragma unroll
                    for (int pt = 0; pt < 4; ++pt) acc[nt][pt] = __builtin_amdgcn_mfma_f32_16x16x32_bf16(uf[nt], vf[pt], acc[nt][pt], 0, 0, 0); }
            float* sp = ST + ((size_t)(c * 2 + dir) * 4 + h) * 8192;
#pragma unroll
            for (int nt = 0; nt < 4; ++nt)
#pragma unroll
                for (int pt = 0; pt < 4; ++pt) *(f32x4*)(sp + (16 * pt + lj) * 128 + 64 * nh + 16 * nt + 4 * lq) = acc[nt][pt];
        }
    }
    if (PART == 2) { LAS bf16* RAW2 = (LAS bf16*)(F.lds + 33792);
        { u32x4 rv[9];
#pragma unroll
            for (int i = 0; i < 9; ++i) { const int t = tid + 512 * i, row = t >> 5, seg = t & 31, rr = r0 - 2 + row; const int rc = rr < slo ? slo : (rr >= shi ? shi - 1 : rr);
                rv[i] = *(const u32x4*)(Z + (size_t)rc * ZC + ZO_C + seg * 8); }
#pragma unroll
            for (int i = 0; i < 9; ++i) { const int t = tid + 512 * i, row = t >> 5, seg = t & 31, rr = r0 - 2 + row; const bool ok = rr >= slo && rr < shi;
                if (t < 132 * 32) *(LAS u32x4*)(RAW2 + row * 256 + seg * 8) = ok ? rv[i] : (u32x4){0u, 0u, 0u, 0u}; } }
        __syncthreads();
        const int cg = tid & 31, ch = 512 + cg * 8;
        f32x4 cw0[5], cw1[5];
#pragma unroll
        for (int k = 0; k < 5; ++k) { cw0[k] = *(const f32x4*)(scw + k * 768 + ch); cw1[k] = *(const f32x4*)(scw + k * 768 + ch + 4); }
        const f32x4 cb0 = *(const f32x4*)(scb + ch), cb1 = *(const f32x4*)(scb + ch + 4);
#pragma unroll 2
        for (int i = 0; i < 8; ++i) { const int lr = (tid >> 5) + 16 * i;
            float acc[8];
            acc[0] = cb0[0]; acc[1] = cb0[1]; acc[2] = cb0[2]; acc[3] = cb0[3]; acc[4] = cb1[0]; acc[5] = cb1[1]; acc[6] = cb1[2]; acc[7] = cb1[3];
#pragma unroll
            for (int k = 0; k < 5; ++k) { float zv[8]; unpack8(*(const LAS u32x4*)(RAW2 + (lr + k) * 256 + cg * 8), zv);
                const f32x4 w0 = cw0[k], w1 = cw1[k];
                acc[0] += w0[0] * zv[0]; acc[1] += w0[1] * zv[1]; acc[2] += w0[2] * zv[2]; acc[3] += w0[3] * zv[3]; acc[4] += w1[0] * zv[4]; acc[5] += w1[1] * zv[5]; acc[6] += w1[2] * zv[6]; acc[7] += w1[3] * zv[7]; }
#pragma unroll
            for (int jj = 0; jj < 8; ++jj) acc[jj] = silu_f(acc[jj]);
            *(u32x4*)(XBC + (size_t)(r0 + lr) * 768 + ch) = pack8(acc); }
    }
}

__device__ __forceinline__ void a2_item(const Frame& F, ArgsP a, int l, int c) {
    unsigned char* ws = F.ws;
    const bf16* Z = (const bf16*)(ws + WS_Z); bf16* MIX = (bf16*)(ws + WS_H); const bf16* WSB = (const bf16*)(ws + WS_WSB);
    LAS bf16* VT = (LAS bf16*)F.lds;
    int lane = F.lane; asm volatile("" : "+v"(lane)); const int wave = F.wave, lj = lane & 15, lq = lane >> 4, r0 = c * 128;
    __syncthreads();
    {
        float gg[4], bbv[4];
#pragma unroll
        for (int e = 0; e < 4; ++e) { gg[e] = a->in[I_GNG][l * 256 + lane + 64 * e]; bbv[e] = a->in[I_GNB][l * 256 + lane + 64 * e]; }
#pragma unroll
        for (int hb = 0; hb < 2; ++hb) {
            bf16 raw[8][4];
#pragma unroll
            for (int i = 0; i < 8; ++i)
#pragma unroll
                for (int e = 0; e < 4; ++e) raw[i][e] = Z[(size_t)(r0 + 16 * wave + 8 * hb + i) * ZC + ZO_V + lane + 64 * e];
            float o[4][8];
#pragma unroll
            for (int i = 0; i < 8; ++i) { float v[4];
#pragma unroll
                for (int e = 0; e < 4; ++e) v[e] = gelu_tanh_f(__uint_as_float((unsigned)raw[i][e] << 16));
                const float mu = wave_sum((v[0] + v[1]) + (v[2] + v[3])) * (1.0f / 256.0f);
#pragma unroll
                for (int e = 0; e < 4; ++e) v[e] -= mu;
                const float rs = 1.0f / sqrtf(wave_sum((v[0] * v[0] + v[1] * v[1]) + (v[2] * v[2] + v[3] * v[3])) * (1.0f / 256.0f) + 1e-5f);
#pragma unroll
                for (int e = 0; e < 4; ++e) o[e][i] = v[e] * rs * gg[e] + bbv[e]; }
#pragma unroll
            for (int e = 0; e < 4; ++e) *(LAS u32x4*)(VT + (lane + 64 * e) * 136 + 16 * wave + 8 * hb) = pack8(o[e]);
        }
    }
    __syncthreads();
    const int g = wave >> 1, th = wave & 1;
    const LAS bf16* Ub = VT + (g * 64 + lj) * 136 + 8 * lq;
    const bf16* Vg = WSB + ((size_t)(l * 4 + g) * 128 + 64 * th + lj) * 128 + 8 * lq;
    f32x4 acc[4][4];
#pragma unroll
    for (int dt = 0; dt < 4; ++dt)
#pragma unroll
        for (int tt = 0; tt < 4; ++tt) acc[dt][tt] = (f32x4){0.f, 0.f, 0.f, 0.f};
    __builtin_amdgcn_sched_barrier(0);
    bf16x8 vfa[4][4];
#pragma unroll
    for (int k = 0; k < 4; ++k)
#pragma unroll
        for (int t = 0; t < 4; ++t) vfa[k][t] = *(const bf16x8*)(Vg + t * 16 * 128 + 32 * k);
#pragma unroll
    for (int k = 0; k < 4; ++k) { bf16x8 uf[4];
#pragma unroll
        for (int t = 0; t < 4; ++t) uf[t] = *(const LAS bf16x8*)(Ub + t * 16 * 136 + 32 * k);
#pragma unroll
        for (int dt = 0; dt < 4; ++dt)
#pragma unroll
            for (int tt = 0; tt < 4; ++tt) acc[dt][tt] = __builtin_amdgcn_mfma_f32_16x16x32_bf16(uf[dt], vfa[k][tt], acc[dt][tt], 0, 0, 0); }
    __builtin_amdgcn_sched_barrier(0);
    u32x2 uwa[4][4];
#pragma unroll
    for (int tt = 0; tt < 4; ++tt)
#pragma unroll
        for (int dt = 0; dt < 4; ++dt) uwa[tt][dt] = *(const u32x2*)(Z + (size_t)(r0 + 64 * th + 16 * tt + lj) * ZC + ZO_U + g * 64 + 16 * dt + 4 * lq);
#pragma unroll
    for (int tt = 0; tt < 4; ++tt) { const int t = 64 * th + 16 * tt + lj, r = r0 + t; const float bs = a->in[I_GBS][((size_t)l * 4 + g) * 128 + t];
#pragma unroll
        for (int dt = 0; dt < 4; ++dt) { const int ch0 = g * 64 + 16 * dt + 4 * lq; const u32x2 uw = uwa[tt][dt]; const f32x4 sv4 = acc[dt][tt];
            u32x2 ow; ow.x = cvt_pk_bf16(gelu_tanh_f(bflo(uw.x)) * (sv4[0] + bs), gelu_tanh_f(bfhi(uw.x)) * (sv4[1] + bs)); ow.y = cvt_pk_bf16(gelu_tanh_f(bflo(uw.y)) * (sv4[2] + bs), gelu_tanh_f(bfhi(uw.y)) * (sv4[3] + bs));
            *(u32x2*)(MIX + (size_t)r * D + 256 + ch0) = ow; } }
}

__device__ __forceinline__ void a3_item(const Frame& F, ArgsP a, int l, int c) {
    unsigned char* ws = F.ws;
    const bf16* Z = (const bf16*)(ws + WS_Z); bf16* MIX = (bf16*)(ws + WS_H);
    int lane = F.lane; asm volatile("" : "+v"(lane)); const int wave = F.wave, tid = wave * 64 + lane;
    int r0, slo, shi; chunk_geom(c, r0, slo, shi);
    {
        { const float* w = a->in[I_SCCW] + (size_t)l * 3 * 256; const int ch = (tid & 31) * 8;
            f32x4 sw0[3], sw1[3];
#pragma unroll
            for (int k = 0; k < 3; ++k) { sw0[k] = *(const f32x4*)(w + k * 256 + ch); sw1[k] = *(const f32x4*)(w + k * 256 + ch + 4); }
#pragma unroll 1
            for (int bt = 0; bt < 2; ++bt) {
                u32x4 gcv[4][3], xiv[4][3], gbv[4];
#pragma unroll
                for (int t4 = 0; t4 < 4; ++t4) { const int lr = (tid >> 5) + 16 * (4 * bt + t4), r = r0 + lr;
#pragma unroll
                    for (int k = 0; k < 3; ++k) { const int rr = r + k - 1; const int rc = rr < slo ? slo : (rr >= shi ? shi - 1 : rr);
                        gcv[t4][k] = *(const u32x4*)(Z + (size_t)rc * ZC + ZO_GC + ch); xiv[t4][k] = *(const u32x4*)(Z + (size_t)rc * ZC + ZO_XIN + ch); }
                    gbv[t4] = *(const u32x4*)(Z + (size_t)r * ZC + ZO_GB + ch); }
#pragma unroll
                for (int t4 = 0; t4 < 4; ++t4) { const int lr = (tid >> 5) + 16 * (4 * bt + t4), r = r0 + lr;
                    float acc[8];
#pragma unroll
                    for (int j = 0; j < 8; ++j) acc[j] = 0.f;
#pragma unroll
                    for (int k = 0; k < 3; ++k) { const int rr = r + k - 1; const float ok = (rr >= slo && rr < shi) ? 1.0f : 0.0f;
                        float gc[8], xi[8]; unpack8(gcv[t4][k], gc); unpack8(xiv[t4][k], xi);
                        const f32x4 w0 = sw0[k] * ok, w1 = sw1[k] * ok;
#pragma unroll
                        for (int j = 0; j < 4; ++j) { acc[j] += w0[j] * (gc[j] * xi[j]); acc[4 + j] += w1[j] * (gc[4 + j] * xi[4 + j]); } }
                    float gb[8]; unpack8(gbv[t4], gb);
#pragma unroll
                    for (int j = 0; j < 8; ++j) acc[j] *= gb[j];
                    *(u32x4*)(MIX + (size_t)r * D + 512 + ch) = pack8(acc); } } }
        {
            LAS bf16* glu = (LAS bf16*)F.lds;
            LAS float* cvb = (LAS float*)F.lds;
            __syncthreads();
#pragma unroll 1
            for (int bt = 0; bt < 2; ++bt) {
                u32x4 cav[5], cgv[5];
#pragma unroll
                for (int t5 = 0; t5 < 5; ++t5) { const int task = tid + 512 * (5 * bt + t5), i = task >> 5, ch = (task & 31) * 8, rr = r0 - 15 + i; const int rc = rr < slo ? slo : (rr >= shi ? shi - 1 : rr);
                    cav[t5] = *(const u32x4*)(Z + (size_t)rc * ZC + ZO_CA + ch); cgv[t5] = *(const u32x4*)(Z + (size_t)rc * ZC + ZO_CG + ch); }
#pragma unroll
                for (int t5 = 0; t5 < 5; ++t5) { const int task = tid + 512 * (5 * bt + t5), i = task >> 5, ch = (task & 31) * 8, rr = r0 - 15 + i; const float ok = (rr >= slo && rr < shi) ? 1.0f : 0.0f;
                    float ca[8], cg[8], o[8]; unpack8(cav[t5], ca); unpack8(cgv[t5], cg);
#pragma unroll
                    for (int j = 0; j < 8; ++j) o[j] = ok * ca[j] * sigmoid_f(cg[j]);
                    if (task < 158 * 32) *(LAS u32x4*)(glu + i * 256 + ch) = pack8(o); } }
            LAS float* wl = (LAS float*)(F.lds + 81920);
            { float wv[16];
#pragma unroll
                for (int i = 0; i < 16; ++i) { const int idx = tid + 512 * i; wv[i] = a->in[I_CFW][(size_t)l * 31 * 256 + (idx < 31 * 256 ? idx : 0)]; }
#pragma unroll
                for (int i = 0; i < 16; ++i) { const int idx = tid + 512 * i; if (idx < 31 * 256) wl[idx] = wv[i]; } }
            __syncthreads();
            const int ch = tid & 255, lh = tid >> 8;
            const LAS float* wp = wl + ch; const LAS bf16* gp = glu + (64 * lh) * 256 + ch; LAS float* cp = cvb + (64 * lh) * 256 + ch;
            float w[31];
#pragma unroll
            for (int k = 0; k < 31; ++k) w[k] = wp[k * 256];
            const float cfb = a->in[I_CFB][l * 256 + ch];
            float res[8][8];
#pragma unroll
            for (int jb = 0; jb < 8; ++jb) {
                bf16 gv[38];
#pragma unroll
                for (int i = 0; i < 38; ++i) gv[i] = gp[(8 * jb + i) * 256];
                __builtin_amdgcn_sched_barrier(0);
#pragma unroll
                for (int j = 0; j < 8; ++j) res[jb][j] = cfb;
#pragma unroll
                for (int i = 0; i < 38; ++i) { const float g = __uint_as_float((unsigned)gv[i] << 16);
#pragma unroll
                    for (int k = 0; k < 31; ++k) { const int lo = i - k; if (lo >= 0 && lo < 8) res[jb][lo] += w[k] * g; } }
                __builtin_amdgcn_sched_barrier(0);
            }
            __syncthreads();
#pragma unroll
            for (int jb = 0; jb < 8; ++jb)
#pragma unroll
                for (int j = 0; j < 8; ++j) cp[(8 * jb + j) * 256] = res[jb][j];
            __syncthreads();
            const f32x4 g = *(const f32x4*)(a->in[I_CFG] + l * 256 + 4 * lane), bb = *(const f32x4*)(a->in[I_CFNB] + l * 256 + 4 * lane);
            for (int lr = wave; lr < 128; lr += 8) { f32x4 v = *(const LAS f32x4*)(cvb + lr * 256 + 4 * lane);
                const float mu = wave_sum((v[0] + v[1]) + (v[2] + v[3])) * (1.0f / 256.0f); v = v - mu;
                const float var = wave_sum((v[0] * v[0] + v[1] * v[1]) + (v[2] * v[2] + v[3] * v[3])) * (1.0f / 256.0f);
                const f32x4 o = v * (1.0f / sqrtf(var + 1e-5f)) * g + bb;
                u32x2 ow; ow.x = cvt_pk_bf16(silu_f(o[0]), silu_f(o[1])); ow.y = cvt_pk_bf16(silu_f(o[2]), silu_f(o[3]));
                *(u32x2*)(MIX + (size_t)(r0 + lr) * D + 768 + 4 * lane) = ow; }
            __syncthreads();
        }
    }
}

__device__ __forceinline__ void pa_phase(const Frame& F, ArgsP a, int l, int nfull, int nall) {
    const int n2 = nfull, n3 = 2 * nfull, n4 = n3 + nall, n5 = n4 + nall, n6 = n5 + nall;
    for (int it = F.vcu; it < n6; it += F.G) {
        if (it < n2) a2_item(F, a, l, it);
        else if (it < n3) a3_item(F, a, l, it - n2);
        else if (it < n4) a1_item<0>(F, a, l, it - n3);
        else if (it < n5) a1_item<1>(F, a, l, it - n4);
        else a1_item<2>(F, a, l, it - n5);
    }
    __syncthreads();
}

__device__ __forceinline__ void m3_phase(const Frame& F) {
    unsigned char* ws = F.ws; const float* ST = (const float*)(ws + WS_ST); bf16* STE = (bf16*)(ws + WS_STE); const float* ACS = (const float*)(ws + WS_ACS);
    for (int task = F.vcu * 512 + F.tid; task < BATCH * 2 * 4 * 2048; task += F.G * 512) {
        const int q = task & 2047, h = (task >> 11) & 3, dir = (task >> 13) & 1, b = task >> 14;
        f32x4 e = {0.f, 0.f, 0.f, 0.f};
        for (int step = 0; step < 18; ++step) {
            int c;
            if (dir == 0) c = step < 2 ? NCHX + 2 * b + step : 16 * b + (step - 2);
            else c = step < 2 ? NCHX + 2 * b + (1 - step) : 16 * b + (17 - step);
            const float dec = __expf(dir == 0 ? ACS[(size_t)(c * 128 + 127) * 8 + h] : ACS[(size_t)(c * 128) * 8 + 4 + h]);
            const size_t eo = ((size_t)(c * 2 + dir) * 4 + h) * 8192 + (size_t)q * 4;
            const f32x4 s = *(const f32x4*)(ST + eo);
            u32x2 w; w.x = cvt_pk_bf16(e[0], e[1]); w.y = cvt_pk_bf16(e[2], e[3]); *(u32x2*)(STE + eo) = w;
            e = e * dec + s;
        }
    }
}

__device__ __forceinline__ void pc_phase(const Frame& F, ArgsP a, int l, int nchunks) {
    unsigned char* ws = F.ws;
    const bf16* Z = (const bf16*)(ws + WS_Z); const bf16* XBC = (const bf16*)(ws + WS_XBC); const bf16* XT = (const bf16*)(ws + WS_XT); const bf16* STE = (const bf16*)(ws + WS_STE);
    const float* DT = (const float*)(ws + WS_DT); const float* ACS = (const float*)(ws + WS_ACS); bf16* MIX = (bf16*)(ws + WS_H);
    LAS unsigned char* BL = F.lds;
    LAS unsigned char* XL = F.lds + 32768;
    LAS unsigned char* SL = F.lds + 65536;
    LAS float* sv = (LAS float*)(F.lds + 131072);
    LAS float* exch = sv + 2048;
    const int tid = F.tid, lane = F.lane, wave = F.wave, j = lane & 15, q = lane >> 4, lt = wave >> 1, hl = wave & 1;
    const int srow = tid >> 4, cpos = tid & 15;
    const unsigned ldsw = (unsigned)wave * 1024u;
    for (int item = F.vcu; item < nchunks * 2; item += F.G) {
        const int c = item >> 1, r0 = c * 128, l0 = 64 * (item & 1) + 16 * lt, lrow = l0 + j;
        __syncthreads();
        for (int i = tid; i < 1024; i += 512) { const int row = i >> 3, col = i & 7; sv[(col >> 2) * 512 + (col & 3) * 128 + row] = ACS[(size_t)(r0 + row) * 8 + col]; sv[1024 + (col >> 2) * 512 + (col & 3) * 128 + row] = DT[(size_t)(r0 + row) * 8 + col]; }
        f32x4 Yt[2][4];
#pragma unroll
        for (int g = 0; g < 2; ++g) {
            const int h = 2 * g + hl;
#pragma unroll
            for (int jj = 0; jj < 4; ++jj) { const int row = srow + 32 * jj; const int sc = 8 * (cpos ^ (row & 15));
                __builtin_amdgcn_global_load_lds((const unsigned*)(XBC + (size_t)(r0 + row) * 768 + 256 + g * 128 + sc), (LAS unsigned*)(BL + jj * 8192 + ldsw), 16, 0, 0);
                __builtin_amdgcn_global_load_lds((const unsigned*)(XT + ((size_t)c * 256 + g * 128 + row) * 128 + sc), (LAS unsigned*)(XL + jj * 8192 + ldsw), 16, 0, 0); }
#pragma unroll
            for (int b = 0; b < 4; ++b)
#pragma unroll
                for (int jj = 0; jj < 2; ++jj) { const int row = srow + 32 * jj; const int sc = 8 * (cpos ^ (row & 15));
                    __builtin_amdgcn_global_load_lds((const unsigned*)(STE + (((size_t)(c * 2 + (b & 1)) * 4 + 2 * g + (b >> 1)) * 64 + row) * 128 + sc), (LAS unsigned*)(SL + b * 16384 + jj * 8192 + ldsw), 16, 0, 0); }
            bf16x8 cf[4];
            { const bf16* Cn = XBC + (size_t)(r0 + lrow) * 768 + 512 + g * 128 + 8 * q;
#pragma unroll
                for (int k = 0; k < 4; ++k) cf[k] = *(const bf16x8*)(Cn + 32 * k); }
            asm volatile("s_waitcnt vmcnt(0)" ::: "memory");
            __syncthreads();
            f32x4 G[8];
#pragma unroll
            for (int st = 0; st < 8; ++st) { G[st] = (f32x4){0.f, 0.f, 0.f, 0.f};
#pragma unroll
                for (int k = 0; k < 4; ++k) G[st] = __builtin_amdgcn_mfma_f32_16x16x32_bf16(*(const LAS bf16x8*)(BL + (16 * st + j) * 256 + 16 * ((4 * k + q) ^ j)), cf[k], G[st], 0, 0, 0); }
            const float afl = sv[h * 128 + lrow], abl = sv[512 + h * 128 + lrow], Dh = a->in[I_SSDD][l * 4 + h];
            bf16x8 wf[4];
#pragma unroll
            for (int J = 0; J < 4; ++J) { float wv[8];
#pragma unroll
                for (int hf = 0; hf < 2; ++hf)
#pragma unroll
                    for (int r = 0; r < 4; ++r) { const int st = 2 * J + hf, sidx = 16 * st + 4 * q + r; float m = 0.f;
                        if (sidx <= lrow) m += fexp(afl - sv[h * 128 + sidx]) * sv[1024 + h * 128 + sidx];
                        if (sidx >= lrow) m += fexp(abl - sv[512 + h * 128 + sidx]) * sv[1536 + h * 128 + sidx];
                        wv[4 * hf + r] = G[st][r] * m + (sidx == lrow ? Dh : 0.f); }
                const u32x4 pk = pack8(wv); wf[J] = __builtin_bit_cast(bf16x8, pk); }
            f32x4 Y[4];
#pragma unroll
            for (int pt = 0; pt < 4; ++pt) { Y[pt] = (f32x4){0.f, 0.f, 0.f, 0.f}; const int row = hl * 64 + 16 * pt + j; const LAS unsigned char* xp = XL + row * 256 + 8 * (q & 1);
#pragma unroll
                for (int J = 0; J < 4; ++J) { const u32x2 lo = *(const LAS u32x2*)(xp + 16 * ((4 * J + (q >> 1)) ^ j)), hi = *(const LAS u32x2*)(xp + 16 * ((4 * J + 2 + (q >> 1)) ^ j)); const u32x4 xw = {lo.x, lo.y, hi.x, hi.y};
                    Y[pt] = __builtin_amdgcn_mfma_f32_16x16x32_bf16(__builtin_bit_cast(bf16x8, xw), wf[J], Y[pt], 0, 0, 0); } }
#pragma unroll
            for (int dir = 0; dir < 2; ++dir) { const float e = fexp(dir == 0 ? afl : abl); const LAS unsigned char* sp = SL + (hl * 2 + dir) * 16384;
#pragma unroll
                for (int pt = 0; pt < 4; ++pt) { f32x4 yd = {0.f, 0.f, 0.f, 0.f};
#pragma unroll
                    for (int k = 0; k < 4; ++k) yd = __builtin_amdgcn_mfma_f32_16x16x32_bf16(*(const LAS bf16x8*)(sp + (16 * pt + j) * 256 + 16 * ((4 * k + q) ^ j)), cf[k], yd, 0, 0, 0);
                    Y[pt] += yd * e; } }
#pragma unroll
            for (int pt = 0; pt < 4; ++pt) Yt[g][pt] = Y[pt];
            if (g == 0) __syncthreads();
        }
        float ssq = 0.f;
#pragma unroll
        for (int g = 0; g < 2; ++g)
#pragma unroll
            for (int pt = 0; pt < 4; ++pt) { const int ch = (2 * g + hl) * 64 + 16 * pt + 4 * q; const u32x2 zw = *(const u32x2*)(Z + (size_t)(r0 + lrow) * ZC + ZO_Z + ch);
                f32x4 v = Yt[g][pt]; v[0] *= silu_f(bflo(zw.x)); v[1] *= silu_f(bfhi(zw.x)); v[2] *= silu_f(bflo(zw.y)); v[3] *= silu_f(bfhi(zw.y)); Yt[g][pt] = v;
                ssq += (v[0] * v[0] + v[1] * v[1]) + (v[2] * v[2] + v[3] * v[3]); }
        ssq += __shfl_xor(ssq, 16); ssq += __shfl_xor(ssq, 32);
        if (q == 0) exch[(hl * 4 + lt) * 16 + j] = ssq;
        __syncthreads();
        const float rstd = 1.0f / sqrtf((exch[lt * 16 + j] + exch[(4 + lt) * 16 + j]) * (1.0f / 256.0f) + 1e-6f);
#pragma unroll
        for (int g = 0; g < 2; ++g)
#pragma unroll
            for (int pt = 0; pt < 4; ++pt) { const int ch = (2 * g + hl) * 64 + 16 * pt + 4 * q; const f32x4 ng = *(const f32x4*)(a->in[I_SNG] + l * 256 + ch); const f32x4 o = Yt[g][pt] * rstd * ng;
                u32x2 ow; ow.x = cvt_pk_bf16(o[0], o[1]); ow.y = cvt_pk_bf16(o[2], o[3]); *(u32x2*)(MIX + (size_t)(r0 + lrow) * D + ch) = ow; }
    }
    __syncthreads();
}

__device__ __forceinline__ void moe_assign(const Frame& F) {
    unsigned char* ws = F.ws; const unsigned* cnt = (const unsigned*)(ws + WS_CTL) + CW_CNT; unsigned* run = (unsigned*)(ws + WS_CTL) + CW_RUN;
    const int* tope = (const int*)(ws + WS_TOPE); const float* topp = (const float*)(ws + WS_TOPP); int* rowtok = (int*)(ws + WS_ROWTOK); float* rowp = (float*)(ws + WS_ROWP);
    int pre[2][8];
#pragma unroll
    for (int k = 0; k < 2; ++k) { int s = 0;
#pragma unroll
        for (int e = 0; e < 8; ++e) { pre[k][e] = s; s += ((int)__hip_atomic_load(cnt + k * 8 + e, RLX_AGENT) + 255) >> 8; } }
    const int gw = F.vcu * 8 + F.wave, NGW = F.G * 8, lane = F.lane;
    for (int base = gw * 64; base < RX; base += NGW * 64) {
        const int tok = base + lane;
#pragma unroll
        for (int k = 0; k < 2; ++k) { const int e = tope[(size_t)tok * 2 + k]; int slot = 0;
#pragma unroll
            for (int q = 0; q < 8; ++q) { const unsigned long long m = __ballot(e == q);
                if (m != 0ull) { unsigned b0 = 0; if (lane == 0) b0 = __hip_atomic_fetch_add(run + k * 8 + q, (unsigned)__popcll(m), RLX_AGENT); b0 = __shfl(b0, 0);
                    if (e == q) slot = 256 * pre[k][q] + (int)b0 + __popcll(m & ((1ull << lane) - 1ull)); } }
            rowtok[k * MOE_ROWS + slot] = tok; rowp[k * MOE_ROWS + slot] = topp[(size_t)tok * 2 + k]; ((int*)(ws + WS_SLOT))[k * RX + tok] = slot; }
    }
}

__device__ __forceinline__ void final_norm(const Frame& F, ArgsP a) {
    const int gw = F.vcu * 8 + F.wave, NGW = F.G * 8, lane = F.lane;
    const float* gate = (const float*)(F.ws + WS_MODV) + 17 * 6144 + 5 * 1024;
    const bf16* Y = (const bf16*)(F.ws + WS_Y);
    f32x4 gv[4];
#pragma unroll
    for (int j = 0; j < 4; ++j) gv[j] = *(const f32x4*)(a->in[I_FNG] + 4 * lane + 256 * j);
    for (int r = gw; r < RX; r += NGW) { float* xr = a->out + (size_t)r * D; f32x4 v[4], y[4]; float ss = 0.f;
        const f32x2 pp = *(const f32x2*)((const float*)(F.ws + WS_TOPP) + (size_t)r * 2);
        const int sl0 = ((const int*)(F.ws + WS_SLOT))[r], sl1 = ((const int*)(F.ws + WS_SLOT))[RX + r];
#pragma unroll
        for (int j = 0; j < 4; ++j) { v[j] = *(const f32x4*)(xr + 4 * lane + 256 * j); y[j] = (f32x4){0.f, 0.f, 0.f, 0.f}; }
#pragma unroll
        for (int k = 0; k < 2; ++k) { const int sl = k == 0 ? sl0 : sl1; const float p = k == 0 ? pp[0] : pp[1];
            if (sl < MOE_YROWS) { const bf16* yr = Y + ((size_t)k * MOE_YROWS + sl) * D + 4 * lane;
#pragma unroll
                for (int j = 0; j < 4; ++j) { const u32x2 w = *(const u32x2*)(yr + 256 * j); y[j][0] += p * bflo(w.x); y[j][1] += p * bfhi(w.x); y[j][2] += p * bflo(w.y); y[j][3] += p * bfhi(w.y); } }
            else {
                const bf16* sb = (const bf16*)(F.ws + (k == 0 ? WS_MSLAB0 : WS_MSLAB1)) + (size_t)(sl & 255) * 256 + 4 * lane; const int tl = (sl >> 8) - 128;
#pragma unroll
                for (int j = 0; j < 4; ++j)
#pragma unroll
                    for (int part = 0; part < MOE_P; ++part) { const u32x2 w = *(const u32x2*)(sb + ((size_t)((tl * 4 + j) * MOE_P + part) << 16)); y[j][0] += p * bflo(w.x); y[j][1] += p * bfhi(w.x); y[j][2] += p * bflo(w.y); y[j][3] += p * bfhi(w.y); } } }
        const float* g = gate + (size_t)(r >> 11) * 6144 + 4 * lane;
#pragma unroll
        for (int j = 0; j < 4; ++j) { v[j] += *(const f32x4*)(g + 256 * j) * y[j]; ss += (v[j][0] * v[j][0] + v[j][1] * v[j][1]) + (v[j][2] * v[j][2] + v[j][3] * v[j][3]); }
        const float rstd = 1.0f / sqrtf(wave_sum(ss) * (1.0f / D) + 1e-6f);
#pragma unroll
        for (int j = 0; j < 4; ++j) *(f32x4*)(xr + 4 * lane + 256 * j) = v[j] * rstd * gv[j]; }
}

__device__ __forceinline__ void phase_begin(Frame& F, int wave0) {
    int w = wave0; asm volatile("" : "+s"(w));
    int ln = (int)__builtin_amdgcn_mbcnt_hi(~0u, __builtin_amdgcn_mbcnt_lo(~0u, 0u)); asm volatile("" : "+v"(ln));
    F.wave = w; F.lane = ln; F.tid = w * 64 + ln; }
enum { PH_P0 = 0, PH0_N1, PH0_WIN, PH0_MA, PH0_M3, PH0_MC, PH0_WOUT, PH0_N2, PH0_UP, PH0_DN,
       PH1_N1, PH1_WIN, PH1_MA, PH1_M3, PH1_MC, PH1_WOUT, PH1_N2R, PH1_ASG, PH1_UP, PH1_DN0, PH1_DN1, PH_FIN, NPHASE };
__global__ void __launch_bounds__(512, 2) fwd_kernel(Args args_unused) {
    extern __shared__ __attribute__((aligned(16))) unsigned char lds_raw[];
    ArgsP ap = (ArgsP)__builtin_amdgcn_kernarg_segment_ptr();
    Frame F;
    F.lds = (LAS unsigned char*)lds_raw;
    const int wave0 = __builtin_amdgcn_readfirstlane((int)threadIdx.x >> 6);
    phase_begin(F, wave0);
    F.G = gridDim.x; { const int bx = blockIdx.x; F.vcu = (F.G % 8 == 0) ? (bx % 8) * (F.G / 8) + bx / 8 : bx; }
    F.ws = ap->ws;
    volatile LAS unsigned* MISC = (volatile LAS unsigned*)(F.lds + MISC_OFF);
    if (F.tid < 64) MISC[F.tid] = 0u;
    __syncthreads();
    XcdBarrier bar; bar.bar = (unsigned*)(ap->ws + WS_CTL) + CW_BAR; bar.x = 0; bar.st = nullptr;
    const int lo = ap->ph_lo, hi = ap->ph_hi;
    if (hi - lo > 1) bar = xcd_barrier_post((unsigned*)(ap->ws + WS_CTL) + CW_BAR, MISC + 8, F.tid);
#define IN(k) (phase_begin(F, wave0), ({ asm volatile("" : "+s"(ap)); }), F.ws = ap->ws, lo <= (k) && (k) < hi)
#define SEAM(k) do { if (IN(k) && IN((k) + 1)) xcd_barrier(bar, F.tid); } while (0)
    const int c = (int)blockIdx.x;
#define XC ((float*)(F.ws + WS_XC))
#define H ((bf16*)(F.ws + WS_H))
#define Zb ((bf16*)(F.ws + WS_Z))
#define modv ((const float*)(F.ws + WS_MODV))
#define ctl ((unsigned*)(F.ws + WS_CTL))

    if (IN(PH_P0)) { p0_prologue(F, ap); } SEAM(PH_P0);
    if (IN(PH0_N1)) { norm_phase<0>(F, ap, 0, RT, ap->in[I_X], ap->in[I_CTX], ap->in[I_N1G], 0, 1); } SEAM(PH0_N1);
    if (IN(PH0_WIN)) { pg8::RegSched S; S.init(H, F.ws + WS_WIN, D, RT / 256, ZC / 256, 0, 1, 0, F.G, c); pg8::EpiStoreBf16 E{Zb, ZC};
        pg8::gemm_phase<pg8::EpiStoreBf16, pg8::RegSched, false>(F.lds, D, S, E, F.tid); } SEAM(PH0_WIN);
    if (IN(PH0_MA)) { pa_phase(F, ap, 0, NCH, NCH); } SEAM(PH0_MA);
    if (IN(PH0_M3)) { m3_phase(F); } SEAM(PH0_M3);
    if (IN(PH0_MC)) { pc_phase(F, ap, 0, NCH); } SEAM(PH0_MC);
    if (IN(PH0_WOUT)) { pg8::RegSched S; S.init(H, F.ws + WS_WOUT, D, RT / 256, D / 256, 0, 1, 0, F.G, c); { pg8::EpiResid E{ap->in[I_X], ap->out, ap->in[I_CTX], XC, modv + 2 * 1024, (float*)(F.ws + WS_FSLAB)};
        pg8::gemm_phase<pg8::EpiResid, pg8::RegSched, false>(F.lds, D, S, E, F.tid); } } SEAM(PH0_WOUT);
#if FFN8
    if (IN(PH0_N2)) { norm_phase<3>(F, ap, 0, RT, ap->out, XC, ap->in[I_N2G], 3, 4); } SEAM(PH0_N2);
    if (IN(PH0_UP)) { g8::SchedD S; S.nMw = RT / 256; S.nN = 2 * DFF / 256; S.nMt = 0; S.G = F.G; S.c = c; S.nt = D / 128; S.P = 1; S.A = (const char*)H; S.tstepA = (size_t)256 * D; S.W = (const char*)(F.ws + WS_WUP); S.tstepB = (size_t)256 * D;
        g8::EpiSwiglu8<DFF> E{F.ws + WS_Z, 1.0f / 64.0f};
        g8::gemm8_phase<g8::EpiSwiglu8<DFF>, g8::SchedD, false>(F.lds, D, S, E, nullptr, F.tid); } SEAM(PH0_UP);
    if (IN(PH0_DN)) { g8::SchedD S; S.nMw = RX / 256; S.nN = D / 256; S.nMt = RC / 256; S.G = F.G; S.c = c; S.nt = DFF / 128; S.P = FFN_P; S.A = (const char*)(F.ws + WS_Z); S.tstepA = (size_t)256 * DFF; S.W = (const char*)(F.ws + WS_WDN); S.tstepB = (size_t)256 * DFF;
        g8::EpiResid8 E{ap->out, XC, modv + 5 * 1024, (float*)(F.ws + WS_FSLAB), 1.0f / 64.0f};
        g8::gemm8_phase<g8::EpiResid8, g8::SchedD, false>(F.lds, DFF, S, E, nullptr, F.tid); } SEAM(PH0_DN);
#else
    if (IN(PH0_N2)) { norm_phase<1>(F, ap, 0, RT, ap->out, XC, ap->in[I_N2G], 3, 4); } SEAM(PH0_N2);
    if (IN(PH0_UP)) { pg8::RegSched S; S.init(H, F.ws + WS_WUP, D, RT / 256, 2 * DFF / 256, 0, 1, 0, F.G, c); pg8::EpiSwiglu E{Zb, DFF};
        pg8::gemm_phase<pg8::EpiSwiglu, pg8::RegSched, false>(F.lds, D, S, E, F.tid); } SEAM(PH0_UP);
    if (IN(PH0_DN)) { pg8::RegSched S; S.init(Zb, F.ws + WS_WDN, DFF, RX / 256, D / 256, RC / 256, D / 256, RX / 256, F.G, c, FFN_P); { pg8::EpiResid E{ap->out, ap->out, XC, XC, modv + 5 * 1024, (float*)(F.ws + WS_FSLAB)};
        pg8::gemm_phase<pg8::EpiResid, pg8::RegSched, false>(F.lds, DFF, S, E, F.tid); } } SEAM(PH0_DN);
#endif
    if (IN(PH1_N1)) { norm_phase<0>(F, ap, 1, RT, ap->out, XC, ap->in[I_N1G] + D, 0, 1, (const float*)(F.ws + WS_FSLAB)); } SEAM(PH1_N1);
    if (IN(PH1_WIN)) { pg8::RegSched S; S.init(H, F.ws + WS_WIN + (size_t)ZC * D * 2, D, RX / 256, ZC / 256, RC / 256, 3, RX / 256, F.G, c); pg8::EpiStoreBf16 E{Zb, ZC};
        pg8::gemm_phase<pg8::EpiStoreBf16, pg8::RegSched, false>(F.lds, D, S, E, F.tid); } SEAM(PH1_WIN);
    if (IN(PH1_MA)) { pa_phase(F, ap, 1, NCHX, NCH); } SEAM(PH1_MA);
    if (IN(PH1_M3)) { m3_phase(F); } SEAM(PH1_M3);
    if (IN(PH1_MC)) { pc_phase(F, ap, 1, NCHX); } SEAM(PH1_MC);
    if (IN(PH1_WOUT)) { pg8::RegSched S; S.init(H, F.ws + WS_WOUT + (size_t)D * D * 2, D, RX / 256, D / 256, 0, 1, 0, F.G, c); { pg8::EpiResid E{ap->out, ap->out, XC, XC, modv + 17 * 6144 + 2 * 1024, (float*)(F.ws + WS_FSLAB)};
        pg8::gemm_phase<pg8::EpiResid, pg8::RegSched, false>(F.lds, D, S, E, F.tid); } } SEAM(PH1_WOUT);
    if (IN(PH1_N2R)) { norm_phase<2>(F, ap, 1, RX, ap->out, XC, ap->in[I_N2G] + D, 3, 4); moe_convert(F, ap); } SEAM(PH1_N2R);
    if (IN(PH1_ASG)) { moe_assign(F); } SEAM(PH1_ASG);
    if (IN(PH1_UP) || IN(PH1_DN0) || IN(PH1_DN1)) {
        g8::Sched S;
#pragma unroll
        for (int k = 0; k < 2; ++k) { int sacc = 0;
#pragma unroll
            for (int e = 0; e < 8; ++e) { if (k == 0) S.pre0[e] = sacc; else S.pre1[e] = sacc; sacc += (__builtin_amdgcn_readfirstlane((int)__hip_atomic_load(ctl + CW_CNT + k * 8 + e, RLX_AGENT)) + 255) >> 8; } if (k == 0) S.pre0[8] = sacc; else S.pre1[8] = sacc; }
        S.G = F.G; S.c = c;
        if (IN(PH1_UP)) {
            S.k0 = 0; S.npass = 2; S.P = 1; S.nN = 2 * EFF / 256; S.nt = D / 128; S.Abase = (const char*)H; S.arow = 0; S.apass = 0; S.Wbase = (const char*)(F.ws + WS_WMUP); S.wstride = (size_t)2 * EFF * D; S.tstepB = (size_t)256 * D;
            g8::EpiSwiglu8<EFF> E{F.ws + WS_T, 1.0f / 64.0f};
            g8::gemm8_phase<g8::EpiSwiglu8<EFF>, g8::Sched, true>(F.lds, D, S, E, (const int*)(F.ws + WS_ROWTOK), F.tid); }
        SEAM(PH1_UP);
#pragma unroll
        for (int k = 0; k < 2; ++k) {
            if (IN(PH1_DN0 + k)) { S.k0 = k; S.npass = 1; S.P = MOE_P; S.nN = D / 256; S.nt = EFF / 128; S.Abase = (const char*)(F.ws + WS_T); S.arow = EFF; S.apass = (size_t)MOE_ROWS * EFF; S.Wbase = (const char*)(F.ws + WS_WMDN); S.wstride = (size_t)D * EFF; S.tstepB = (size_t)256 * EFF;
                g8::EpiMoeDown8 E{(bf16*)(F.ws + WS_Y), 1.0f / 64.0f, (bf16*)(F.ws + WS_MSLAB0), (bf16*)(F.ws + WS_MSLAB1)};
                g8::gemm8_phase<g8::EpiMoeDown8, g8::Sched, false>(F.lds, EFF, S, E, nullptr, F.tid); }
            SEAM(PH1_DN0 + k);
        }
    }
    if (IN(PH_FIN)) { final_norm(F, ap); }
#undef IN
#undef SEAM
#undef XC
#undef H
#undef Zb
#undef modv
#undef ctl
}

extern "C" void kernel_launch(void* const* d_in, const int* in_sizes, int n_in, void* d_out, int out_size, void* d_ws, size_t ws_size, hipStream_t stream) {
    static int grid = 0;
    if (grid == 0) {
        if (n_in != 33 || out_size != RX * D || ws_size < WS_NEED) { fprintf(stderr, "kernel_launch: unexpected problem (n_in %d, out %d, ws %zu, need %zu); nothing launched\n", n_in, out_size, ws_size, (size_t)WS_NEED); grid = -1; return; }
        int dev = 0, cus = 0, per_cu = 0;
        if (hipGetDevice(&dev) != hipSuccess || hipDeviceGetAttribute(&cus, hipDeviceAttributeMultiprocessorCount, dev) != hipSuccess) { grid = -1; return; }
        if (hipFuncSetAttribute((const void*)fwd_kernel, hipFuncAttributeMaxDynamicSharedMemorySize, LDS_BYTES) != hipSuccess) { fprintf(stderr, "kernel_launch: hipFuncSetAttribute failed\n"); grid = -1; return; }
        if (hipOccupancyMaxActiveBlocksPerMultiprocessor(&per_cu, (const void*)fwd_kernel, 512, LDS_BYTES) != hipSuccess || per_cu < 1) fprintf(stderr, "kernel_launch: occupancy query reports %d\n", per_cu);
        (void)hipGetLastError();
        grid = cus;
    }
    if (grid < 0) return;
    (void)hipMemsetAsync((char*)d_ws + WS_CTL, 0, CTL_BYTES, stream);
    Args a{};
    for (int i = 0; i < 33; ++i) a.in[i] = (const float*)d_in[i];
    a.out = (float*)d_out; a.ws = (unsigned char*)d_ws;
#if ONE_LAUNCH
    a.ph_lo = 0; a.ph_hi = NPHASE;
    hipLaunchKernelGGL(fwd_kernel, dim3(grid), dim3(512), LDS_BYTES, stream, a);
#else
    for (int p = 0; p < NPHASE; ++p) { a.ph_lo = p; a.ph_hi = p + 1; hipLaunchKernelGGL(fwd_kernel, dim3(grid), dim3(512), LDS_BYTES, stream, a); }
#endif
}
```

```cpp
#include <hip/hip_runtime.h>
#include <cstdio>
#include <cstdint>

#ifndef PROBE_MASK
#define PROBE_MASK 0u
#endif
#define REPS(k) (((PROBE_MASK >> (k)) & 1u) ? 2 : 1)
#ifndef ONE_LAUNCH
#define ONE_LAUNCH 1
#endif
#ifndef G8_PIPE
#define G8_PIPE 1
#endif
#ifndef PROBE_EPI
#define PROBE_EPI 0
#endif

#define GAS __attribute__((address_space(1)))
#define LAS __attribute__((address_space(3)))
typedef unsigned short bf16;
typedef short bf16x8 __attribute__((ext_vector_type(8)));
typedef float f32x4 __attribute__((ext_vector_type(4)));
typedef float f32x2 __attribute__((ext_vector_type(2)));
typedef unsigned u32x4 __attribute__((ext_vector_type(4)));
typedef unsigned u32x2 __attribute__((ext_vector_type(2)));
typedef int i32x4 __attribute__((ext_vector_type(4)));
typedef int i32x8 __attribute__((ext_vector_type(8)));

constexpr int D = 1024, BATCH = 16, SEQ = 2048, CTXL = 256;
constexpr int RX = BATCH * SEQ, RC = BATCH * CTXL, RT = RX + RC;
constexpr int INC = 2824, ZC = 2816, DFF = 2816, EFF = 3584, NE = 8;
constexpr int NCHX = RX / 128, NCHC = RC / 128, NCH = NCHX + NCHC;
constexpr int MOE_ROWS = 34816;
constexpr int MOE_TILES = MOE_ROWS / 256;
constexpr int ZO_X = 0, ZO_B = 256, ZO_C = 512, ZO_Z = 768, ZO_U = 1024, ZO_V = 1280, ZO_GB = 1536, ZO_GC = 1792, ZO_XIN = 2048, ZO_CA = 2304, ZO_CG = 2560;

constexpr size_t al256(size_t x) { return (x + 255) & ~(size_t)255; }
constexpr size_t WS_CTL = 0, CTL_BYTES = 1u << 20;
constexpr size_t WS_MODV = WS_CTL + CTL_BYTES;
constexpr size_t WS_DT = WS_MODV + al256((size_t)2 * 17 * 6144 * 4);
constexpr size_t WS_ACS = WS_DT + (size_t)RT * 8 * 4;
constexpr size_t WS_TOPE = WS_ACS + (size_t)RT * 8 * 4;
constexpr size_t WS_TOPP = WS_TOPE + (size_t)RX * 2 * 4;
constexpr size_t WS_ROWTOK = WS_TOPP + (size_t)RX * 2 * 4;
constexpr size_t WS_ROWP = WS_ROWTOK + (size_t)2 * MOE_ROWS * 4;
constexpr size_t WS_SLOT = WS_ROWP + (size_t)2 * MOE_ROWS * 4;
constexpr size_t WS_DUMP = WS_SLOT + (size_t)2 * RX * 4;
constexpr size_t WS_WIN = WS_DUMP + 4096;
constexpr size_t WS_WOUT = WS_WIN + (size_t)2 * ZC * D * 2;
constexpr size_t WS_WUP = WS_WOUT + (size_t)2 * D * D * 2;
constexpr size_t WS_WDN = WS_WUP + (size_t)2 * DFF * D * 2;
constexpr size_t WS_XC = WS_WDN + (size_t)D * DFF * 2;
constexpr size_t WS_H = WS_XC + (size_t)RC * D * 4;
constexpr size_t WS_Z = WS_H + (size_t)RT * D * 2;
constexpr size_t WS_XBC = WS_Z + (size_t)RT * ZC * 2;
constexpr size_t WS_ST = WS_XBC + (size_t)RT * 768 * 2;
constexpr size_t WS_STE = WS_ST + (size_t)NCH * 2 * 4 * 8192 * 4;
constexpr size_t WS_XT = WS_STE + (size_t)NCH * 2 * 4 * 8192 * 2;
constexpr size_t WS_WSB = WS_XT + (size_t)NCH * 256 * 128 * 2;
constexpr size_t WS_END_MIX = WS_WSB + (size_t)2 * 4 * 128 * 128 * 2;
constexpr int FFN_P = 4;
constexpr size_t WS_FSLAB = WS_ST;
static_assert((size_t)16 * 4 * FFN_P * 65536 * 4 <= (size_t)NCH * 2 * 4 * 8192 * 4, "ffn slabs fit the chunk-state buffer");
constexpr size_t WS_WMUP = WS_Z;
constexpr size_t WS_WMDN = WS_WMUP + (size_t)NE * 2 * EFF * D;
constexpr size_t WS_T = WS_WMDN + (size_t)NE * D * EFF;
constexpr int MOE_P = 7, MOE_TAIL_TILES = MOE_TILES - 128;
constexpr size_t MOE_SLAB_BYTES = (size_t)MOE_TAIL_TILES * 4 * MOE_P * 65536 * 2;
constexpr int MOE_YROWS = 128 * 256;
constexpr size_t WS_Y = WS_H;
static_assert(WS_H + (size_t)2 * MOE_YROWS * D * 2 <= WS_WMDN, "y rows end below the down weights");
constexpr size_t WS_MSLAB0 = WS_WIN;
constexpr size_t WS_MSLAB1 = WS_T + (size_t)2 * MOE_ROWS * EFF;
constexpr size_t WS_END_MOE = WS_MSLAB1 + MOE_SLAB_BYTES;
static_assert(WS_MSLAB0 + MOE_SLAB_BYTES <= WS_H, "pass-0 slabs fit below the activation buffer");
constexpr size_t WS_XS = al256(WS_END_MOE > WS_END_MIX ? WS_END_MOE : WS_END_MIX);
constexpr size_t WS_NEED = WS_XS + (size_t)RT * D * 2;
static_assert(WS_NEED < (size_t)612 * 1000 * 1000, "workspace budget");
constexpr int CW_BAR = 4096;
constexpr int CW_CNT = 8192;
constexpr int CW_RUN = 8192 + 64;
constexpr int CW_TMO = 0;

constexpr int RING_BYTES = 131072;
constexpr int LDS_BYTES = 147456;
constexpr int MISC_OFF = LDS_BYTES - 256;

#define RLX_AGENT __ATOMIC_RELAXED, __HIP_MEMORY_SCOPE_AGENT
__device__ __forceinline__ float bflo(unsigned w) { return __uint_as_float(w << 16); }
__device__ __forceinline__ float bfhi(unsigned w) { return __uint_as_float(w & 0xffff0000u); }
__device__ __forceinline__ unsigned cvt_pk_bf16(float lo, float hi) { unsigned r; asm volatile("v_cvt_pk_bf16_f32 %0, %1, %2" : "=v"(r) : "v"(lo), "v"(hi)); return r; }
__device__ __forceinline__ float fexp(float x) { return __builtin_amdgcn_exp2f(x * 1.4426950408889634f); }
__device__ __forceinline__ float silu_f(float x) { return x * __builtin_amdgcn_rcpf(1.0f + fexp(-x)); }
__device__ __forceinline__ float sigmoid_f(float x) { return __builtin_amdgcn_rcpf(1.0f + fexp(-x)); }
__device__ __forceinline__ float gelu_tanh_f(float x) { const float u = 0.7978845608028654f * (x + 0.044715f * x * x * x); return x * __builtin_amdgcn_rcpf(1.0f + fexp(-2.0f * u)); }
__device__ __forceinline__ unsigned pk4_fp8(float a, float b, float c, float d) { int w = __builtin_amdgcn_cvt_pk_fp8_f32(a, b, 0, false); w = __builtin_amdgcn_cvt_pk_fp8_f32(c, d, w, true); return (unsigned)w; }
__device__ __forceinline__ float softplus_f(float x) { return fmaxf(x, 0.0f) + log1pf(__expf(-fabsf(x))); }
__device__ __forceinline__ float wave_sum(float v) {
#pragma unroll
    for (int o = 1; o < 64; o <<= 1) v += __shfl_xor(v, o);
    return v;
}
__device__ __forceinline__ void unpack8(const u32x4 w, float (&f)[8]) { f[0] = bflo(w.x); f[1] = bfhi(w.x); f[2] = bflo(w.y); f[3] = bfhi(w.y); f[4] = bflo(w.z); f[5] = bfhi(w.z); f[6] = bflo(w.w); f[7] = bfhi(w.w); }
__device__ __forceinline__ u32x4 pack8(const float (&f)[8]) { u32x4 w; w.x = cvt_pk_bf16(f[0], f[1]); w.y = cvt_pk_bf16(f[2], f[3]); w.z = cvt_pk_bf16(f[4], f[5]); w.w = cvt_pk_bf16(f[6], f[7]); return w; }

#define XB_TMO      128
#define XB_XCNT(j)  (256  + 64 * (j))
#define XB_XSUB(j)  (1280 + 64 * (j))
#define XB_XGEN(j)  (2304 + 64 * (j))
#define XB_TOP      3328
#define XB_TOPGEN   3392
#define XCD_BAR_WORDS 3456
#define XB_SPIN_CAP (1u << 22)
__device__ __forceinline__ unsigned xb_ld(unsigned* p)              { return __hip_atomic_load(p, __ATOMIC_RELAXED, __HIP_MEMORY_SCOPE_AGENT); }
__device__ __forceinline__ unsigned xb_add(unsigned* p, unsigned v) { return __hip_atomic_fetch_add(p, v, __ATOMIC_RELAXED, __HIP_MEMORY_SCOPE_AGENT); }
__device__ __forceinline__ unsigned xb_xcc_id() { return (unsigned)__builtin_amdgcn_s_getreg((3 << 11) | 20) & 0xFu; }
#define XB_SPIN(cond, bar) do { unsigned _sp = 0; while (cond) { __builtin_amdgcn_s_sleep(1); \
    if ((++_sp & 255u) == 0u) { if (xb_ld(&(bar)[XB_TMO])) break; if (_sp > XB_SPIN_CAP) { atomicAdd(&(bar)[XB_TMO], 1u); break; } } } } while (0)
struct XcdBarrier { unsigned* bar; unsigned x; volatile LAS unsigned* st; };
__device__ __forceinline__ XcdBarrier xcd_barrier_post(unsigned* bar, volatile LAS unsigned* st, int tid) {
    XcdBarrier b; b.bar = bar; b.x = xb_xcc_id(); b.st = st;
    if (tid == 0) (void)xb_add(&bar[XB_XCNT(b.x)], 1u);
    return b;
}
__device__ __forceinline__ void xcd_barrier_complete(unsigned* bar, unsigned x, unsigned& nloc, unsigned& nx) {
    const unsigned G = gridDim.x * gridDim.y * gridDim.z;
    unsigned sum, cnt, mine, sp = 0u;
    for (;;) {
        sum = 0u; cnt = 0u; mine = 0u;
#pragma unroll
        for (unsigned j = 0; j < 16; ++j) { const unsigned c = xb_ld(&bar[XB_XCNT(j)]); sum += c; cnt += (c > 0u) ? 1u : 0u; mine = (j == x) ? c : mine; }
        if (sum == G) break;
        __builtin_amdgcn_s_sleep(1);
        if ((++sp & 255u) == 0u) { if (xb_ld(&bar[XB_TMO])) break; if (sp > XB_SPIN_CAP) { atomicAdd(&bar[XB_TMO], 1u); break; } }
    }
    nloc = mine > 0u ? mine : 1u; nx = cnt > 0u ? cnt : 1u;
}
__device__ __forceinline__ void xcd_barrier(const XcdBarrier& b, int tid) {
    asm volatile("s_waitcnt vmcnt(0)" ::: "memory");
    __syncthreads();
    if (tid == 0) {
        unsigned* bar = b.bar;
        __builtin_amdgcn_s_waitcnt(0);
        unsigned nloc = b.st[0], nx = b.st[1];
        if (nloc == 0u) { xcd_barrier_complete(bar, b.x, nloc, nx); b.st[0] = nloc; b.st[1] = nx; }
        const unsigned k = b.st[2] + 1u; b.st[2] = k;
        const unsigned old = xb_add(&bar[XB_XSUB(b.x)], 1u);
        if (old + 1u == k * nloc) {
            __builtin_amdgcn_fence(__ATOMIC_RELEASE, "agent");
            asm volatile("s_waitcnt vmcnt(0)" ::: "memory");
            xb_add(&bar[XB_TOP], 1u);
        }
        { unsigned sp = 0u; while (xb_add(&bar[XB_TOP], 0u) < k * nx) {
            __builtin_amdgcn_s_sleep(2); if ((++sp & 255u) == 0u) { if (xb_ld(&bar[XB_TMO])) break; if (sp > XB_SPIN_CAP) { atomicAdd(&bar[XB_TMO], 1u); break; } } } }
        __builtin_amdgcn_fence(__ATOMIC_ACQUIRE, "agent");
        asm volatile("s_waitcnt vmcnt(0)" ::: "memory");
    }
    __syncthreads();
}

namespace pg8 {
constexpr int BM = 256, BK = 64, HALF = 128, HTB = HALF * BK * 2, STAGE_BYTES = 8 * HTB, NXCD = 8, WGM = 8;
__host__ __device__ __forceinline__ int lds_byte(int r, int c) { const int st = (r >> 4) * 2 + (c >> 5), rr = r & 15, cc = c & 31, ob = rr * 64 + cc * 2; return st * 1024 + (ob ^ (((ob >> 9) & 1) << 5)); }
__host__ __device__ __forceinline__ void stage_rc(int b, int& R, int& C) { const int st = b / 1024, sb = b % 1024, swz = sb ^ (((sb >> 9) & 1) << 5); R = (st >> 1) * 16 + swz / 64; C = (st & 1) * 32 + (swz % 64) / 2; }
__host__ __device__ __forceinline__ int perm32(int rho) { const int n = rho >> 4, i = rho & 15; return 8 * (i >> 2) + 4 * n + (i & 3); }
__device__ __forceinline__ const char* uptr(const char* p) { const unsigned long long v = (unsigned long long)p; const unsigned lo = __builtin_amdgcn_readfirstlane((unsigned)v), hi = __builtin_amdgcn_readfirstlane((unsigned)(v >> 32)); return (const char*)(((unsigned long long)hi << 32) | lo); }
struct Unit { int pm, pn; const char* a; const char* b; int nt, split, part; };
__device__ __forceinline__ void tile_map(int L, int nM, int nN, int& pm, int& pn) {
    const int nwg = nM * nN; int wgid = L;
    { const int q = nwg / NXCD, r = nwg % NXCD, xcd = wgid % NXCD, off = wgid / NXCD; wgid = (xcd < r ? xcd * (q + 1) : r * (q + 1) + (xcd - r) * q) + off; }
    const int nig = WGM * nN, gid = wgid / nig, fm = gid * WGM, gsz = (nM - fm) < WGM ? (nM - fm) : WGM;
    pm = fm + ((wgid % nig) % gsz); pn = (wgid % nig) / gsz;
}
__device__ __forceinline__ bool tail_split(long L, int nu, int nwhole, int npairs, int P, int& tile, int& kt0, int& nt, int& split, int& part) {
    if (L < nwhole) { tile = (int)L; kt0 = 0; nt = 2 * npairs; split = 0; part = 0; return true; }
    const int Lt = (int)L - nwhole; if (Lt >= (nu - nwhole) * P) return false;
    part = Lt % P; const int base = npairs / P, rem = npairs % P, start = part * base + (part < rem ? part : rem), cnt = base + (part < rem ? 1 : 0);
    tile = nwhole + Lt / P; kt0 = 2 * start; nt = 2 * cnt; split = 1; return true;
}
struct RegSched {
    int nM0, nN0, n0, nM1, nN1, n1, pm1off, G, c, npairs, P; const char* A; const char* B; size_t tstep;
    __device__ __forceinline__ void init(const void* A_, const void* B_, int K, int nM0_, int nN0_, int nM1_, int nN1_, int pm1off_, int G_, int c_, int P_ = 1) {
        A = (const char*)A_; B = (const char*)B_; tstep = (size_t)256 * K * 2; nM0 = nM0_; nN0 = nN0_; n0 = nM0_ * nN0_; nM1 = nM1_; nN1 = nN1_; n1 = nM1_ * nN1_; pm1off = pm1off_; G = G_; c = c_; npairs = K / 128; P = P_; }
    __device__ __forceinline__ bool next(int i, Unit& u) const {
        const long L = (long)i * G + c; int tile, kt0;
        if (!tail_split(L, n0 + n1, P > 1 ? n0 : n0 + n1, npairs, P, tile, kt0, u.nt, u.split, u.part)) return false;
        int pm, pn;
        if (tile < n0) tile_map(tile, nM0, nN0, pm, pn); else { tile_map(tile - n0, nM1, nN1, pm, pn); pm += pm1off; }
        u.pm = pm; u.pn = pn; u.a = A + (size_t)pm * tstep + (size_t)kt0 * 128; u.b = B + (size_t)pn * tstep + (size_t)kt0 * 128; return true;
    }
    __device__ __forceinline__ void gather(const Unit&, int, unsigned (&)[2][2]) const {}
};
template <class Epi, class Sched, bool GATHER>
__device__ __forceinline__ void gemm_phase(LAS unsigned char* lds, const int K, const Sched& S, const Epi& E, int tid) {
    asm volatile("" : "+v"(tid));
    const int wid = __builtin_amdgcn_readfirstlane(tid >> 6), lane = tid & 63, wr = wid >> 2, wc = wid & 3, fr = lane & 15, fq = lane >> 4;
    unsigned voffA[2], voffB[2];
#pragma unroll
    for (int i = 0; i < 2; ++i) { int R, C; stage_rc(tid * 16 + i * 8192, R, C); const int Rb = Epi::PERM ? ((R & ~31) + perm32(R & 31)) : R;
        voffA[i] = (unsigned)(R * K + C) * 2u; voffB[i] = (unsigned)(Rb * K + C) * 2u; }
    const size_t kstep = (size_t)(BK * 2);
    const size_t hstep = (size_t)HALF * K * 2;
    const unsigned ldsw = (unsigned)wid * 1024u;
    const int aoff = lds_byte(wr * 64 + fr, fq * 8), boff = lds_byte(wc * 32 + fr, fq * 8);
#define PG8_SA(b, h) (((b) * 2 + (h)) * HTB)
#define PG8_SB(b, h) ((4 + (b) * 2 + (h)) * HTB)
#define PG8_STAGE(bufoff, gbase, voff) do { _Pragma("unroll") for (int _i = 0; _i < 2; ++_i) \
        __builtin_amdgcn_global_load_lds((const unsigned*)((const char*)(gbase) + (voff)[_i]), (LAS unsigned*)(lds + (bufoff) + ldsw + _i * 8192), 16, 0, 0); } while (0)
#define PG8_STAGE_A(bufoff, kptr, h, SEL) do { if constexpr (GATHER) { unsigned _vo[2]; _vo[0] = (SEL) ? nva[h][0] : cva[h][0]; _vo[1] = (SEL) ? nva[h][1] : cva[h][1]; PG8_STAGE(bufoff, kptr, _vo); } else { PG8_STAGE(bufoff, (kptr) + (h) * hstep, voffA); } } while (0)
#define PG8_LDA(dst, b, h) do { _Pragma("unroll") for (int m = 0; m < 4; ++m) _Pragma("unroll") for (int k = 0; k < 2; ++k) dst[m][k] = *(const LAS bf16x8*)(lds + PG8_SA(b, h) + aoff + m * 2048 + k * 1024); } while (0)
#define PG8_LDB(dst, b, h) do { _Pragma("unroll") for (int n = 0; n < 2; ++n) _Pragma("unroll") for (int k = 0; k < 2; ++k) dst[n][k] = *(const LAS bf16x8*)(lds + PG8_SB(b, h) + boff + n * 2048 + k * 1024); } while (0)
#define PG8_MMA(ai, bj, At, Bt) do { __builtin_amdgcn_s_setprio(1); _Pragma("unroll") for (int m = 0; m < 4; ++m) _Pragma("unroll") for (int n = 0; n < 2; ++n) _Pragma("unroll") for (int k = 0; k < 2; ++k) \
        acc[ai][bj][m][n] = __builtin_amdgcn_mfma_f32_16x16x32_bf16(Bt[n][k], At[m][k], acc[ai][bj][m][n], 0, 0, 0); __builtin_amdgcn_s_setprio(0); } while (0)
#define PG8_WAIT_V(n) asm volatile("s_waitcnt vmcnt(" #n ")" ::: "memory")
#define PG8_WAIT_L(n) asm volatile("s_waitcnt lgkmcnt(" #n ")" ::: "memory")
#define PG8_BAR __builtin_amdgcn_s_barrier()
#define PG8_SCHED __builtin_amdgcn_sched_barrier(0)
    Unit cur, nxt; int ui = 0;
    if (!S.next(0, cur)) return;
    f32x4 acc[2][2][4][2];
#pragma unroll
    for (int a = 0; a < 2; ++a)
#pragma unroll
        for (int b = 0; b < 2; ++b)
#pragma unroll
            for (int m = 0; m < 4; ++m)
#pragma unroll
                for (int n = 0; n < 2; ++n) acc[a][b][m][n] = (f32x4){0.f, 0.f, 0.f, 0.f};
    bf16x8 At[4][2], B0[2][2], B1[2][2];
    unsigned cva[2][2] = {{0u, 0u}, {0u, 0u}}, nva[2][2] = {{0u, 0u}, {0u, 0u}};
    if constexpr (GATHER) S.gather(cur, tid, cva);
    const char* cA = uptr(cur.a); const char* cB = uptr(cur.b);
    PG8_STAGE(PG8_SB(0, 0), cB, voffB); PG8_STAGE(PG8_SB(0, 1), cB + hstep, voffB); PG8_STAGE_A(PG8_SA(0, 0), cA, 0, false); PG8_STAGE_A(PG8_SA(0, 1), cA, 1, false);
    if (wr == 1) PG8_BAR;
    PG8_WAIT_V(2); PG8_BAR;
    PG8_STAGE(PG8_SB(1, 0), cB + kstep, voffB); PG8_STAGE_A(PG8_SA(1, 0), cA + kstep, 0, false); PG8_STAGE(PG8_SB(1, 1), cB + hstep + kstep, voffB);
    PG8_WAIT_V(6); PG8_BAR;
    for (;;) {
        const bool has_next = S.next(ui + 1, nxt);
        const char* nA = uptr(has_next ? nxt.a : cA); const char* nB = uptr(has_next ? nxt.b : cB);
        if constexpr (GATHER) { if (has_next) S.gather(nxt, tid, nva); else {
#pragma unroll
            for (int h = 0; h < 2; ++h)
#pragma unroll
                for (int i = 0; i < 2; ++i) nva[h][i] = cva[h][i]; } }
        const int nt = cur.nt;
        for (int t = 0; t < nt; t += 2) {
            const bool last = (t == nt - 2);
            asm volatile("" : "+v"(voffA[0]), "+v"(voffA[1]), "+v"(voffB[0]), "+v"(voffB[1]));
            const char* a1 = uptr(cA + (size_t)(t + 1) * kstep);
            const char* a2 = uptr(last ? nA : cA + (size_t)(t + 2) * kstep); const char* b2 = uptr(last ? nB : cB + (size_t)(t + 2) * kstep);
            const char* a3 = a2 + kstep; const char* b3 = b2 + kstep;
            PG8_LDB(B0, 0, 0); PG8_LDB(B1, 0, 1); PG8_SCHED; PG8_LDA(At, 0, 0); PG8_STAGE_A(PG8_SA(1, 1), a1, 1, false);
            PG8_WAIT_V(8); PG8_WAIT_L(0); PG8_BAR; PG8_MMA(0, 0, At, B0); PG8_MMA(0, 1, At, B1); PG8_BAR; PG8_SCHED;
            PG8_LDA(At, 0, 1); PG8_STAGE(PG8_SB(0, 0), b2, voffB); PG8_STAGE(PG8_SB(0, 1), b2 + hstep, voffB); PG8_STAGE_A(PG8_SA(0, 0), a2, 0, last);
            PG8_WAIT_V(8); PG8_WAIT_L(0); PG8_BAR; PG8_MMA(1, 0, At, B0); PG8_MMA(1, 1, At, B1); PG8_BAR; PG8_SCHED;
            PG8_LDB(B0, 1, 0); PG8_LDB(B1, 1, 1); PG8_SCHED; PG8_LDA(At, 1, 0); PG8_STAGE_A(PG8_SA(0, 1), a2, 1, last);
            PG8_WAIT_V(8); PG8_WAIT_L(0); PG8_BAR; PG8_MMA(0, 0, At, B0); PG8_MMA(0, 1, At, B1); PG8_BAR; PG8_SCHED;
            PG8_LDA(At, 1, 1); PG8_STAGE(PG8_SB(1, 0), b3, voffB); PG8_STAGE(PG8_SB(1, 1), b3 + hstep, voffB); PG8_STAGE_A(PG8_SA(1, 0), a3, 0, last);
            PG8_WAIT_V(8); PG8_WAIT_L(0); PG8_BAR; PG8_MMA(1, 0, At, B0); PG8_MMA(1, 1, At, B1); PG8_BAR; PG8_SCHED;
        }
        if (wr == 0) PG8_BAR;
        { Unit eu = cur; int efr = fr, efq = fq; asm volatile("" : "+s"(eu.pm), "+s"(eu.pn), "+s"(eu.split), "+s"(eu.part), "+v"(efr), "+v"(efq));
          E(acc, eu, wr, wc, efr, efq);
#if PROBE_EPI
          if constexpr (!Epi::RMW && ((PROBE_EPI >> Epi::PB) & 1)) { asm volatile("" ::: "memory");
#pragma unroll
            for (int a_ = 0; a_ < 2; ++a_)
#pragma unroll
              for (int b_ = 0; b_ < 2; ++b_)
#pragma unroll
                for (int m_ = 0; m_ < 4; ++m_)
#pragma unroll
                  for (int n_ = 0; n_ < 2; ++n_) asm volatile("" : "+v"(acc[a_][b_][m_][n_]));
            E(acc, eu, wr, wc, efr, efq); }
#endif
          }
        if (!has_next) break;
#pragma unroll
        for (int a = 0; a < 2; ++a)
#pragma unroll
            for (int b = 0; b < 2; ++b)
#pragma unroll
                for (int m = 0; m < 4; ++m)
#pragma unroll
                    for (int n = 0; n < 2; ++n) acc[a][b][m][n] = (f32x4){0.f, 0.f, 0.f, 0.f};
        cur = nxt; cA = nA; cB = nB; ++ui;
        if constexpr (GATHER) {
#pragma unroll
            for (int h = 0; h < 2; ++h)
#pragma unroll
                for (int i = 0; i < 2; ++i) cva[h][i] = nva[h][i]; }
        if (wr == 1) PG8_BAR;
    }
    PG8_WAIT_V(0);
    PG8_BAR;
#undef PG8_SA
#undef PG8_SB
#undef PG8_STAGE
#undef PG8_STAGE_A
#undef PG8_LDA
#undef PG8_LDB
#undef PG8_MMA
#undef PG8_WAIT_V
#undef PG8_WAIT_L
#undef PG8_BAR
#undef PG8_SCHED
}

struct EpiStoreBf16 {
    static constexpr bool PERM = true, RMW = false; static constexpr int PB = 3;
    bf16* O; int ldc;
    __device__ __forceinline__ void operator()(const f32x4 (&acc)[2][2][4][2], const Unit& u, int wr, int wc, int fr, int fq) const {
        const int row0 = u.pm * BM + wr * 64 + fr, col0 = u.pn * BM + wc * 32 + 8 * fq;
#pragma unroll
        for (int ai = 0; ai < 2; ++ai)
#pragma unroll
            for (int m = 0; m < 4; ++m) { bf16* rowp = O + (size_t)(row0 + ai * HALF + m * 16) * ldc + col0;
#pragma unroll
                for (int bj = 0; bj < 2; ++bj) { const f32x4 v0 = acc[ai][bj][m][0], v1 = acc[ai][bj][m][1];
                    u32x4 w; w.x = cvt_pk_bf16(v0[0], v0[1]); w.y = cvt_pk_bf16(v0[2], v0[3]); w.z = cvt_pk_bf16(v1[0], v1[1]); w.w = cvt_pk_bf16(v1[2], v1[3]);
                    *(u32x4*)(rowp + bj * HALF) = w; } }
    }
};
struct EpiSwiglu {
    static constexpr bool PERM = true, RMW = false; static constexpr int PB = 4;
    bf16* O; int ldc;
    __device__ __forceinline__ void operator()(const f32x4 (&acc)[2][2][4][2], const Unit& u, int wr, int wc, int fr, int fq) const {
        const int row0 = u.pm * BM + wr * 64 + fr, col0 = u.pn * HALF + wc * 32 + 8 * fq;
#pragma unroll
        for (int ai = 0; ai < 2; ++ai)
#pragma unroll
            for (int m = 0; m < 4; ++m) { bf16* rowp = O + (size_t)(row0 + ai * HALF + m * 16) * ldc + col0;
                float t[8];
#pragma unroll
                for (int n = 0; n < 2; ++n)
#pragma unroll
                    for (int j = 0; j < 4; ++j) t[4 * n + j] = silu_f(acc[ai][0][m][n][j]) * acc[ai][1][m][n][j];
                *(u32x4*)rowp = pack8(t); }
    }
};
template <bool IN32>
struct EpiResid {
    static constexpr bool PERM = true, RMW = true; static constexpr int PB = 5;
    const float* xin; const float* cin; bf16* xs; const float* gate;
    __device__ __forceinline__ void operator()(const f32x4 (&acc)[2][2][4][2], const Unit& u, int wr, int wc, int fr, int fq) const {
        const float* b32 = nullptr; const float* g;
        if (u.pm < RX / 256) { if (IN32) b32 = xin + (size_t)u.pm * 256 * D; g = gate + (size_t)(u.pm >> 3) * 6144; }
        else { if (IN32) b32 = cin + (size_t)(u.pm - RX / 256) * 256 * D; g = gate + (size_t)16 * 6144; }
        bf16* out = xs + (size_t)u.pm * 256 * D;
        const int col0 = u.pn * BM + wc * 32 + 8 * fq;
        f32x4 gv[2][2];
#pragma unroll
        for (int bj = 0; bj < 2; ++bj)
#pragma unroll
            for (int n = 0; n < 2; ++n) gv[bj][n] = *(const f32x4*)(g + col0 + bj * HALF + n * 4);
#pragma unroll
        for (int ab = 0; ab < 4; ++ab) { const int ai = ab >> 1, m0 = 2 * (ab & 1);
            f32x4 b4[IN32 ? 2 : 1][2][2]; u32x4 b2[IN32 ? 1 : 2][2];
#pragma unroll
            for (int mm = 0; mm < 2; ++mm)
#pragma unroll
                for (int bj = 0; bj < 2; ++bj) { const size_t off = (size_t)(wr * 64 + fr + ai * HALF + (m0 + mm) * 16) * D + col0 + bj * HALF;
                    if (IN32) { b4[IN32 ? mm : 0][bj][0] = *(const f32x4*)(b32 + off); b4[IN32 ? mm : 0][bj][1] = *(const f32x4*)(b32 + off + 4); } else b2[IN32 ? 0 : mm][bj] = *(const u32x4*)(out + off); }
            __builtin_amdgcn_sched_barrier(0);
#pragma unroll
            for (int mm = 0; mm < 2; ++mm)
#pragma unroll
                for (int bj = 0; bj < 2; ++bj) { const int m = m0 + mm; const size_t off = (size_t)(wr * 64 + fr + ai * HALF + m * 16) * D + col0 + bj * HALF; float t[8];
                    if (IN32) { const f32x4 v0 = b4[IN32 ? mm : 0][bj][0], v1 = b4[IN32 ? mm : 0][bj][1]; t[0] = v0[0]; t[1] = v0[1]; t[2] = v0[2]; t[3] = v0[3]; t[4] = v1[0]; t[5] = v1[1]; t[6] = v1[2]; t[7] = v1[3]; } else unpack8(b2[IN32 ? 0 : mm][bj], t);
#pragma unroll
                    for (int n = 0; n < 2; ++n)
#pragma unroll
                        for (int jj = 0; jj < 4; ++jj) t[4 * n + jj] += gv[bj][n][jj] * acc[ai][bj][m][n][jj];
                    *(u32x4*)(out + off) = pack8(t); }
            __builtin_amdgcn_sched_barrier(0); }
    }
};
}


namespace g8 {
constexpr int TA = 32768, TB = 32768, STG = TA + TB, NSTG = 2;
struct Unit { const char* a; const char* b; int row0, k, pn, nt, split, part; };
__device__ __forceinline__ const char* uptr(const char* p) { const unsigned long long v = (unsigned long long)p; const unsigned lo = __builtin_amdgcn_readfirstlane((unsigned)v), hi = __builtin_amdgcn_readfirstlane((unsigned)(v >> 32)); return (const char*)(((unsigned long long)hi << 32) | lo); }

struct Sched {
    int pre0[9], pre1[9]; int k0, npass, nN, G, c, nt, P; const char* Abase; size_t arow;   size_t apass; const char* Wbase; size_t wstride, tstepB;
    __device__ __forceinline__ bool next(int i, Unit& u) const {
        long L = (long)i * G + c; int k = k0;
        const int nm0 = (k0 == 0 ? pre0[8] : pre1[8]);
        if (P == 1 && L >= (long)nm0 * nN) { if (npass < 2) return false; L -= (long)nm0 * nN; k = 1; if (L >= (long)pre1[8] * nN) return false; }
        const int nm = (k == 0 ? pre0[8] : pre1[8]);
        int pm, pn, kt0 = 0; u.split = 0; u.part = 0; u.nt = nt;
        if (P > 1) {
            if (L < 128 * nN) pg8::tile_map((int)L, 128, nN, pm, pn);
            else { const int Lt = (int)L - 128 * nN; if (Lt >= (nm - 128) * nN * P) return false; const int tile = Lt / P; pm = 128 + tile / nN; pn = tile % nN; u.part = Lt % P; u.split = 1; u.nt = nt / P; kt0 = u.part * (nt / P); }
        } else pg8::tile_map((int)L, nm, nN, pm, pn);
        int e = 0;
#pragma unroll
        for (int j = 1; j < 8; ++j) e += (pm >= (k == 0 ? pre0[j] : pre1[j])) ? 1 : 0;
        u.row0 = pm * 256; u.k = k; u.pn = pn;
        u.a = Abase + (size_t)k * apass + (size_t)u.row0 * arow + (size_t)kt0 * 128; u.b = Wbase + (size_t)e * wstride + (size_t)pn * tstepB + (size_t)kt0 * 128; return true;
    }
};

struct SchedD {
    int nMw, nN, nMt, G, c, nt, P; const char* A; size_t tstepA; const char* W; size_t tstepB;
    __device__ __forceinline__ bool next(int i, Unit& u) const {
        const long L = (long)i * G + c; int pm, pn, kt0 = 0; u.split = 0; u.part = 0; u.nt = nt; u.k = 0;
        if (L < (long)nMw * nN) pg8::tile_map((int)L, nMw, nN, pm, pn);
        else { const int Lt = (int)(L - (long)nMw * nN); if (Lt >= nMt * nN * P) return false; const int tile = Lt / P, part = Lt % P, base = nt / P, rem = nt % P;
            pm = nMw + tile / nN; pn = tile % nN; u.part = part; u.split = 1; u.nt = base + (part < rem ? 1 : 0); kt0 = part * base + (part < rem ? part : rem); }
        u.row0 = pm * 256; u.pn = pn; u.a = A + (size_t)pm * tstepA + (size_t)kt0 * 128; u.b = W + (size_t)pn * tstepB + (size_t)kt0 * 128; return true;
    }
};

template <class Epi, class Sched, bool GATHER>
__device__ __forceinline__ void gemm8_phase(LAS unsigned char* lds, const int rowbytes, const Sched& S, const Epi& E, const int* rowtok  , int tid) {
    asm volatile("" : "+v"(tid));
    const int wave = __builtin_amdgcn_readfirstlane(tid >> 6), lane = tid & 63, wr = wave >> 2, wc = wave & 3, i16 = lane & 15, q = lane >> 4;
    const int srow = tid >> 3, cpos = tid & 7;
    const unsigned soff = 16u * (unsigned)(cpos ^ (srow & 7));
    const unsigned voffB = (unsigned)srow * (unsigned)rowbytes + soff;
    unsigned voffA[4] = {voffB, voffB + 64u * (unsigned)rowbytes, voffB + 128u * (unsigned)rowbytes, voffB + 192u * (unsigned)rowbytes};
    const unsigned ldsw = (unsigned)wave * 1024u;
    const int swz = i16 & 7;
    const unsigned c0 = 16u * (unsigned)(q ^ swz), c1 = 16u * (unsigned)((4 + q) ^ swz);
    const unsigned ard = (unsigned)((128 * wr + i16) * 128), brd = (unsigned)(TA + (64 * wc + i16) * 128);
    Unit cu, su, nu;
    if (!S.next(0, cu)) return;
    su = cu; int si = 0, skt = 0; bool s_valid = true; bool n_valid = S.next(1, nu);
    unsigned gnext[4] = {0u, 0u, 0u, 0u};
    int issued = 0, pos = 0;
#define G8_GATHER(U, DST) do { if constexpr (GATHER) { _Pragma("unroll") for (int _j = 0; _j < 4; ++_j) { int tk = rowtok[(U).k * MOE_ROWS + (U).row0 + srow + 64 * _j]; tk = tk < 0 ? 0 : tk; DST[_j] = (unsigned)tk * (unsigned)rowbytes + soff; } } } while (0)
#define G8_STAGE() do { const int _sb = issued & 1; const char* _a = uptr(su.a + (size_t)skt * 128); const char* _b = uptr(su.b + (size_t)skt * 128); \
        _Pragma("unroll") for (int _j = 0; _j < 4; ++_j) { if constexpr (GATHER) __builtin_amdgcn_global_load_lds((const unsigned*)(_a + voffA[_j]), (LAS unsigned*)(lds + _sb * STG + _j * 8192 + ldsw), 16, 0, 0); \
            else __builtin_amdgcn_global_load_lds((const unsigned*)(_a + voffB + (unsigned)(64 * _j) * (unsigned)rowbytes), (LAS unsigned*)(lds + _sb * STG + _j * 8192 + ldsw), 16, 0, 0); } \
        _Pragma("unroll") for (int _j = 0; _j < 4; ++_j) __builtin_amdgcn_global_load_lds((const unsigned*)(_b + voffB + (unsigned)(64 * _j) * (unsigned)rowbytes), (LAS unsigned*)(lds + _sb * STG + TA + _j * 8192 + ldsw), 16, 0, 0); \
        ++issued; if (++skt == su.nt) { skt = 0; ++si; su = nu; s_valid = n_valid; if constexpr (GATHER) { _Pragma("unroll") for (int _j = 0; _j < 4; ++_j) voffA[_j] = gnext[_j]; } \
            n_valid = s_valid && S.next(si + 1, nu); if (n_valid) G8_GATHER(nu, gnext); } } while (0)
    G8_GATHER(su, voffA);
    if (n_valid) G8_GATHER(nu, gnext);
    G8_STAGE();
    f32x4 acc[8][4];
    int ci = 0;
    for (;;) {
#pragma unroll
        for (int m = 0; m < 8; ++m)
#pragma unroll
            for (int n = 0; n < 4; ++n) acc[m][n] = (f32x4){0.f, 0.f, 0.f, 0.f};
#pragma unroll 1
        for (int kt = 0; kt < cu.nt; ++kt) {
            if (kt == 0 && ci > 0) asm volatile("s_waitcnt vmcnt(%0)" :: "n"(Epi::NST) : "memory");
            else asm volatile("s_waitcnt vmcnt(0)" ::: "memory");
            __builtin_amdgcn_s_barrier();
            asm volatile("" ::: "memory");
#if G8_PIPE
            if (wr == 0 && s_valid) G8_STAGE();
            __builtin_amdgcn_sched_barrier(0);
            const LAS unsigned char* sb = lds + (pos & 1) * STG;
            i32x8 bf[4], a0[2], a1[2];
#define G8_RDA(dst, m0) do { _Pragma("unroll") for (int _m = 0; _m < 2; ++_m) { dst[_m].lo = *(const LAS i32x4*)(sb + ard + ((m0) + _m) * 2048 + c0); dst[_m].hi = *(const LAS i32x4*)(sb + ard + ((m0) + _m) * 2048 + c1); } } while (0)
#define G8_MM(src, m0) do { _Pragma("unroll") for (int _m = 0; _m < 2; ++_m) _Pragma("unroll") for (int n = 0; n < 4; ++n) \
                acc[(m0) + _m][n] = __builtin_amdgcn_mfma_scale_f32_16x16x128_f8f6f4(bf[n], src[_m], acc[(m0) + _m][n], 0, 0, 0, 0x7f7f7f7f, 0, 0x7f7f7f7f); } while (0)
#pragma unroll
            for (int n = 0; n < 4; ++n) { bf[n].lo = *(const LAS i32x4*)(sb + brd + n * 2048 + c0); bf[n].hi = *(const LAS i32x4*)(sb + brd + n * 2048 + c1); }
            G8_RDA(a0, 0);
            __builtin_amdgcn_sched_barrier(0);
            G8_RDA(a1, 2);
            __builtin_amdgcn_sched_barrier(0);
            __builtin_amdgcn_s_setprio(1);
            G8_MM(a0, 0);
            __builtin_amdgcn_sched_barrier(0);
            G8_RDA(a0, 4);
            __builtin_amdgcn_sched_barrier(0);
            G8_MM(a1, 2);
            __builtin_amdgcn_sched_barrier(0);
#pragma unroll
            for (int m = 0; m < 4; ++m)
#pragma unroll
                for (int n = 0; n < 4; ++n) asm volatile("" : "+v"(acc[m][n]));
            G8_RDA(a1, 6);
            __builtin_amdgcn_sched_barrier(0);
            __builtin_amdgcn_s_setprio(0);
            if (wr == 1 && s_valid) G8_STAGE();
            __builtin_amdgcn_sched_barrier(0);
            __builtin_amdgcn_s_setprio(1);
            G8_MM(a0, 4);
            __builtin_amdgcn_sched_barrier(0);
            G8_MM(a1, 6);
            __builtin_amdgcn_s_setprio(0);
            __builtin_amdgcn_sched_barrier(0);
#undef G8_RDA
#undef G8_MM
#else
            if (s_valid) G8_STAGE();
            const LAS unsigned char* sb = lds + (pos & 1) * STG;
            i32x8 af[4], bf[4];
#pragma unroll
            for (int n = 0; n < 4; ++n) { bf[n].lo = *(const LAS i32x4*)(sb + brd + n * 2048 + c0); bf[n].hi = *(const LAS i32x4*)(sb + brd + n * 2048 + c1); }
#pragma unroll
            for (int mh = 0; mh < 2; ++mh) {
#pragma unroll
                for (int m = 0; m < 4; ++m) { af[m].lo = *(const LAS i32x4*)(sb + ard + (4 * mh + m) * 2048 + c0); af[m].hi = *(const LAS i32x4*)(sb + ard + (4 * mh + m) * 2048 + c1); }
                asm volatile("s_waitcnt lgkmcnt(0)" ::: "memory");
                __builtin_amdgcn_s_setprio(1);
#pragma unroll
                for (int m = 0; m < 4; ++m)
#pragma unroll
                    for (int n = 0; n < 4; ++n) acc[4 * mh + m][n] = __builtin_amdgcn_mfma_scale_f32_16x16x128_f8f6f4(bf[n], af[m], acc[4 * mh + m][n], 0, 0, 0, 0x7f7f7f7f, 0, 0x7f7f7f7f);
                __builtin_amdgcn_s_setprio(0);
                __builtin_amdgcn_sched_barrier(0);
            }
#endif
            ++pos;
        }
        { Unit eu = cu; eu.row0 = __builtin_amdgcn_readfirstlane(cu.row0); eu.k = __builtin_amdgcn_readfirstlane(cu.k); eu.pn = __builtin_amdgcn_readfirstlane(cu.pn); eu.split = __builtin_amdgcn_readfirstlane(cu.split); eu.part = __builtin_amdgcn_readfirstlane(cu.part); int ej = i16, eq = q; asm volatile("" : "+v"(ej), "+v"(eq)); E(acc, eu, wr, wc, ej, eq);
#if PROBE_EPI
          if (((PROBE_EPI >> Epi::PB) & 1) && !eu.split) { asm volatile("" ::: "memory");
#pragma unroll
            for (int m_ = 0; m_ < 8; ++m_)
#pragma unroll
              for (int n_ = 0; n_ < 4; ++n_) asm volatile("" : "+v"(acc[m_][n_]));
            Epi E2 = E; if constexpr (Epi::RMW) E2.s = 0.f; E2(acc, eu, wr, wc, ej, eq); }
#endif
          }
        ++ci; if (!S.next(ci, cu)) break;
    }
    asm volatile("s_waitcnt vmcnt(0)" ::: "memory");
    __builtin_amdgcn_s_barrier();
#undef G8_GATHER
#undef G8_STAGE
}

template <int LD>
struct EpiSwiglu8 {
    static constexpr bool RMW = false; static constexpr int NST = 8, PB = 0;
    unsigned char* T; float s;
    __device__ __forceinline__ void operator()(const f32x4 (&acc)[8][4], const Unit& u, int wr, int wc, int j, int q) const {
        unsigned char* base = T + ((size_t)u.k * MOE_ROWS + u.row0 + 128 * wr + j) * LD + u.pn * 128 + 32 * wc + 8 * q;
        const float kf = -s * 1.4426950408889634f, cf = 1.0f / (s * s);
        const f32x2 kk = {kf, kf}, cc = {cf, cf};
#pragma unroll
        for (int m = 0; m < 8; ++m) { f32x2 t[4];
#pragma unroll
            for (int n = 0; n < 2; ++n)
#pragma unroll
                for (int h = 0; h < 2; ++h) { const f32x2 a = {acc[m][n][2 * h], acc[m][n][2 * h + 1]}, b = {acc[m][n + 2][2 * h], acc[m][n + 2][2 * h + 1]};
                    const f32x2 ab = a * b, x = a * kk; f32x2 e; e[0] = __builtin_amdgcn_exp2f(x[0]); e[1] = __builtin_amdgcn_exp2f(x[1]);
                    const f32x2 d = e * cc + cc; f32x2 r; r[0] = __builtin_amdgcn_rcpf(d[0]); r[1] = __builtin_amdgcn_rcpf(d[1]);
                    t[2 * n + h] = ab * r; }
            u32x2 w; w.x = pk4_fp8(t[0][0], t[0][1], t[1][0], t[1][1]); w.y = pk4_fp8(t[2][0], t[2][1], t[3][0], t[3][1]); *(u32x2*)(base + (size_t)(16 * m) * LD) = w; }
    }
};
struct EpiMoeDown8 {
    static constexpr bool RMW = false; static constexpr int NST = 32, PB = 1;
    bf16* Y; float s; bf16* slab0; bf16* slab1;
    __device__ __forceinline__ void operator()(const f32x4 (&acc)[8][4], const Unit& u, int wr, int wc, int j, int q) const {
        bf16* dst; size_t rstride;
        if (u.split) { dst = (u.k == 0 ? slab0 : slab1) + ((size_t)((((u.row0 >> 8) - 128) * 4 + u.pn) * MOE_P + u.part) << 16) + (size_t)(128 * wr + j) * 256 + 64 * wc + 4 * q; rstride = 256; }
        else { dst = Y + ((size_t)u.k * MOE_YROWS + u.row0 + 128 * wr + j) * D + u.pn * 256 + 64 * wc + 4 * q; rstride = D; }
#pragma unroll
        for (int m = 0; m < 8; ++m)
#pragma unroll
            for (int n = 0; n < 4; ++n) { const f32x4 v = acc[m][n] * s; u32x2 w; w.x = cvt_pk_bf16(v[0], v[1]); w.y = cvt_pk_bf16(v[2], v[3]); *(u32x2*)(dst + (size_t)(16 * m) * rstride + 16 * n) = w; }
    }
};
struct EpiResid8 {
    static constexpr bool RMW = true; static constexpr int NST = 32, PB = 2;
    bf16* xs; const float* gate; float* slab; float s;
    __device__ __forceinline__ void operator()(const f32x4 (&acc)[8][4], const Unit& u, int wr, int wc, int j, int q) const {
        const int pm = u.row0 >> 8; const float* g = gate + (size_t)(pm < RX / 256 ? (pm >> 3) : 16) * 6144 + u.pn * 256 + 64 * wc + 4 * q;
        if (u.split) {
            float* sl = slab + ((size_t)(((pm - RX / 256) * 4 + u.pn) * FFN_P + u.part) << 16) + (size_t)(128 * wr + j) * 256 + 64 * wc + 4 * q;
#pragma unroll
            for (int m = 0; m < 8; ++m) {
#pragma unroll
                for (int n = 0; n < 4; ++n) *(f32x4*)(sl + (size_t)(16 * m) * 256 + 16 * n) = (*(const f32x4*)(g + 16 * n) * s) * acc[m][n];
                __builtin_amdgcn_sched_barrier(0); }
        } else {
            bf16* o = xs + (size_t)(u.row0 + 128 * wr + j) * D + u.pn * 256 + 64 * wc + 4 * q;
#pragma unroll
            for (int m = 0; m < 8; ++m) { u32x2 bs[4]; f32x4 gv[4];
#pragma unroll
                for (int n = 0; n < 4; ++n) { bs[n] = *(const u32x2*)(o + (size_t)(16 * m) * D + 16 * n); gv[n] = *(const f32x4*)(g + 16 * n); }
                __builtin_amdgcn_sched_barrier(0);
#pragma unroll
                for (int n = 0; n < 4; ++n) { const f32x4 v = (gv[n] * s) * acc[m][n]; const u32x2 b = bs[n];
                    u32x2 w; w.x = cvt_pk_bf16(bflo(b.x) + v[0], bfhi(b.x) + v[1]); w.y = cvt_pk_bf16(bflo(b.y) + v[2], bfhi(b.y) + v[3]);
                    *(u32x2*)(o + (size_t)(16 * m) * D + 16 * n) = w; }
                __builtin_amdgcn_sched_barrier(0); }
        }
    }
};
}

struct Args { const float* in[33]; float* out; unsigned char* ws; int ph_lo, ph_hi; };
enum { I_X = 0, I_C, I_CTX, I_CCTX, I_MODW, I_MODB, I_N1G, I_N2G, I_WIN, I_WOUT, I_SCW, I_SCB, I_DTB, I_ALOG, I_SSDD, I_SNG, I_GNG, I_GNB, I_GWS, I_GBS, I_SCCW, I_CFW, I_CFB, I_CFG, I_CFNB,
       I_F1, I_F3, I_F2, I_RT, I_M1, I_M3, I_M2, I_FNG };
typedef const __attribute__((address_space(4))) Args* ArgsP;
struct Frame { LAS unsigned char* lds; int tid, lane, wave, vcu, G; unsigned char* ws; };

__device__ __forceinline__ void conv_job(const Frame& F, const float* W, int ldw, int K, int c0, int ncols, bf16* WT, int rowbase, int blk, int blkstride) {
    LAS float* scr = (LAS float*)(F.lds + F.wave * 16384);
    const int gw = F.vcu * 8 + F.wave, NGW = F.G * 8, lane = F.lane;
    const int nblk = ncols / 32, nitems = (K / 64) * nblk;
    for (int it = gw; it < nitems; it += NGW) {
        const int kb = it / nblk, nb = it % nblk, k0 = 64 * kb, n0 = 32 * nb;
        const int drow0 = rowbase + (n0 / blk) * blkstride + (n0 % blk);
#pragma unroll 8
        for (int i = 0; i < 32; ++i) { const int kk = 2 * i + (lane >> 5); scr[kk * 33 + (lane & 31)] = W[(size_t)(k0 + kk) * ldw + c0 + n0 + (lane & 31)]; }
        asm volatile("s_waitcnt lgkmcnt(0)" ::: "memory");
        const int c = lane & 7;
#pragma unroll
        for (int j = 0; j < 4; ++j) { const int n = (lane >> 3) + 8 * j; const LAS float* s = scr + (8 * c) * 33 + n;
            u32x4 o; o.x = cvt_pk_bf16(s[0 * 33], s[1 * 33]); o.y = cvt_pk_bf16(s[2 * 33], s[3 * 33]); o.z = cvt_pk_bf16(s[4 * 33], s[5 * 33]); o.w = cvt_pk_bf16(s[6 * 33], s[7 * 33]);
            *(u32x4*)(WT + (size_t)(drow0 + n) * K + k0 + 8 * c) = o; }
        asm volatile("s_waitcnt lgkmcnt(0)" ::: "memory");
    }
}

__device__ __forceinline__ void conv_job8(const Frame& F, const float* W, int ldw, int K, int ncols, unsigned char* WT, int mode, int half, float scale) {
    LAS float* scr = (LAS float*)(F.lds + F.wave * 16384);
    const int gw = F.vcu * 8 + F.wave, NGW = F.G * 8, lane = F.lane;
    const int nblk = ncols / 32, nitems = (K / 64) * nblk;
    for (int it = gw; it < nitems; it += NGW) {
        const int kb = it / nblk, nb = it % nblk, k0 = 64 * kb, n0 = 32 * nb;
#pragma unroll 8
        for (int i = 0; i < 32; ++i) { const int kk = 2 * i + (lane >> 5); scr[kk * 33 + (lane & 31)] = W[(size_t)(k0 + kk) * ldw + n0 + (lane & 31)] * scale; }
        asm volatile("s_waitcnt lgkmcnt(0)" ::: "memory");
        const int c = lane & 3;
#pragma unroll
        for (int jj = 0; jj < 2; ++jj) { const int n = (lane >> 2) + 16 * jj; const LAS float* sp = scr + (16 * c) * 33 + n;
            const int drow = mode == 0 ? n0 + n : (n0 >> 7) * 256 + ((n0 & 127) >> 5) * 64 + half * 32 + (16 * ((n >> 2) & 1) + 4 * (n >> 3) + (n & 3));
            u32x4 o; o.x = pk4_fp8(sp[0 * 33], sp[1 * 33], sp[2 * 33], sp[3 * 33]); o.y = pk4_fp8(sp[4 * 33], sp[5 * 33], sp[6 * 33], sp[7 * 33]);
            o.z = pk4_fp8(sp[8 * 33], sp[9 * 33], sp[10 * 33], sp[11 * 33]); o.w = pk4_fp8(sp[12 * 33], sp[13 * 33], sp[14 * 33], sp[15 * 33]);
            *(u32x4*)(WT + (size_t)drow * K + k0 + 16 * c) = o; }
        asm volatile("s_waitcnt lgkmcnt(0)" ::: "memory");
    }
}

__device__ __forceinline__ void p0_prologue(const Frame& F, ArgsP a) {
    unsigned char* ws = F.ws;
    if (F.vcu < 192) {
        LAS float* sc = (LAS float*)F.lds;
        LAS float* red = sc + 17 * 1024;
        for (int i = F.tid; i < 17 * 1024; i += 512) { const int b = i >> 10, k = i & 1023; const float v = b < 16 ? a->in[I_C][b * 1024 + k] : a->in[I_CCTX][k]; sc[i] = silu_f(v); }
        __syncthreads();
        float* modv = (float*)(ws + WS_MODV);
        for (int item = F.vcu; item < 192; item += F.G) {
            const int l = item / 96, cb = item % 96, col = cb * 64 + F.lane;
            const float* W = a->in[I_MODW] + (size_t)l * 1024 * 6144 + col;
            float acc[17];
#pragma unroll
            for (int b = 0; b < 17; ++b) acc[b] = 0.f;
            for (int k = F.wave * 128; k < F.wave * 128 + 128; ++k) { const float w = W[(size_t)k * 6144];
#pragma unroll
                for (int b = 0; b < 17; ++b) acc[b] += sc[b * 1024 + k] * w; }
#pragma unroll
            for (int b = 0; b < 17; ++b) red[(F.wave * 17 + b) * 64 + F.lane] = acc[b];
            __syncthreads();
            for (int o = F.tid; o < 17 * 64; o += 512) { const int b = o >> 6, ln = o & 63; float s = a->in[I_MODB][l * 6144 + cb * 64 + ln];
#pragma unroll
                for (int w = 0; w < 8; ++w) s += red[(w * 17 + b) * 64 + ln];
                modv[(size_t)(l * 17 + b) * 6144 + cb * 64 + ln] = s; }
            __syncthreads();
        }
    }
    __syncthreads();
    for (int l = 0; l < 2; ++l) {
        const float* win = a->in[I_WIN] + (size_t)l * D * INC; bf16* wt = (bf16*)(ws + WS_WIN) + (size_t)l * ZC * D;
        conv_job(F, win, INC, D, 0, 768, wt, 0, 1 << 30, 0);
        conv_job(F, win, INC, D, 776, 2048, wt, 768, 1 << 30, 0);
        conv_job(F, a->in[I_WOUT] + (size_t)l * D * D, D, D, 0, D, (bf16*)(ws + WS_WOUT) + (size_t)l * D * D, 0, 1 << 30, 0);
    }
    conv_job8(F, a->in[I_F1], DFF, D, DFF, ws + WS_WUP, 1, 0, 64.0f);
    conv_job8(F, a->in[I_F3], DFF, D, DFF, ws + WS_WUP, 1, 1, 64.0f);
    conv_job8(F, a->in[I_F2], D, DFF, D, ws + WS_WDN, 0, 0, 64.0f);
    int* rowtok = (int*)(ws + WS_ROWTOK);
    for (int i = F.vcu * 512 + F.tid; i < 2 * MOE_ROWS; i += F.G * 512) rowtok[i] = -1;
    for (int i = F.vcu * 512 + F.tid; i < 2 * 4 * 128 * 128 / 2; i += F.G * 512) { const f32x2 v = *(const f32x2*)(a->in[I_GWS] + 2 * i); ((unsigned*)(ws + WS_WSB))[i] = cvt_pk_bf16(v[0], v[1]); }
}
__device__ __forceinline__ void moe_convert(const Frame& F, ArgsP a) {
    for (int e = 0; e < NE; ++e) {
        unsigned char* up = F.ws + WS_WMUP + (size_t)e * 2 * EFF * D;
        conv_job8(F, a->in[I_M1] + (size_t)e * D * EFF, EFF, D, EFF, up, 1, 0, 64.0f);
        conv_job8(F, a->in[I_M3] + (size_t)e * D * EFF, EFF, D, EFF, up, 1, 1, 64.0f);
        conv_job8(F, a->in[I_M2] + (size_t)e * EFF * D, D, EFF, D, F.ws + WS_WMDN + (size_t)e * D * EFF, 0, 0, 64.0f);
    }
}

template <int MODE, bool SRC16>
__device__ __forceinline__ void norm_phase(const Frame& F, ArgsP a, int l, int nrows, const float* xsrc, const float* csrc, const float* gain, int slot_shift, int slot_scale, const float* fslab = nullptr) {
    unsigned char* ws = F.ws;
    LAS float* wx = (LAS float*)F.lds;
    LAS int* hist = (LAS int*)(F.lds + 8 * 1024 * 4);
    if (MODE == 0 || MODE == 2) {
        for (int i = F.tid; i < 8192; i += 512) { const int k = i >> 3, j = i & 7; wx[j * 1024 + k] = (MODE == 0) ? a->in[I_WIN][(size_t)l * D * INC + (size_t)k * INC + 768 + j] : a->in[I_RT][k * 8 + j]; }
        if (F.tid < 16) hist[F.tid] = 0;
        __syncthreads();
    }
    const float* modv = (const float*)(ws + WS_MODV) + (size_t)l * 17 * 6144;
    bf16* H = (bf16*)(ws + WS_H);
    const int gw = F.vcu * 8 + F.wave, NGW = F.G * 8, lane = F.lane;
    f32x4 gv[4];
#pragma unroll
    for (int j = 0; j < 4; ++j) gv[j] = *(const f32x4*)(gain + 4 * lane + 256 * j);
    for (int r = gw; r < nrows; r += NGW) {
        const float* xr; int mb;
        if (r < RX) { xr = xsrc + (size_t)r * D; mb = r >> 11; } else { xr = csrc + (size_t)(r - RX) * D; mb = 16; }
        const bf16* xr16 = (const bf16*)xsrc + (size_t)r * D;
        const float* mv = modv + (size_t)mb * 6144;
        f32x4 v[4]; float ss = 0.f;
#pragma unroll
        for (int j = 0; j < 4; ++j) { if (SRC16) { const u32x2 w = *(const u32x2*)(xr16 + 4 * lane + 256 * j); v[j] = (f32x4){bflo(w.x), bfhi(w.x), bflo(w.y), bfhi(w.y)}; } else v[j] = *(const f32x4*)(xr + 4 * lane + 256 * j);
            if (fslab != nullptr && r >= RX) {
#pragma unroll
                for (int part = 0; part < FFN_P; ++part) v[j] += *(const f32x4*)(fslab + ((size_t)((((r - RX) >> 8) * 4 + j) * FFN_P + part) << 16) + (size_t)((r - RX) & 255) * 256 + 4 * lane); }
            ss += (v[j][0] * v[j][0] + v[j][1] * v[j][1]) + (v[j][2] * v[j][2] + v[j][3] * v[j][3]); }
        const float rstd = 1.0f / sqrtf(wave_sum(ss) * (1.0f / D) + 1e-6f);
        float e[8];
#pragma unroll
        for (int q = 0; q < 8; ++q) e[q] = 0.f;
#pragma unroll
        for (int j = 0; j < 4; ++j) {
            const f32x4 sh = *(const f32x4*)(mv + slot_shift * 1024 + 4 * lane + 256 * j), sc = *(const f32x4*)(mv + slot_scale * 1024 + 4 * lane + 256 * j);
            const f32x4 hv = (v[j] * rstd) * gv[j] * (sc + 1.0f) + sh;
            if (MODE >= 2) *(unsigned*)((unsigned char*)H + (size_t)r * D + 4 * lane + 256 * j) = pk4_fp8(hv[0], hv[1], hv[2], hv[3]);
            else { u32x2 w; w.x = cvt_pk_bf16(hv[0], hv[1]); w.y = cvt_pk_bf16(hv[2], hv[3]); *(u32x2*)(H + (size_t)r * D + 4 * lane + 256 * j) = w; }
            if (MODE == 0 || MODE == 2) {
#pragma unroll
                for (int q = 0; q < 8; ++q) { const f32x4 wv = *(const LAS f32x4*)(wx + q * 1024 + 4 * lane + 256 * j); e[q] += (hv[0] * wv[0] + hv[1] * wv[1]) + (hv[2] * wv[2] + hv[3] * wv[3]); }
            }
        }
        if (MODE == 0) {
#pragma unroll
            for (int q = 0; q < 8; ++q) e[q] = wave_sum(e[q]);
            float mine = 0.f;
#pragma unroll
            for (int q = 0; q < 8; ++q) mine = (lane == q) ? e[q] : mine;
            if (lane < 8) ((float*)(ws + WS_DT))[(size_t)r * 8 + lane] = softplus_f(mine + a->in[I_DTB][l * 8 + lane]);
        }
        if (MODE == 2) {
#pragma unroll
            for (int q = 0; q < 8; ++q) e[q] = wave_sum(e[q]);
            int i0 = 0; float v0 = e[0];
#pragma unroll
            for (int q = 1; q < 8; ++q) if (e[q] > v0) { v0 = e[q]; i0 = q; }
            int i1 = -1; float v1 = -3.0e38f;
#pragma unroll
            for (int q = 0; q < 8; ++q) if (q != i0 && e[q] > v1) { v1 = e[q]; i1 = q; }
            const float p0 = 1.0f / (1.0f + __expf(v1 - v0)), p1 = 1.0f - p0;
            if (lane == 0) { int* te = (int*)(ws + WS_TOPE) + (size_t)r * 2; te[0] = i0; te[1] = i1; float* tp = (float*)(ws + WS_TOPP) + (size_t)r * 2; tp[0] = p0; tp[1] = p1;
                __hip_atomic_fetch_add(&hist[i0], 1, __ATOMIC_RELAXED, __HIP_MEMORY_SCOPE_WORKGROUP); __hip_atomic_fetch_add(&hist[8 + i1], 1, __ATOMIC_RELAXED, __HIP_MEMORY_SCOPE_WORKGROUP); }
        }
    }
    if (MODE == 2) {
        __syncthreads();
        if (F.tid < 16 && hist[F.tid] != 0) atomicAdd((unsigned*)(ws + WS_CTL) + CW_CNT + F.tid, (unsigned)hist[F.tid]);
    }
    __syncthreads();
}

__device__ __forceinline__ void chunk_geom(int c, int& r0, int& seq_lo, int& seq_hi) {
    r0 = c * 128;
    if (c < NCHX) { seq_lo = (c >> 4) * SEQ; seq_hi = seq_lo + SEQ; } else { seq_lo = RX + ((c - NCHX) >> 1) * CTXL; seq_hi = seq_lo + CTXL; }
}

template <int PART>
__device__ __forceinline__ void a1_item(const Frame& F, ArgsP a, int l, int c) {
    unsigned char* ws = F.ws;
    const bf16* Z = (const bf16*)(ws + WS_Z); bf16* XBC = (bf16*)(ws + WS_XBC); bf16* XT = (bf16*)(ws + WS_XT);
    const float* DT = (const float*)(ws + WS_DT); float* ACS = (float*)(ws + WS_ACS); float* ST = (float*)(ws + WS_ST);
    const float* scw = a->in[I_SCW] + (size_t)l * 5 * 768; const float* scb = a->in[I_SCB] + (size_t)l * 768;
    LAS bf16* RAW = (LAS bf16*)F.lds;
    LAS bf16* BT = (LAS bf16*)(F.lds + 33792);
    LAS bf16* XF = (LAS bf16*)(F.lds + 68608);
    LAS bf16* XB = (LAS bf16*)(F.lds + 103424);
    LAS float* wts = (LAS float*)(F.lds + 138240);
    int lane = F.lane; asm volatile("" : "+v"(lane)); const int wave = F.wave, tid = wave * 64 + lane, lj = lane & 15, lq = lane >> 4;
    int r0, slo, shi; chunk_geom(c, r0, slo, shi);
    __syncthreads();
    if (PART < 2 && wave < 4) {
        const int h = 2 * PART + (wave >> 1), dir = wave & 1; const float av = -__expf(a->in[I_ALOG][l * 8 + dir * 4 + h]);
        const int la = dir == 0 ? 2 * lane : 127 - 2 * lane, lb = dir == 0 ? 2 * lane + 1 : 126 - 2 * lane;
        const float da = DT[(size_t)(r0 + la) * 8 + dir * 4 + h], db = DT[(size_t)(r0 + lb) * 8 + dir * 4 + h];
        const float s0 = av * da, s1 = s0 + av * db;
        float inc = s1;
#pragma unroll
        for (int o = 1; o < 64; o <<= 1) { const float t = __shfl_up(inc, o); if (lane >= o) inc += t; }
        const float pre = inc - s1, ca = pre + s0, cb = pre + s1, tot = __shfl(inc, 63);
        ACS[(size_t)(r0 + la) * 8 + dir * 4 + h] = ca; ACS[(size_t)(r0 + lb) * 8 + dir * 4 + h] = cb;
        wts[(h * 2 + dir) * 128 + la] = __expf(tot - ca) * da; wts[(h * 2 + dir) * 128 + lb] = __expf(tot - cb) * db;
    }
    if (PART < 2) { const int g = PART;
#pragma unroll
        for (int pass = 0; pass < 2; ++pass) {
            const int xc0 = pass == 0 ? 256 + g * 128 : g * 128;
            __syncthreads();
            { u32x4 rv[5];
#pragma unroll
                for (int i = 0; i < 5; ++i) { const int t = tid + 512 * i, row = t >> 4, seg = t & 15, rr = r0 - 2 + row; const int rc = rr < slo ? slo : (rr >= shi ? shi - 1 : rr);
                    rv[i] = *(const u32x4*)(Z + (size_t)rc * ZC + xc0 + seg * 8); }
#pragma unroll
                for (int i = 0; i < 5; ++i) { const int t = tid + 512 * i, row = t >> 4, seg = t & 15, rr = r0 - 2 + row; const bool ok = rr >= slo && rr < shi;
                    if (t < 132 * 16) *(LAS u32x4*)(RAW + row * 128 + seg * 8) = ok ? rv[i] : (u32x4){0u, 0u, 0u, 0u}; } }
            __syncthreads();
            const int ch = tid & 127;
            float w[5];
#pragma unroll
            for (int k = 0; k < 5; ++k) w[k] = scw[k * 768 + xc0 + ch];
            const float bias = scb[xc0 + ch];
#pragma unroll 2
            for (int i = 0; i < 4; ++i) { const int lb = (tid >> 7) + 4 * i;
                const LAS bf16* rp = RAW + (8 * lb) * 128 + ch;
                float in[12];
#pragma unroll
                for (int t = 0; t < 12; ++t) in[t] = __uint_as_float((unsigned)rp[t * 128] << 16);
                float o[8];
#pragma unroll
                for (int jj = 0; jj < 8; ++jj) { float sacc = bias;
#pragma unroll
                    for (int k = 0; k < 5; ++k) sacc += w[k] * in[jj + k];
                    o[jj] = silu_f(sacc); }
                if (pass == 0) {
                    *(LAS u32x4*)(BT + ch * 136 + 8 * lb) = pack8(o);
#pragma unroll
                    for (int jj = 0; jj < 8; ++jj) XBC[(size_t)(r0 + 8 * lb + jj) * 768 + xc0 + ch] = (bf16)(cvt_pk_bf16(o[jj], 0.f) & 0xffffu);
                } else {
                    *(u32x4*)(XT + ((size_t)c * 256 + xc0 + ch) * 128 + 8 * lb) = pack8(o);
                    const int h = 2 * g + (ch >> 6);
                    const f32x4 f0 = *(const LAS f32x4*)(wts + (h * 2) * 128 + 8 * lb), f1 = *(const LAS f32x4*)(wts + (h * 2) * 128 + 8 * lb + 4);
                    const f32x4 b0 = *(const LAS f32x4*)(wts + (h * 2 + 1) * 128 + 8 * lb), b1 = *(const LAS f32x4*)(wts + (h * 2 + 1) * 128 + 8 * lb + 4);
                    float of[8], ob[8];
#pragma unroll
                    for (int jj = 0; jj < 4; ++jj) { of[jj] = o[jj] * f0[jj]; of[4 + jj] = o[4 + jj] * f1[jj]; ob[jj] = o[jj] * b0[jj]; ob[4 + jj] = o[4 + jj] * b1[jj]; }
                    *(LAS u32x4*)(XF + ch * 136 + 8 * lb) = pack8(of); *(LAS u32x4*)(XB + ch * 136 + 8 * lb) = pack8(ob);
                }
            }
        }
        __syncthreads();
        {
            const int hl = wave >> 2, dir = (wave >> 1) & 1, nh = wave & 1, h = 2 * g + hl;
            const LAS bf16* Ub = BT + (64 * nh + lj) * 136 + 8 * lq;
            const LAS bf16* Vb = (dir ? XB : XF) + (64 * hl + lj) * 136 + 8 * lq;
            f32x4 acc[4][4];
#pragma unroll
            for (int nt = 0; nt < 4; ++nt)
#pragma unroll
                for (int pt = 0; pt < 4; ++pt) acc[nt][pt] = (f32x4){0.f, 0.f, 0.f, 0.f};
#pragma unroll
            for (int k = 0; k < 4; ++k) { bf16x8 uf[4], vf[4];
#pragma unroll
                for (int t = 0; t < 4; ++t) { uf[t] = *(const LAS bf16x8*)(Ub + t * 16 * 136 + 32 * k); vf[t] = *(const LAS bf16x8*)(Vb + t * 16 * 136 + 32 * k); }
#pragma unroll
                for (int nt = 0; nt < 4; ++nt)
#pragma unroll
                    for (int pt = 0; pt < 4; ++pt) acc[nt][pt] = __builtin_amdgcn_mfma_f32_16x16x32_bf16(uf[nt], vf[pt], acc[nt][pt], 0, 0, 0); }
            float* sp = ST + ((size_t)(c * 2 + dir) * 4 + h) * 8192;
#pragma unroll
            for (int nt = 0; nt < 4; ++nt)
#pragma unroll
                for (int pt = 0; pt < 4; ++pt) *(f32x4*)(sp + (16 * pt + lj) * 128 + 64 * nh + 16 * nt + 4 * lq) = acc[nt][pt];
        }
    }
    if (PART == 2) { LAS bf16* RAW2 = (LAS bf16*)(F.lds + 33792);
        { u32x4 rv[9];
#pragma unroll
            for (int i = 0; i < 9; ++i) { const int t = tid + 512 * i, row = t >> 5, seg = t & 31, rr = r0 - 2 + row; const int rc = rr < slo ? slo : (rr >= shi ? shi - 1 : rr);
                rv[i] = *(const u32x4*)(Z + (size_t)rc * ZC + ZO_C + seg * 8); }
#pragma unroll
            for (int i = 0; i < 9; ++i) { const int t = tid + 512 * i, row = t >> 5, seg = t & 31, rr = r0 - 2 + row; const bool ok = rr >= slo && rr < shi;
                if (t < 132 * 32) *(LAS u32x4*)(RAW2 + row * 256 + seg * 8) = ok ? rv[i] : (u32x4){0u, 0u, 0u, 0u}; } }
        __syncthreads();
        const int cg = tid & 31, ch = 512 + cg * 8;
        f32x4 cw0[5], cw1[5];
#pragma unroll
        for (int k = 0; k < 5; ++k) { cw0[k] = *(const f32x4*)(scw + k * 768 + ch); cw1[k] = *(const f32x4*)(scw + k * 768 + ch + 4); }
        const f32x4 cb0 = *(const f32x4*)(scb + ch), cb1 = *(const f32x4*)(scb + ch + 4);
#pragma unroll 2
        for (int i = 0; i < 8; ++i) { const int lr = (tid >> 5) + 16 * i;
            float acc[8];
            acc[0] = cb0[0]; acc[1] = cb0[1]; acc[2] = cb0[2]; acc[3] = cb0[3]; acc[4] = cb1[0]; acc[5] = cb1[1]; acc[6] = cb1[2]; acc[7] = cb1[3];
#pragma unroll
            for (int k = 0; k < 5; ++k) { float zv[8]; unpack8(*(const LAS u32x4*)(RAW2 + (lr + k) * 256 + cg * 8), zv);
                const f32x4 w0 = cw0[k], w1 = cw1[k];
                acc[0] += w0[0] * zv[0]; acc[1] += w0[1] * zv[1]; acc[2] += w0[2] * zv[2]; acc[3] += w0[3] * zv[3]; acc[4] += w1[0] * zv[4]; acc[5] += w1[1] * zv[5]; acc[6] += w1[2] * zv[6]; acc[7] += w1[3] * zv[7]; }
#pragma unroll
            for (int jj = 0; jj < 8; ++jj) acc[jj] = silu_f(acc[jj]);
            *(u32x4*)(XBC + (size_t)(r0 + lr) * 768 + ch) = pack8(acc); }
    }
}

__device__ __forceinline__ void a2_item(const Frame& F, ArgsP a, int l, int c) {
    unsigned char* ws = F.ws;
    const bf16* Z = (const bf16*)(ws + WS_Z); bf16* MIX = (bf16*)(ws + WS_H); const bf16* WSB = (const bf16*)(ws + WS_WSB);
    LAS bf16* VT = (LAS bf16*)F.lds;
    int lane = F.lane; asm volatile("" : "+v"(lane)); const int wave = F.wave, lj = lane & 15, lq = lane >> 4, r0 = c * 128;
    __syncthreads();
    {
        float gg[4], bbv[4];
#pragma unroll
        for (int e = 0; e < 4; ++e) { gg[e] = a->in[I_GNG][l * 256 + lane + 64 * e]; bbv[e] = a->in[I_GNB][l * 256 + lane + 64 * e]; }
#pragma unroll
        for (int hb = 0; hb < 2; ++hb) {
            bf16 raw[8][4];
#pragma unroll
            for (int i = 0; i < 8; ++i)
#pragma unroll
                for (int e = 0; e < 4; ++e) raw[i][e] = Z[(size_t)(r0 + 16 * wave + 8 * hb + i) * ZC + ZO_V + lane + 64 * e];
            float o[4][8];
#pragma unroll
            for (int i = 0; i < 8; ++i) { float v[4];
#pragma unroll
                for (int e = 0; e < 4; ++e) v[e] = gelu_tanh_f(__uint_as_float((unsigned)raw[i][e] << 16));
                const float mu = wave_sum((v[0] + v[1]) + (v[2] + v[3])) * (1.0f / 256.0f);
#pragma unroll
                for (int e = 0; e < 4; ++e) v[e] -= mu;
                const float rs = 1.0f / sqrtf(wave_sum((v[0] * v[0] + v[1] * v[1]) + (v[2] * v[2] + v[3] * v[3])) * (1.0f / 256.0f) + 1e-5f);
#pragma unroll
                for (int e = 0; e < 4; ++e) o[e][i] = v[e] * rs * gg[e] + bbv[e]; }
#pragma unroll
            for (int e = 0; e < 4; ++e) *(LAS u32x4*)(VT + (lane + 64 * e) * 136 + 16 * wave + 8 * hb) = pack8(o[e]);
        }
    }
    __syncthreads();
    const int g = wave >> 1, th = wave & 1;
    const LAS bf16* Ub = VT + (g * 64 + lj) * 136 + 8 * lq;
    const bf16* Vg = WSB + ((size_t)(l * 4 + g) * 128 + 64 * th + lj) * 128 + 8 * lq;
    f32x4 acc[4][4];
#pragma unroll
    for (int dt = 0; dt < 4; ++dt)
#pragma unroll
        for (int tt = 0; tt < 4; ++tt) acc[dt][tt] = (f32x4){0.f, 0.f, 0.f, 0.f};
    __builtin_amdgcn_sched_barrier(0);
    bf16x8 vfa[4][4];
#pragma unroll
    for (int k = 0; k < 4; ++k)
#pragma unroll
        for (int t = 0; t < 4; ++t) vfa[k][t] = *(const bf16x8*)(Vg + t * 16 * 128 + 32 * k);
#pragma unroll
    for (int k = 0; k < 4; ++k) { bf16x8 uf[4];
#pragma unroll
        for (int t = 0; t < 4; ++t) uf[t] = *(const LAS bf16x8*)(Ub + t * 16 * 136 + 32 * k);
#pragma unroll
        for (int dt = 0; dt < 4; ++dt)
#pragma unroll
            for (int tt = 0; tt < 4; ++tt) acc[dt][tt] = __builtin_amdgcn_mfma_f32_16x16x32_bf16(uf[dt], vfa[k][tt], acc[dt][tt], 0, 0, 0); }
    __builtin_amdgcn_sched_barrier(0);
    u32x2 uwa[4][4];
#pragma unroll
    for (int tt = 0; tt < 4; ++tt)
#pragma unroll
        for (int dt = 0; dt < 4; ++dt) uwa[tt][dt] = *(const u32x2*)(Z + (size_t)(r0 + 64 * th + 16 * tt + lj) * ZC + ZO_U + g * 64 + 16 * dt + 4 * lq);
#pragma unroll
    for (int tt = 0; tt < 4; ++tt) { const int t = 64 * th + 16 * tt + lj, r = r0 + t; const float bs = a->in[I_GBS][((size_t)l * 4 + g) * 128 + t];
#pragma unroll
        for (int dt = 0; dt < 4; ++dt) { const int ch0 = g * 64 + 16 * dt + 4 * lq; const u32x2 uw = uwa[tt][dt]; const f32x4 sv4 = acc[dt][tt];
            u32x2 ow; ow.x = cvt_pk_bf16(gelu_tanh_f(bflo(uw.x)) * (sv4[0] + bs), gelu_tanh_f(bfhi(uw.x)) * (sv4[1] + bs)); ow.y = cvt_pk_bf16(gelu_tanh_f(bflo(uw.y)) * (sv4[2] + bs), gelu_tanh_f(bfhi(uw.y)) * (sv4[3] + bs));
            *(u32x2*)(MIX + (size_t)r * D + 256 + ch0) = ow; } }
}

__device__ __forceinline__ void a3_item(const Frame& F, ArgsP a, int l, int c) {
    unsigned char* ws = F.ws;
    const bf16* Z = (const bf16*)(ws + WS_Z); bf16* MIX = (bf16*)(ws + WS_H);
    int lane = F.lane; asm volatile("" : "+v"(lane)); const int wave = F.wave, tid = wave * 64 + lane;
    int r0, slo, shi; chunk_geom(c, r0, slo, shi);
    {
        { const float* w = a->in[I_SCCW] + (size_t)l * 3 * 256; const int ch = (tid & 31) * 8;
            f32x4 sw0[3], sw1[3];
#pragma unroll
            for (int k = 0; k < 3; ++k) { sw0[k] = *(const f32x4*)(w + k * 256 + ch); sw1[k] = *(const f32x4*)(w + k * 256 + ch + 4); }
#pragma unroll 1
            for (int bt = 0; bt < 2; ++bt) {
                u32x4 gcv[4][3], xiv[4][3], gbv[4];
#pragma unroll
                for (int t4 = 0; t4 < 4; ++t4) { const int lr = (tid >> 5) + 16 * (4 * bt + t4), r = r0 + lr;
#pragma unroll
                    for (int k = 0; k < 3; ++k) { const int rr = r + k - 1; const int rc = rr < slo ? slo : (rr >= shi ? shi - 1 : rr);
                        gcv[t4][k] = *(const u32x4*)(Z + (size_t)rc * ZC + ZO_GC + ch); xiv[t4][k] = *(const u32x4*)(Z + (size_t)rc * ZC + ZO_XIN + ch); }
                    gbv[t4] = *(const u32x4*)(Z + (size_t)r * ZC + ZO_GB + ch); }
#pragma unroll
                for (int t4 = 0; t4 < 4; ++t4) { const int lr = (tid >> 5) + 16 * (4 * bt + t4), r = r0 + lr;
                    float acc[8];
#pragma unroll
                    for (int j = 0; j < 8; ++j) acc[j] = 0.f;
#pragma unroll
                    for (int k = 0; k < 3; ++k) { const int rr = r + k - 1; const float ok = (rr >= slo && rr < shi) ? 1.0f : 0.0f;
                        float gc[8], xi[8]; unpack8(gcv[t4][k], gc); unpack8(xiv[t4][k], xi);
                        const f32x4 w0 = sw0[k] * ok, w1 = sw1[k] * ok;
#pragma unroll
                        for (int j = 0; j < 4; ++j) { acc[j] += w0[j] * (gc[j] * xi[j]); acc[4 + j] += w1[j] * (gc[4 + j] * xi[4 + j]); } }
                    float gb[8]; unpack8(gbv[t4], gb);
#pragma unroll
                    for (int j = 0; j < 8; ++j) acc[j] *= gb[j];
                    *(u32x4*)(MIX + (size_t)r * D + 512 + ch) = pack8(acc); } } }
        {
            LAS bf16* glu = (LAS bf16*)F.lds;
            LAS float* cvb = (LAS float*)F.lds;
            __syncthreads();
#pragma unroll 1
            for (int bt = 0; bt < 2; ++bt) {
                u32x4 cav[5], cgv[5];
#pragma unroll
                for (int t5 = 0; t5 < 5; ++t5) { const int task = tid + 512 * (5 * bt + t5), i = task >> 5, ch = (task & 31) * 8, rr = r0 - 15 + i; const int rc = rr < slo ? slo : (rr >= shi ? shi - 1 : rr);
                    cav[t5] = *(const u32x4*)(Z + (size_t)rc * ZC + ZO_CA + ch); cgv[t5] = *(const u32x4*)(Z + (size_t)rc * ZC + ZO_CG + ch); }
#pragma unroll
                for (int t5 = 0; t5 < 5; ++t5) { const int task = tid + 512 * (5 * bt + t5), i = task >> 5, ch = (task & 31) * 8, rr = r0 - 15 + i; const float ok = (rr >= slo && rr < shi) ? 1.0f : 0.0f;
                    float ca[8], cg[8], o[8]; unpack8(cav[t5], ca); unpack8(cgv[t5], cg);
#pragma unroll
                    for (int j = 0; j < 8; ++j) o[j] = ok * ca[j] * sigmoid_f(cg[j]);
                    if (task < 158 * 32) *(LAS u32x4*)(glu + i * 256 + ch) = pack8(o); } }
            LAS float* wl = (LAS float*)(F.lds + 81920);
            { float wv[16];
#pragma unroll
                for (int i = 0; i < 16; ++i) { const int idx = tid + 512 * i; wv[i] = a->in[I_CFW][(size_t)l * 31 * 256 + (idx < 31 * 256 ? idx : 0)]; }
#pragma unroll
                for (int i = 0; i < 16; ++i) { const int idx = tid + 512 * i; if (idx < 31 * 256) wl[idx] = wv[i]; } }
            __syncthreads();
            const int ch = tid & 255, lh = tid >> 8;
            const LAS float* wp = wl + ch; const LAS bf16* gp = glu + (64 * lh) * 256 + ch; LAS float* cp = cvb + (64 * lh) * 256 + ch;
            float w[31];
#pragma unroll
            for (int k = 0; k < 31; ++k) w[k] = wp[k * 256];
            const float cfb = a->in[I_CFB][l * 256 + ch];
            float res[8][8];
#pragma unroll
            for (int jb = 0; jb < 8; ++jb) {
                bf16 gv[38];
#pragma unroll
                for (int i = 0; i < 38; ++i) gv[i] = gp[(8 * jb + i) * 256];
                __builtin_amdgcn_sched_barrier(0);
#pragma unroll
                for (int j = 0; j < 8; ++j) res[jb][j] = cfb;
#pragma unroll
                for (int i = 0; i < 38; ++i) { const float g = __uint_as_float((unsigned)gv[i] << 16);
#pragma unroll
                    for (int k = 0; k < 31; ++k) { const int lo = i - k; if (lo >= 0 && lo < 8) res[jb][lo] += w[k] * g; } }
                __builtin_amdgcn_sched_barrier(0);
            }
            __syncthreads();
#pragma unroll
            for (int jb = 0; jb < 8; ++jb)
#pragma unroll
                for (int j = 0; j < 8; ++j) cp[(8 * jb + j) * 256] = res[jb][j];
            __syncthreads();
            const f32x4 g = *(const f32x4*)(a->in[I_CFG] + l * 256 + 4 * lane), bb = *(const f32x4*)(a->in[I_CFNB] + l * 256 + 4 * lane);
            for (int lr = wave; lr < 128; lr += 8) { f32x4 v = *(const LAS f32x4*)(cvb + lr * 256 + 4 * lane);
                const float mu = wave_sum((v[0] + v[1]) + (v[2] + v[3])) * (1.0f / 256.0f); v = v - mu;
                const float var = wave_sum((v[0] * v[0] + v[1] * v[1]) + (v[2] * v[2] + v[3] * v[3])) * (1.0f / 256.0f);
                const f32x4 o = v * (1.0f / sqrtf(var + 1e-5f)) * g + bb;
                u32x2 ow; ow.x = cvt_pk_bf16(silu_f(o[0]), silu_f(o[1])); ow.y = cvt_pk_bf16(silu_f(o[2]), silu_f(o[3]));
                *(u32x2*)(MIX + (size_t)(r0 + lr) * D + 768 + 4 * lane) = ow; }
            __syncthreads();
        }
    }
}

__device__ __forceinline__ void pa_phase(const Frame& F, ArgsP a, int l, int nfull, int nall) {
    const int n2 = nfull, n3 = 2 * nfull, n4 = n3 + nall, n5 = n4 + nall, n6 = n5 + nall;
    for (int it = F.vcu; it < n6; it += F.G) {
        if (it < n2) a2_item(F, a, l, it);
        else if (it < n3) a3_item(F, a, l, it - n2);
        else if (it < n4) a1_item<0>(F, a, l, it - n3);
        else if (it < n5) a1_item<1>(F, a, l, it - n4);
        else a1_item<2>(F, a, l, it - n5);
    }
    __syncthreads();
}

__device__ __forceinline__ void m3_phase(const Frame& F) {
    unsigned char* ws = F.ws; const float* ST = (const float*)(ws + WS_ST); bf16* STE = (bf16*)(ws + WS_STE); const float* ACS = (const float*)(ws + WS_ACS);
    for (int task = F.vcu * 512 + F.tid; task < BATCH * 2 * 4 * 2048; task += F.G * 512) {
        const int q = task & 2047, h = (task >> 11) & 3, dir = (task >> 13) & 1, b = task >> 14;
        f32x4 e = {0.f, 0.f, 0.f, 0.f};
        for (int step = 0; step < 18; ++step) {
            int c;
            if (dir == 0) c = step < 2 ? NCHX + 2 * b + step : 16 * b + (step - 2);
            else c = step < 2 ? NCHX + 2 * b + (1 - step) : 16 * b + (17 - step);
            const float dec = __expf(dir == 0 ? ACS[(size_t)(c * 128 + 127) * 8 + h] : ACS[(size_t)(c * 128) * 8 + 4 + h]);
            const size_t eo = ((size_t)(c * 2 + dir) * 4 + h) * 8192 + (size_t)q * 4;
            const f32x4 s = *(const f32x4*)(ST + eo);
            u32x2 w; w.x = cvt_pk_bf16(e[0], e[1]); w.y = cvt_pk_bf16(e[2], e[3]); *(u32x2*)(STE + eo) = w;
            e = e * dec + s;
        }
    }
}

__device__ __forceinline__ void pc_phase(const Frame& F, ArgsP a, int l, int nchunks) {
    unsigned char* ws = F.ws;
    const bf16* Z = (const bf16*)(ws + WS_Z); const bf16* XBC = (const bf16*)(ws + WS_XBC); const bf16* XT = (const bf16*)(ws + WS_XT); const bf16* STE = (const bf16*)(ws + WS_STE);
    const float* DT = (const float*)(ws + WS_DT); const float* ACS = (const float*)(ws + WS_ACS); bf16* MIX = (bf16*)(ws + WS_H);
    LAS unsigned char* BL = F.lds;
    LAS unsigned char* XL = F.lds + 32768;
    LAS unsigned char* SL = F.lds + 65536;
    LAS float* sv = (LAS float*)(F.lds + 131072);
    LAS float* exch = sv + 2048;
    const int tid = F.tid, lane = F.lane, wave = F.wave, j = lane & 15, q = lane >> 4, lt = wave >> 1, hl = wave & 1;
    const int srow = tid >> 4, cpos = tid & 15;
    const unsigned ldsw = (unsigned)wave * 1024u;
    for (int item = F.vcu; item < nchunks * 2; item += F.G) {
        const int c = item >> 1, r0 = c * 128, l0 = 64 * (item & 1) + 16 * lt, lrow = l0 + j;
        __syncthreads();
        for (int i = tid; i < 1024; i += 512) { const int row = i >> 3, col = i & 7; sv[(col >> 2) * 512 + (col & 3) * 128 + row] = ACS[(size_t)(r0 + row) * 8 + col]; sv[1024 + (col >> 2) * 512 + (col & 3) * 128 + row] = DT[(size_t)(r0 + row) * 8 + col]; }
        f32x4 Yt[2][4];
#pragma unroll
        for (int g = 0; g < 2; ++g) {
            const int h = 2 * g + hl;
#pragma unroll
            for (int jj = 0; jj < 4; ++jj) { const int row = srow + 32 * jj; const int sc = 8 * (cpos ^ (row & 15));
                __builtin_amdgcn_global_load_lds((const unsigned*)(XBC + (size_t)(r0 + row) * 768 + 256 + g * 128 + sc), (LAS unsigned*)(BL + jj * 8192 + ldsw), 16, 0, 0);
                __builtin_amdgcn_global_load_lds((const unsigned*)(XT + ((size_t)c * 256 + g * 128 + row) * 128 + sc), (LAS unsigned*)(XL + jj * 8192 + ldsw), 16, 0, 0); }
#pragma unroll
            for (int b = 0; b < 4; ++b)
#pragma unroll
                for (int jj = 0; jj < 2; ++jj) { const int row = srow + 32 * jj; const int sc = 8 * (cpos ^ (row & 15));
                    __builtin_amdgcn_global_load_lds((const unsigned*)(STE + (((size_t)(c * 2 + (b & 1)) * 4 + 2 * g + (b >> 1)) * 64 + row) * 128 + sc), (LAS unsigned*)(SL + b * 16384 + jj * 8192 + ldsw), 16, 0, 0); }
            bf16x8 cf[4];
            { const bf16* Cn = XBC + (size_t)(r0 + lrow) * 768 + 512 + g * 128 + 8 * q;
#pragma unroll
                for (int k = 0; k < 4; ++k) cf[k] = *(const bf16x8*)(Cn + 32 * k); }
            asm volatile("s_waitcnt vmcnt(0)" ::: "memory");
            __syncthreads();
            f32x4 G[8];
#pragma unroll
            for (int st = 0; st < 8; ++st) { G[st] = (f32x4){0.f, 0.f, 0.f, 0.f};
#pragma unroll
                for (int k = 0; k < 4; ++k) G[st] = __builtin_amdgcn_mfma_f32_16x16x32_bf16(*(const LAS bf16x8*)(BL + (16 * st + j) * 256 + 16 * ((4 * k + q) ^ j)), cf[k], G[st], 0, 0, 0); }
            const float afl = sv[h * 128 + lrow], abl = sv[512 + h * 128 + lrow], Dh = a->in[I_SSDD][l * 4 + h];
            bf16x8 wf[4];
#pragma unroll
            for (int J = 0; J < 4; ++J) { float wv[8];
#pragma unroll
                for (int hf = 0; hf < 2; ++hf)
#pragma unroll
                    for (int r = 0; r < 4; ++r) { const int st = 2 * J + hf, sidx = 16 * st + 4 * q + r; float m = 0.f;
                        if (sidx <= lrow) m += fexp(afl - sv[h * 128 + sidx]) * sv[1024 + h * 128 + sidx];
                        if (sidx >= lrow) m += fexp(abl - sv[512 + h * 128 + sidx]) * sv[1536 + h * 128 + sidx];
                        wv[4 * hf + r] = G[st][r] * m + (sidx == lrow ? Dh : 0.f); }
                const u32x4 pk = pack8(wv); wf[J] = __builtin_bit_cast(bf16x8, pk); }
            f32x4 Y[4];
#pragma unroll
            for (int pt = 0; pt < 4; ++pt) { Y[pt] = (f32x4){0.f, 0.f, 0.f, 0.f}; const int row = hl * 64 + 16 * pt + j; const LAS unsigned char* xp = XL + row * 256 + 8 * (q & 1);
#pragma unroll
                for (int J = 0; J < 4; ++J) { const u32x2 lo = *(const LAS u32x2*)(xp + 16 * ((4 * J + (q >> 1)) ^ j)), hi = *(const LAS u32x2*)(xp + 16 * ((4 * J + 2 + (q >> 1)) ^ j)); const u32x4 xw = {lo.x, lo.y, hi.x, hi.y};
                    Y[pt] = __builtin_amdgcn_mfma_f32_16x16x32_bf16(__builtin_bit_cast(bf16x8, xw), wf[J], Y[pt], 0, 0, 0); } }
#pragma unroll
            for (int dir = 0; dir < 2; ++dir) { const float e = fexp(dir == 0 ? afl : abl); const LAS unsigned char* sp = SL + (hl * 2 + dir) * 16384;
#pragma unroll
                for (int pt = 0; pt < 4; ++pt) { f32x4 yd = {0.f, 0.f, 0.f, 0.f};
#pragma unroll
                    for (int k = 0; k < 4; ++k) yd = __builtin_amdgcn_mfma_f32_16x16x32_bf16(*(const LAS bf16x8*)(sp + (16 * pt + j) * 256 + 16 * ((4 * k + q) ^ j)), cf[k], yd, 0, 0, 0);
                    Y[pt] += yd * e; } }
#pragma unroll
            for (int pt = 0; pt < 4; ++pt) Yt[g][pt] = Y[pt];
            if (g == 0) __syncthreads();
        }
        float ssq = 0.f;
#pragma unroll
        for (int g = 0; g < 2; ++g)
#pragma unroll
            for (int pt = 0; pt < 4; ++pt) { const int ch = (2 * g + hl) * 64 + 16 * pt + 4 * q; const u32x2 zw = *(const u32x2*)(Z + (size_t)(r0 + lrow) * ZC + ZO_Z + ch);
                f32x4 v = Yt[g][pt]; v[0] *= silu_f(bflo(zw.x)); v[1] *= silu_f(bfhi(zw.x)); v[2] *= silu_f(bflo(zw.y)); v[3] *= silu_f(bfhi(zw.y)); Yt[g][pt] = v;
                ssq += (v[0] * v[0] + v[1] * v[1]) + (v[2] * v[2] + v[3] * v[3]); }
        ssq += __shfl_xor(ssq, 16); ssq += __shfl_xor(ssq, 32);
        if (q == 0) exch[(hl * 4 + lt) * 16 + j] = ssq;
        __syncthreads();
        const float rstd = 1.0f / sqrtf((exch[lt * 16 + j] + exch[(4 + lt) * 16 + j]) * (1.0f / 256.0f) + 1e-6f);
#pragma unroll
        for (int g = 0; g < 2; ++g)
#pragma unroll
            for (int pt = 0; pt < 4; ++pt) { const int ch = (2 * g + hl) * 64 + 16 * pt + 4 * q; const f32x4 ng = *(const f32x4*)(a->in[I_SNG] + l * 256 + ch); const f32x4 o = Yt[g][pt] * rstd * ng;
                u32x2 ow; ow.x = cvt_pk_bf16(o[0], o[1]); ow.y = cvt_pk_bf16(o[2], o[3]); *(u32x2*)(MIX + (size_t)(r0 + lrow) * D + ch) = ow; }
    }
    __syncthreads();
}

__device__ __forceinline__ void moe_assign(const Frame& F) {
    unsigned char* ws = F.ws; const unsigned* cnt = (const unsigned*)(ws + WS_CTL) + CW_CNT; unsigned* run = (unsigned*)(ws + WS_CTL) + CW_RUN;
    const int* tope = (const int*)(ws + WS_TOPE); const float* topp = (const float*)(ws + WS_TOPP); int* rowtok = (int*)(ws + WS_ROWTOK); float* rowp = (float*)(ws + WS_ROWP);
    int pre[2][8];
#pragma unroll
    for (int k = 0; k < 2; ++k) { int s = 0;
#pragma unroll
        for (int e = 0; e < 8; ++e) { pre[k][e] = s; s += ((int)__hip_atomic_load(cnt + k * 8 + e, RLX_AGENT) + 255) >> 8; } }
    const int gw = F.vcu * 8 + F.wave, NGW = F.G * 8, lane = F.lane;
    for (int base = gw * 64; base < RX; base += NGW * 64) {
        const int tok = base + lane;
#pragma unroll
        for (int k = 0; k < 2; ++k) { const int e = tope[(size_t)tok * 2 + k]; int slot = 0;
#pragma unroll
            for (int q = 0; q < 8; ++q) { const unsigned long long m = __ballot(e == q);
                if (m != 0ull) { unsigned b0 = 0; if (lane == 0) b0 = __hip_atomic_fetch_add(run + k * 8 + q, (unsigned)__popcll(m), RLX_AGENT); b0 = __shfl(b0, 0);
                    if (e == q) slot = 256 * pre[k][q] + (int)b0 + __popcll(m & ((1ull << lane) - 1ull)); } }
            rowtok[k * MOE_ROWS + slot] = tok; rowp[k * MOE_ROWS + slot] = topp[(size_t)tok * 2 + k]; ((int*)(ws + WS_SLOT))[k * RX + tok] = slot; }
    }
}

__device__ __forceinline__ void final_norm(const Frame& F, ArgsP a) {
    const int gw = F.vcu * 8 + F.wave, NGW = F.G * 8, lane = F.lane;
    const float* gate = (const float*)(F.ws + WS_MODV) + 17 * 6144 + 5 * 1024;
    const bf16* Y = (const bf16*)(F.ws + WS_Y);
    f32x4 gv[4];
#pragma unroll
    for (int j = 0; j < 4; ++j) gv[j] = *(const f32x4*)(a->in[I_FNG] + 4 * lane + 256 * j);
    for (int r = gw; r < RX; r += NGW) { float* xr = a->out + (size_t)r * D; const bf16* xs = (const bf16*)(F.ws + WS_XS) + (size_t)r * D; f32x4 v[4], y[4]; float ss = 0.f;
        const f32x2 pp = *(const f32x2*)((const float*)(F.ws + WS_TOPP) + (size_t)r * 2);
        const int sl0 = ((const int*)(F.ws + WS_SLOT))[r], sl1 = ((const int*)(F.ws + WS_SLOT))[RX + r];
#pragma unroll
        for (int j = 0; j < 4; ++j) { const u32x2 w = *(const u32x2*)(xs + 4 * lane + 256 * j); v[j] = (f32x4){bflo(w.x), bfhi(w.x), bflo(w.y), bfhi(w.y)}; y[j] = (f32x4){0.f, 0.f, 0.f, 0.f}; }
#pragma unroll
        for (int k = 0; k < 2; ++k) { const int sl = k == 0 ? sl0 : sl1; const float p = k == 0 ? pp[0] : pp[1];
            if (sl < MOE_YROWS) { const bf16* yr = Y + ((size_t)k * MOE_YROWS + sl) * D + 4 * lane;
#pragma unroll
                for (int j = 0; j < 4; ++j) { const u32x2 w = *(const u32x2*)(yr + 256 * j); y[j][0] += p * bflo(w.x); y[j][1] += p * bfhi(w.x); y[j][2] += p * bflo(w.y); y[j][3] += p * bfhi(w.y); } }
            else {
                const bf16* sb = (const bf16*)(F.ws + (k == 0 ? WS_MSLAB0 : WS_MSLAB1)) + (size_t)(sl & 255) * 256 + 4 * lane; const int tl = (sl >> 8) - 128;
#pragma unroll
                for (int j = 0; j < 4; ++j)
#pragma unroll
                    for (int part = 0; part < MOE_P; ++part) { const u32x2 w = *(const u32x2*)(sb + ((size_t)((tl * 4 + j) * MOE_P + part) << 16)); y[j][0] += p * bflo(w.x); y[j][1] += p * bfhi(w.x); y[j][2] += p * bflo(w.y); y[j][3] += p * bfhi(w.y); } } }
        const float* g = gate + (size_t)(r >> 11) * 6144 + 4 * lane;
#pragma unroll
        for (int j = 0; j < 4; ++j) { v[j] += *(const f32x4*)(g + 256 * j) * y[j]; ss += (v[j][0] * v[j][0] + v[j][1] * v[j][1]) + (v[j][2] * v[j][2] + v[j][3] * v[j][3]); }
        const float rstd = 1.0f / sqrtf(wave_sum(ss) * (1.0f / D) + 1e-6f);
#pragma unroll
        for (int j = 0; j < 4; ++j) *(f32x4*)(xr + 4 * lane + 256 * j) = v[j] * rstd * gv[j]; }
}

__device__ __forceinline__ void phase_begin(Frame& F, int wave0) {
    int w = wave0; asm volatile("" : "+s"(w));
    int ln = (int)__builtin_amdgcn_mbcnt_hi(~0u, __builtin_amdgcn_mbcnt_lo(~0u, 0u)); asm volatile("" : "+v"(ln));
    F.wave = w; F.lane = ln; F.tid = w * 64 + ln; }
enum { PH_P0 = 0, PH0_N1, PH0_WIN, PH0_MA, PH0_M3, PH0_MC, PH0_WOUT, PH0_N2, PH0_UP, PH0_DN,
       PH1_N1, PH1_WIN, PH1_MA, PH1_M3, PH1_MC, PH1_WOUT, PH1_N2R, PH1_ASG, PH1_UP, PH1_DN0, PH1_DN1, PH_FIN, NPHASE };
__global__ void __launch_bounds__(512, 2) fwd_kernel(Args args_unused) {
    extern __shared__ __attribute__((aligned(16))) unsigned char lds_raw[];
    ArgsP ap = (ArgsP)__builtin_amdgcn_kernarg_segment_ptr();
    Frame F;
    F.lds = (LAS unsigned char*)lds_raw;
    const int wave0 = __builtin_amdgcn_readfirstlane((int)threadIdx.x >> 6);
    phase_begin(F, wave0);
    F.G = gridDim.x; { const int bx = blockIdx.x; F.vcu = (F.G % 8 == 0) ? (bx % 8) * (F.G / 8) + bx / 8 : bx; }
    F.ws = ap->ws;
    volatile LAS unsigned* MISC = (volatile LAS unsigned*)(F.lds + MISC_OFF);
    if (F.tid < 64) MISC[F.tid] = 0u;
    __syncthreads();
    XcdBarrier bar; bar.bar = (unsigned*)(ap->ws + WS_CTL) + CW_BAR; bar.x = 0; bar.st = nullptr;
    const int lo = ap->ph_lo, hi = ap->ph_hi;
    if (hi - lo > 1) bar = xcd_barrier_post((unsigned*)(ap->ws + WS_CTL) + CW_BAR, MISC + 8, F.tid);
#define IN(k) (phase_begin(F, wave0), ({ asm volatile("" : "+s"(ap)); }), F.ws = ap->ws, lo <= (k) && (k) < hi)
#define SEAM(k) do { if (IN(k) && IN((k) + 1)) xcd_barrier(bar, F.tid); } while (0)
    const int c = (int)blockIdx.x;
#define XS ((bf16*)(F.ws + WS_XS))
#define H ((bf16*)(F.ws + WS_H))
#define Zb ((bf16*)(F.ws + WS_Z))
#define modv ((const float*)(F.ws + WS_MODV))
#define ctl ((unsigned*)(F.ws + WS_CTL))

    if (IN(PH_P0)) { p0_prologue(F, ap); } SEAM(PH_P0);
    if (IN(PH0_N1)) { norm_phase<0, false>(F, ap, 0, RT, ap->in[I_X], ap->in[I_CTX], ap->in[I_N1G], 0, 1); } SEAM(PH0_N1);
    if (IN(PH0_WIN)) { pg8::RegSched S; S.init(H, F.ws + WS_WIN, D, RT / 256, ZC / 256, 0, 1, 0, F.G, c); pg8::EpiStoreBf16 E{Zb, ZC};
        pg8::gemm_phase<pg8::EpiStoreBf16, pg8::RegSched, false>(F.lds, D, S, E, F.tid); } SEAM(PH0_WIN);
    if (IN(PH0_MA)) { pa_phase(F, ap, 0, NCH, NCH); } SEAM(PH0_MA);
    if (IN(PH0_M3)) { m3_phase(F); } SEAM(PH0_M3);
    if (IN(PH0_MC)) { pc_phase(F, ap, 0, NCH); } SEAM(PH0_MC);
    if (IN(PH0_WOUT)) { pg8::RegSched S; S.init(H, F.ws + WS_WOUT, D, RT / 256, D / 256, 0, 1, 0, F.G, c); { pg8::EpiResid<true> E{ap->in[I_X], ap->in[I_CTX], XS, modv + 2 * 1024};
        pg8::gemm_phase<pg8::EpiResid<true>, pg8::RegSched, false>(F.lds, D, S, E, F.tid); } } SEAM(PH0_WOUT);
    if (IN(PH0_N2)) { norm_phase<3, true>(F, ap, 0, RT, (const float*)XS, nullptr, ap->in[I_N2G], 3, 4); } SEAM(PH0_N2);
    if (IN(PH0_UP)) { g8::SchedD S; S.nMw = RT / 256; S.nN = 2 * DFF / 256; S.nMt = 0; S.G = F.G; S.c = c; S.nt = D / 128; S.P = 1; S.A = (const char*)H; S.tstepA = (size_t)256 * D; S.W = (const char*)(F.ws + WS_WUP); S.tstepB = (size_t)256 * D;
        g8::EpiSwiglu8<DFF> E{F.ws + WS_Z, 1.0f / 64.0f};
        g8::gemm8_phase<g8::EpiSwiglu8<DFF>, g8::SchedD, false>(F.lds, D, S, E, nullptr, F.tid); } SEAM(PH0_UP);
    if (IN(PH0_DN)) { g8::SchedD S; S.nMw = RX / 256; S.nN = D / 256; S.nMt = RC / 256; S.G = F.G; S.c = c; S.nt = DFF / 128; S.P = FFN_P; S.A = (const char*)(F.ws + WS_Z); S.tstepA = (size_t)256 * DFF; S.W = (const char*)(F.ws + WS_WDN); S.tstepB = (size_t)256 * DFF;
        g8::EpiResid8 E{XS, modv + 5 * 1024, (float*)(F.ws + WS_FSLAB), 1.0f / 64.0f};
        g8::gemm8_phase<g8::EpiResid8, g8::SchedD, false>(F.lds, DFF, S, E, nullptr, F.tid); } SEAM(PH0_DN);
    if (IN(PH1_N1)) { norm_phase<0, true>(F, ap, 1, RT, (const float*)XS, nullptr, ap->in[I_N1G] + D, 0, 1, (const float*)(F.ws + WS_FSLAB)); } SEAM(PH1_N1);
    if (IN(PH1_WIN)) { pg8::RegSched S; S.init(H, F.ws + WS_WIN + (size_t)ZC * D * 2, D, RX / 256, ZC / 256, RC / 256, 3, RX / 256, F.G, c); pg8::EpiStoreBf16 E{Zb, ZC};
        pg8::gemm_phase<pg8::EpiStoreBf16, pg8::RegSched, false>(F.lds, D, S, E, F.tid); } SEAM(PH1_WIN);
    if (IN(PH1_MA)) { pa_phase(F, ap, 1, NCHX, NCH); } SEAM(PH1_MA);
    if (IN(PH1_M3)) { m3_phase(F); } SEAM(PH1_M3);
    if (IN(PH1_MC)) { pc_phase(F, ap, 1, NCHX); } SEAM(PH1_MC);
    if (IN(PH1_WOUT)) { pg8::RegSched S; S.init(H, F.ws + WS_WOUT + (size_t)D * D * 2, D, RX / 256, D / 256, 0, 1, 0, F.G, c); { pg8::EpiResid<false> E{nullptr, nullptr, XS, modv + 17 * 6144 + 2 * 1024};
        pg8::gemm_phase<pg8::EpiResid<false>, pg8::RegSched, false>(F.lds, D, S, E, F.tid); } } SEAM(PH1_WOUT);
    if (IN(PH1_N2R)) { norm_phase<2, true>(F, ap, 1, RX, (const float*)XS, nullptr, ap->in[I_N2G] + D, 3, 4); moe_convert(F, ap); } SEAM(PH1_N2R);
    if (IN(PH1_ASG)) { moe_assign(F); } SEAM(PH1_ASG);
    if (IN(PH1_UP) || IN(PH1_DN0) || IN(PH1_DN1)) {
        g8::Sched S;
#pragma unroll
        for (int k = 0; k < 2; ++k) { int sacc = 0;
#pragma unroll
            for (int e = 0; e < 8; ++e) { if (k == 0) S.pre0[e] = sacc; else S.pre1[e] = sacc; sacc += (__builtin_amdgcn_readfirstlane((int)__hip_atomic_load(ctl + CW_CNT + k * 8 + e, RLX_AGENT)) + 255) >> 8; } if (k == 0) S.pre0[8] = sacc; else S.pre1[8] = sacc; }
        S.G = F.G; S.c = c;
        if (IN(PH1_UP)) {
            S.k0 = 0; S.npass = 2; S.P = 1; S.nN = 2 * EFF / 256; S.nt = D / 128; S.Abase = (const char*)H; S.arow = 0; S.apass = 0; S.Wbase = (const char*)(F.ws + WS_WMUP); S.wstride = (size_t)2 * EFF * D; S.tstepB = (size_t)256 * D;
            g8::EpiSwiglu8<EFF> E{F.ws + WS_T, 1.0f / 64.0f};
            g8::gemm8_phase<g8::EpiSwiglu8<EFF>, g8::Sched, true>(F.lds, D, S, E, (const int*)(F.ws + WS_ROWTOK), F.tid); }
        SEAM(PH1_UP);
#pragma unroll
        for (int k = 0; k < 2; ++k) {
            if (IN(PH1_DN0 + k)) { S.k0 = k; S.npass = 1; S.P = MOE_P; S.nN = D / 256; S.nt = EFF / 128; S.Abase = (const char*)(F.ws + WS_T); S.arow = EFF; S.apass = (size_t)MOE_ROWS * EFF; S.Wbase = (const char*)(F.ws + WS_WMDN); S.wstride = (size_t)D * EFF; S.tstepB = (size_t)256 * EFF;
                g8::EpiMoeDown8 E{(bf16*)(F.ws + WS_Y), 1.0f / 64.0f, (bf16*)(F.ws + WS_MSLAB0), (bf16*)(F.ws + WS_MSLAB1)};
                g8::gemm8_phase<g8::EpiMoeDown8, g8::Sched, false>(F.lds, EFF, S, E, nullptr, F.tid); }
            SEAM(PH1_DN0 + k);
        }
    }
    if (IN(PH_FIN)) { final_norm(F, ap); }
#undef IN
#undef SEAM
#undef XS
#undef H
#undef Zb
#undef modv
#undef ctl
}

extern "C" void kernel_launch(void* const* d_in, const int* in_sizes, int n_in, void* d_out, int out_size, void* d_ws, size_t ws_size, hipStream_t stream) {
    static int grid = 0;
    if (grid == 0) {
        if (n_in != 33 || out_size != RX * D || ws_size < WS_NEED) { fprintf(stderr, "kernel_launch: unexpected problem (n_in %d, out %d, ws %zu, need %zu); nothing launched\n", n_in, out_size, ws_size, (size_t)WS_NEED); grid = -1; return; }
        int dev = 0, cus = 0, per_cu = 0;
        if (hipGetDevice(&dev) != hipSuccess || hipDeviceGetAttribute(&cus, hipDeviceAttributeMultiprocessorCount, dev) != hipSuccess) { grid = -1; return; }
        if (hipFuncSetAttribute((const void*)fwd_kernel, hipFuncAttributeMaxDynamicSharedMemorySize, LDS_BYTES) != hipSuccess) { fprintf(stderr, "kernel_launch: hipFuncSetAttribute failed\n"); grid = -1; return; }
        if (hipOccupancyMaxActiveBlocksPerMultiprocessor(&per_cu, (const void*)fwd_kernel, 512, LDS_BYTES) != hipSuccess || per_cu < 1) fprintf(stderr, "kernel_launch: occupancy query reports %d\n", per_cu);
        (void)hipGetLastError();
        grid = cus;
    }
    if (grid < 0) return;
    (void)hipMemsetAsync((char*)d_ws + WS_CTL, 0, CTL_BYTES, stream);
    Args a{};
    for (int i = 0; i < 33; ++i) a.in[i] = (const float*)d_in[i];
    a.out = (float*)d_out; a.ws = (unsigned char*)d_ws;
#if ONE_LAUNCH
    a.ph_lo = 0; a.ph_hi = NPHASE;
    hipLaunchKernelGGL(fwd_kernel, dim3(grid), dim3(512), LDS_BYTES, stream, a);
#else
    for (int p = 0; p < NPHASE; ++p) { a.ph_lo = p; a.ph_hi = p + 1; hipLaunchKernelGGL(fwd_kernel, dim3(grid), dim3(512), LDS_BYTES, stream, a); }
#endif
}
```
